# Optimizing an MI355X kernel written in HIP

```python
import jax
import jax.numpy as jnp
from jax import lax
import numpy as np

D_MODEL = 2048
BATCH = 4
SEQ = 2048
DEPTH = 4

GRID_W = 64
CTX_LEN = 256
N_BRANCH = 3
MIX_W = 1024
A_HEADS = 8
A_DK = 128
A_DV = MIX_W // A_HEADS
B_HEADS = 8
B_DK = 64
B_DV = MIX_W // B_HEADS
GK_RANK = 16
GATE_LOGIT_NORMALIZER = 16.0
C_HEADS = 8
C_DH = MIX_W // C_HEADS
KR_MAX = 8
KC = 16
D_FF = 4 * D_MODEL
CHUNK = 16
ROPE_THETA = 10000.0
RMS_EPS = 1e-6
LN_EPS = 1e-5
MASK_VALUE = -1e30
DEEPNORM_ALPHA = (2 * DEPTH) ** 0.25
DEEPNORM_BETA = (8 * DEPTH) ** -0.25
IN_SPLITS = (A_HEADS * A_DK, MIX_W, MIX_W, A_HEADS * A_DK, A_HEADS * A_DK,
             B_HEADS * B_DK, B_HEADS * B_DK, MIX_W, MIX_W, 2 * GK_RANK,
             MIX_W, MIX_W, MIX_W,
             N_BRANCH * D_MODEL)
N_IN = int(sum(IN_SPLITS))
SPLIT_POINTS = tuple(int(s) for s in np.cumsum(IN_SPLITS)[:-1])

kernel_name = 'hybrid_dit_hgrn2_gla_natten'


def to_heads(a, n_heads):
    b, t, w = a.shape
    return a.reshape(b, t, n_heads, w // n_heads).transpose(0, 2, 1, 3)


def from_heads(a):
    b, h, t, d = a.shape
    return a.transpose(0, 2, 1, 3).reshape(b, t, h * d)


def layer_norm(x, g, b):
    xf = x.astype(jnp.float32)
    mu = xf.mean(-1, keepdims=True)
    var = jnp.square(xf - mu).mean(-1, keepdims=True)
    return ((xf - mu) * lax.rsqrt(var + LN_EPS) * g.astype(jnp.float32) + b.astype(jnp.float32)).astype(x.dtype)


def rms_norm_swish_gate(o, gain, gate):
    of = o.astype(jnp.float32)
    of = of * lax.rsqrt(jnp.mean(jnp.square(of), -1, keepdims=True) + RMS_EPS) * gain.astype(jnp.float32)
    return (from_heads(of) * jax.nn.silu(gate.astype(jnp.float32))).astype(gate.dtype)


def axial_rope(t, dim):
    half = dim // 2
    freqs = ROPE_THETA ** (-jnp.arange(0, half, 2, dtype=jnp.float32) / half)
    pos = jnp.arange(t)
    ang_r = (pos // GRID_W).astype(jnp.float32)[:, None] * freqs
    ang_c = (pos % GRID_W).astype(jnp.float32)[:, None] * freqs
    ang = jnp.concatenate([ang_r, ang_r, ang_c, ang_c], axis=-1)
    return jnp.cos(ang), jnp.sin(ang)


def rotate_half(u):
    h = u.shape[-1] // 2
    return jnp.concatenate([-u[..., h:], u[..., :h]], axis=-1)


def apply_axial_rope(x, cos, sin):
    x_r, x_c = jnp.split(x, 2, axis=-1)
    return x * cos + jnp.concatenate([rotate_half(x_r), rotate_half(x_c)], axis=-1) * sin


def chunk_gated_scan(q, k, v, log_a, s0):
    bsz, nh, t, _ = q.shape
    dv = v.shape[-1]
    n = t // CHUNK
    blk = lambda a: a.astype(jnp.float32).reshape(bsz, nh, n, CHUNK, a.shape[-1])
    q, k, v, log_a = blk(q), blk(k), blk(v), blk(log_a)
    b = jnp.cumsum(log_a, axis=3)
    lower = jnp.tril(jnp.ones((CHUNK, CHUNK), dtype=bool))[:, :, None]
    rel = b[:, :, :, :, None, :] - b[:, :, :, None, :, :]
    decay = jnp.where(lower, jnp.exp(jnp.where(lower, rel, 0.0)), 0.0)
    scores = jnp.einsum('bhntd,bhntsd,bhnsd->bhnts', q, decay, k)
    o = jnp.einsum('bhnts,bhnsv->bhntv', scores, v)
    b_end = b[:, :, :, -1, :]
    kv = jnp.einsum('bhnsd,bhnsv->bhndv', k * jnp.exp(b_end[:, :, :, None, :] - b), v)

    def step(s, inp):
        a_end, kv_c = inp
        return a_end[..., None] * s + kv_c, s

    s_final, s_prev = lax.scan(step, s0.astype(jnp.float32),
                               (jnp.moveaxis(jnp.exp(b_end), 2, 0), jnp.moveaxis(kv, 2, 0)))
    o = o + jnp.einsum('bhntd,nbhdv->bhntv', q * jnp.exp(b), s_prev)
    return o.reshape(bsz, nh, t, dv), s_final


def context_final_state(k, v, log_a):
    k, v, log_a = (a.astype(jnp.float32) for a in (k, v, log_a))
    b = jnp.cumsum(log_a, axis=2)
    return jnp.einsum('bhtd,bhtv->bhdv', k * jnp.exp(b[:, :, -1:, :] - b), v)


def one_direction(q_l, k_l, v_l, la_l, q_c, k_c, v_c, la_c, with_ctx_out):
    if with_ctx_out:
        bsz, nh, _, dk = k_c.shape
        o_c, s_c = chunk_gated_scan(q_c, k_c, v_c, la_c, jnp.zeros((bsz, nh, dk, v_c.shape[-1]), jnp.float32))
    else:
        o_c, s_c = None, context_final_state(k_c, v_c, la_c)
    o_l, _ = chunk_gated_scan(q_l, k_l, v_l, la_l, s_c)
    return o_l, o_c


def bidirectional_scan(q_l, k_l, v_l, la_l, q_c, k_c, v_c, la_c, with_ctx_out):
    rev = lambda a: jnp.flip(a, axis=2)
    f_l, f_c = one_direction(q_l, k_l[0], v_l, la_l[0], q_c, k_c[0], v_c, la_c[0], with_ctx_out)
    r_l, r_c = one_direction(rev(q_l), rev(k_l[1]), rev(v_l), rev(la_l[1]),
                             rev(q_c), rev(k_c[1]), rev(v_c), rev(la_c[1]), with_ctx_out)
    o_l = f_l + rev(r_l)
    o_c = f_c + rev(r_c) if with_ctx_out else None
    return o_l, o_c


def hgrn2_forget(f_raw, lb):
    f = f_raw.astype(jnp.float32)
    k = (1.0 - lb) * jax.nn.sigmoid(-f)
    log_a = jnp.log(lb + (1.0 - lb) * jax.nn.sigmoid(f))
    return to_heads(k, A_HEADS), to_heads(log_a, A_HEADS)


def hgrn2_branch(p_l, p_c, lb, norm_g, with_ctx_out):
    def prep(p):
        q, i, g, f_fwd, f_bwd = p
        q = to_heads(jax.nn.silu(q.astype(jnp.float32)), A_HEADS) * (A_DK ** -0.5)
        v = to_heads(i.astype(jnp.float32), A_HEADS)
        k_f, la_f = hgrn2_forget(f_fwd, lb[0])
        k_b, la_b = hgrn2_forget(f_bwd, lb[1])
        return q, (k_f, k_b), v, (la_f, la_b), g

    q_l, k_l, v_l, la_l, g_l = prep(p_l)
    q_c, k_c, v_c, la_c, g_c = prep(p_c)
    o_l, o_c = bidirectional_scan(q_l, k_l, v_l, la_l, q_c, k_c, v_c, la_c, with_ctx_out)
    y_l = rms_norm_swish_gate(o_l, norm_g, g_l)
    y_c = rms_norm_swish_gate(o_c, norm_g, g_c) if with_ctx_out else None
    return y_l, y_c


def gla_branch(p_l, p_c, w_gk2, b_gk2, norm_g, cos, sin, with_ctx_out):
    def decays(gk_low):
        lows = jnp.split(gk_low, 2, axis=-1)
        return tuple(to_heads(jax.nn.log_sigmoid((lo @ w_gk2[d] + b_gk2[d]).astype(jnp.float32))
                              / GATE_LOGIT_NORMALIZER, B_HEADS) for d, lo in enumerate(lows))

    q_l, k_l, v_l, g_l, gk_l = p_l
    q_c, k_c, v_c, g_c, gk_c = p_c
    scale = B_DK ** -0.5
    ql = apply_axial_rope(to_heads(q_l.astype(jnp.float32), B_HEADS), cos, sin) * scale
    kl = apply_axial_rope(to_heads(k_l.astype(jnp.float32), B_HEADS), cos, sin)
    vl = to_heads(v_l, B_HEADS)
    qc = to_heads(q_c.astype(jnp.float32), B_HEADS) * scale
    kc = to_heads(k_c, B_HEADS)
    vc = to_heads(v_c, B_HEADS)
    o_l, o_c = bidirectional_scan(ql, (kl, kl), vl, decays(gk_l), qc, (kc, kc), vc, decays(gk_c), with_ctx_out)
    y_l = rms_norm_swish_gate(o_l, norm_g, g_l)
    y_c = rms_norm_swish_gate(o_c, norm_g, g_c) if with_ctx_out else None
    return y_l, y_c


def neighbourhood_branch(p_l, p_c, rpb, with_ctx_out):
    q, k, v = (to_heads(a, C_HEADS) for a in p_l)
    qc, kc, vc = (to_heads(a, C_HEADS) for a in p_c)
    bsz, nh, t, dh = q.shape
    rows = t // GRID_W
    kr = min(KR_MAX, rows)
    scale = dh ** -0.5
    r = jnp.arange(rows)
    col = jnp.arange(GRID_W)
    row_idx = jnp.clip(r - kr // 2, 0, rows - kr)[:, None] + jnp.arange(kr)[None, :]
    col_start = jnp.clip(col - KC // 2, 0, GRID_W - KC)
    col_ok = (col[None, :] >= col_start[:, None]) & (col[None, :] < col_start[:, None] + KC)
    q_grid = q.reshape(bsz, nh, rows, GRID_W, dh)
    k_band = k.reshape(bsz, nh, rows, GRID_W, dh)[:, :, row_idx]
    v_band = v.reshape(bsz, nh, rows, GRID_W, dh)[:, :, row_idx]
    dr = row_idx - r[:, None] + (KR_MAX - 1)
    dc = jnp.clip(col[None, :] - col[:, None] + (KC - 1), 0, 2 * KC - 2)
    bias = rpb[:, dr[:, None, :, None], dc[None, :, None, :]].astype(jnp.float32)
    s_band = jnp.einsum('bhrqd,bhrkjd->bhrqkj', q_grid, k_band).astype(jnp.float32) * scale + bias
    s_band = jnp.where(col_ok[:, None, :], s_band, MASK_VALUE)
    s_ctx = jnp.einsum('bhtd,bhcd->bhtc', q, kc).astype(jnp.float32) * scale
    n_band = kr * GRID_W
    s = jnp.concatenate([s_band.reshape(bsz, nh, rows, GRID_W, n_band),
                         s_ctx.reshape(bsz, nh, rows, GRID_W, -1)], axis=-1)
    p = jax.nn.softmax(s, axis=-1).astype(v.dtype)
    o = (jnp.einsum('bhrqkj,bhrkjd->bhrqd', p[..., :n_band].reshape(bsz, nh, rows, GRID_W, kr, GRID_W), v_band)
         + jnp.einsum('bhrqc,bhcd->bhrqd', p[..., n_band:], vc))
    y_l = from_heads(o.reshape(bsz, nh, t, dh))
    if with_ctx_out:
        pc = jax.nn.softmax(jnp.einsum('bhsd,bhcd->bhsc', qc, kc).astype(jnp.float32) * scale, axis=-1)
        y_c = from_heads(jnp.einsum('bhsc,bhcd->bhsd', pc.astype(vc.dtype), vc))
    else:
        y_c = None
    return y_l, y_c


def merge_branches(ys, gate_logits, w_branch, w_out):
    gates = jax.nn.sigmoid(gate_logits).reshape(*gate_logits.shape[:-1], N_BRANCH, D_MODEL)
    z = jnp.einsum('btnm,nmd->btnd', jnp.stack(ys, axis=-2), w_branch)
    return jnp.sum(gates * z, axis=-2) @ w_out


def hybrid_mixer(h, h_c, w_in, lb, hgrn_norm_g, gla_w_gk2, gla_b_gk2, gla_norm_g, rpb,
                 w_branch, w_out, cos, sin, with_ctx_out):
    p_l = jnp.split(h @ w_in, SPLIT_POINTS, axis=-1)
    p_c = jnp.split(h_c @ w_in, SPLIT_POINTS, axis=-1)
    a_l, a_c = hgrn2_branch(p_l[0:5], p_c[0:5], lb, hgrn_norm_g, with_ctx_out)
    b_l, b_c = gla_branch(p_l[5:10], p_c[5:10], gla_w_gk2, gla_b_gk2, gla_norm_g, cos, sin, with_ctx_out)
    n_l, n_c = neighbourhood_branch(p_l[10:13], p_c[10:13], rpb, with_ctx_out)
    out_l = merge_branches((a_l, b_l, n_l), p_l[13], w_branch, w_out)
    out_c = merge_branches((a_c, b_c, n_c), p_c[13], w_branch, w_out) if with_ctx_out else None
    return out_l, out_c


def sqrelu_mlp(h, w1, w2):
    return jnp.square(jax.nn.relu(h @ w1)) @ w2


def setup_inputs(seed: int = 0) -> dict:
    key = jax.random.key(seed)
    ks = jax.random.split(key, 24)
    nrm = lambda k, shape, s: jax.random.normal(k, shape, jnp.float32) * s
    return {
        'x': nrm(ks[0], (BATCH, SEQ, D_MODEL), 1.0),
        'c': nrm(ks[1], (BATCH, D_MODEL), 1.0),
        'ctx': nrm(ks[2], (BATCH, CTX_LEN, D_MODEL), 1.0),
        'c_ctx': nrm(ks[3], (D_MODEL,), 1.0),
        'w_ada': nrm(ks[4], (DEPTH, D_MODEL, 6 * D_MODEL), 0.5 * D_MODEL ** -0.5),
        'b_ada': nrm(ks[5], (DEPTH, 6 * D_MODEL), 0.02),
        'w_in': nrm(ks[6], (DEPTH, D_MODEL, N_IN), D_MODEL ** -0.5),
        'hgrn_lb_logits': nrm(ks[7], (DEPTH, 2, A_HEADS * A_DK), 0.5),
        'hgrn_norm_g': 1.0 + nrm(ks[8], (DEPTH, A_DV), 0.02),
        'gla_w_gk2': nrm(ks[9], (DEPTH, 2, GK_RANK, B_HEADS * B_DK), GK_RANK ** -0.5),
        'gla_b_gk2': nrm(ks[10], (DEPTH, 2, B_HEADS * B_DK), 0.02),
        'gla_norm_g': 1.0 + nrm(ks[11], (DEPTH, B_DV), 0.02),
        'natten_rpb': nrm(ks[12], (DEPTH, C_HEADS, 2 * KR_MAX - 1, 2 * KC - 1), 0.02),
        'w_branch': nrm(ks[13], (DEPTH, N_BRANCH, MIX_W, D_MODEL), DEEPNORM_BETA * MIX_W ** -0.5),
        'w_out': nrm(ks[14], (DEPTH, D_MODEL, D_MODEL), DEEPNORM_BETA * D_MODEL ** -0.5),
        'ln1_g': 1.0 + nrm(ks[15], (DEPTH, D_MODEL), 0.02),
        'ln1_b': nrm(ks[16], (DEPTH, D_MODEL), 0.02),
        'ln2_g': 1.0 + nrm(ks[17], (DEPTH, D_MODEL), 0.02),
        'ln2_b': nrm(ks[18], (DEPTH, D_MODEL), 0.02),
        'w_mlp1': nrm(ks[19], (DEPTH, D_MODEL, D_FF), D_MODEL ** -0.5),
        'w_mlp2': nrm(ks[20], (DEPTH, D_FF, D_MODEL), DEEPNORM_BETA * D_FF ** -0.5),
    }


def reference(x, c, ctx, c_ctx, w_ada, b_ada, w_in, hgrn_lb_logits, hgrn_norm_g, gla_w_gk2, gla_b_gk2,
              gla_norm_g, natten_rpb, w_branch, w_out, ln1_g, ln1_b, ln2_g, ln2_b, w_mlp1, w_mlp2):
    cos, sin = axial_rope(x.shape[1], B_DK)
    lb_p = jax.nn.softmax(hgrn_lb_logits.astype(jnp.float32), axis=0)
    lb_cum = jnp.cumsum(lb_p, axis=0)
    lower_bounds = jnp.concatenate([jnp.zeros_like(lb_cum[:1]), lb_cum[:-1]], axis=0)
    for l in range(DEPTH):
        with_ctx_out = l < DEPTH - 1
        mod = jax.nn.silu(c) @ w_ada[l] + b_ada[l]
        mod_c = jax.nn.silu(c_ctx) @ w_ada[l] + b_ada[l]
        sh1, sc1, g1, sh2, sc2, g2 = (m[:, None, :] for m in jnp.split(mod, 6, axis=-1))
        sh1c, sc1c, g1c, sh2c, sc2c, g2c = jnp.split(mod_c, 6, axis=-1)
        h = x * (1.0 + sc1) + sh1
        h_c = ctx * (1.0 + sc1c) + sh1c
        mix, mix_c = hybrid_mixer(h, h_c, w_in[l], lower_bounds[l], hgrn_norm_g[l], gla_w_gk2[l], gla_b_gk2[l],
                                  gla_norm_g[l], natten_rpb[l], w_branch[l], w_out[l], cos, sin, with_ctx_out)
        x = layer_norm(DEEPNORM_ALPHA * x + g1 * mix, ln1_g[l], ln1_b[l])
        x = layer_norm(DEEPNORM_ALPHA * x + g2 * sqrelu_mlp(x * (1.0 + sc2) + sh2, w_mlp1[l], w_mlp2[l]),
                       ln2_g[l], ln2_b[l])
        if with_ctx_out:
            ctx = layer_norm(DEEPNORM_ALPHA * ctx + g1c * mix_c, ln1_g[l], ln1_b[l])
            ctx = layer_norm(DEEPNORM_ALPHA * ctx + g2c * sqrelu_mlp(ctx * (1.0 + sc2c) + sh2c, w_mlp1[l], w_mlp2[l]),
                             ln2_g[l], ln2_b[l])
    return x
```

```cpp
#define MK_LAUNCHES 1
#include <hip/hip_runtime.h>
#include <hip/hip_bf16.h>
#include <cstdio>
#include <cstdint>

namespace pg8 {
#define PG8_LAS __attribute__((address_space(3)))
typedef unsigned short bf16_t;
typedef short bf16x8 __attribute__((ext_vector_type(8)));
typedef float f32x4 __attribute__((ext_vector_type(4)));
typedef unsigned u32x4 __attribute__((ext_vector_type(4)));
constexpr int BM = 256, BK = 64, HALF = 128, HTB = HALF * BK * 2  , STAGE_BYTES = 8 * HTB, NXCD = 8, WGM = 4;

__host__ __device__ __forceinline__ int lds_byte(int r, int c) { const int st = (r >> 4) * 2 + (c >> 5), rr = r & 15, cc = c & 31, ob = rr * 64 + cc * 2; return st * 1024 + (ob ^ (((ob >> 9) & 1) << 5)); }
__host__ __device__ __forceinline__ void stage_rc(int b, int& R, int& C) { const int st = b / 1024, sb = b % 1024, swz = sb ^ (((sb >> 9) & 1) << 5); R = (st >> 1) * 16 + swz / 64; C = (st & 1) * 32 + (swz % 64) / 2; }
__host__ __device__ __forceinline__ int perm32(int rho) { const int n = rho >> 4, i = rho & 15; return 8 * (i >> 2) + 4 * n + (i & 3); }

__device__ __forceinline__ int xb_lane_pg8() { int z = 0; asm volatile("" : "+v"(z)); return (int)__builtin_amdgcn_mbcnt_hi(~0u, __builtin_amdgcn_mbcnt_lo(~0u, (unsigned)z)); }
struct Unit { int pm, pn, z, k0, zo; };
struct Gemm { const bf16_t* A; const bf16_t* Bt; int M, N, K; size_t zsA, zsB; int lda, ldb; };

struct StaticOrder {
    int nM, nN, nwg, G, c, wgm;
    __host__ __device__ void init(int M, int N, int G_, int c_, int wgm_ = WGM) { nM = M / BM; nN = N / BM; nwg = nM * nN; G = G_; c = c_; wgm = wgm_; }
    __host__ __device__ bool tile(long L, Unit& u) const {
        if (L >= nwg) return false;
        int wgid = (int)L; { const int q = nwg / NXCD, r = nwg % NXCD, xcd = wgid % NXCD, off = wgid / NXCD; wgid = (xcd < r ? xcd * (q + 1) : r * (q + 1) + (xcd - r) * q) + off; }
        const int nig = wgm * nN, gid = wgid / nig, fm = gid * wgm, gsz = (nM - fm) < wgm ? (nM - fm) : wgm;
        u.pm = fm + ((wgid % nig) % gsz); u.pn = (wgid % nig) / gsz; u.z = 0; u.k0 = 0; u.zo = 0; return true;
    }
    __host__ __device__ bool next(int i, Unit& u) const { return tile((long)i * G + c, u); }
    __device__ __forceinline__ void a_ready(const Unit&) const {}
    __device__ __forceinline__ void done(const Unit&) const {}
};
template <int NZ> struct SlabOrder : StaticOrder {
    __host__ __device__ bool next(int i, Unit& u) const { if (!tile((long)(i / NZ) * G + c, u)) return false; u.z = i % NZ; return true; }
};

template <int NS, int NZ = 1> struct SplitKOrder {
    int nM, nN, nwg, G, c, pm0, Kc;
    __host__ __device__ void init(int M, int N, int G_, int c_, int pm0_, int Kc_) { nM = M / BM; nN = N / BM; nwg = nM * nN * NS * NZ; G = G_; c = c_; pm0 = pm0_; Kc = Kc_; }
    __host__ __device__ bool next(int i, Unit& u) const { const long L = (long)i * G + c; if (L >= nwg) return false; const int t = (int)L / (NS * NZ), rem = (int)L % (NS * NZ), z = rem / NS, ks = rem % NS;
        u.pm = pm0 + t / nN; u.pn = t % nN; u.z = z; u.k0 = ks * Kc; u.zo = z * NS + ks; return true; }
    __device__ __forceinline__ void a_ready(const Unit&) const {}
    __device__ __forceinline__ void done(const Unit&) const {}
};
typedef float f32x2_t __attribute__((ext_vector_type(2))); typedef __bf16 bf16x2_t __attribute__((ext_vector_type(2)));
__device__ __forceinline__ unsigned cvt_pk_bf16(float lo, float hi) { const f32x2_t v = {lo, hi}; const bf16x2_t b = __builtin_convertvector(v, bf16x2_t); return __builtin_bit_cast(unsigned, b); }
__device__ __forceinline__ float bf_lo(unsigned w) { return __uint_as_float(w << 16); }
__device__ __forceinline__ float bf_hi(unsigned w) { return __uint_as_float(w & 0xffff0000u); }

template <int ACT  > struct EpiBf16 {
    static constexpr bool PERM = true, AFTER_DRAIN = false;
    bf16_t* O; int ldc; size_t zsO;
    __device__ __forceinline__ void operator()(const f32x4 (&acc)[2][2][4][2], const Unit& u, int wr, int wc, int fr, int fq) const {
        const int row0 = u.pm * BM + wr * 64 + fr; const int col0 = u.pn * BM + wc * 32 + 8 * fq;
#pragma unroll
        for (int ai = 0; ai < 2; ++ai)
#pragma unroll
            for (int m = 0; m < 4; ++m) { bf16_t* rowp = O + (size_t)u.zo * zsO + (size_t)(row0 + ai * HALF + m * 16) * ldc + col0;
#pragma unroll
                for (int bj = 0; bj < 2; ++bj) { f32x4 v0 = acc[ai][bj][m][0], v1 = acc[ai][bj][m][1];
                    if (ACT == 2) {
#pragma unroll
                        for (int j = 0; j < 4; ++j) { const float a = fmaxf(v0[j], 0.f), b = fmaxf(v1[j], 0.f); v0[j] = a * a; v1[j] = b * b; } }
                    u32x4 w; w.x = cvt_pk_bf16(v0[0], v0[1]); w.y = cvt_pk_bf16(v0[2], v0[3]); w.z = cvt_pk_bf16(v1[0], v1[1]); w.w = cvt_pk_bf16(v1[2], v1[3]);
                    *(u32x4*)(rowp + bj * HALF) = w; } }
    }
};
struct EpiF32 {
    static constexpr bool PERM = false, AFTER_DRAIN = false;
    float* C; int ldc; size_t zsC;
    __device__ __forceinline__ void operator()(const f32x4 (&acc)[2][2][4][2], const Unit& u, int wr, int wc, int fr, int fq) const {
        const int row0 = u.pm * BM + wr * 64 + fr, col0 = u.pn * BM + wc * 32 + 4 * fq;
#pragma unroll
        for (int ai = 0; ai < 2; ++ai)
#pragma unroll
            for (int m = 0; m < 4; ++m) { float* rowp = C + (size_t)u.zo * zsC + (size_t)(row0 + ai * HALF + m * 16) * ldc + col0;
#pragma unroll
                for (int bj = 0; bj < 2; ++bj)
#pragma unroll
                    for (int n = 0; n < 2; ++n) *(f32x4*)(rowp + bj * HALF + n * 16) = acc[ai][bj][m][n]; }
    }
};
template <bool ACCUM> struct EpiGate {
    static constexpr bool PERM = true, AFTER_DRAIN = false;
    bf16_t* U; int ldc; const bf16_t* GT; int ldg; size_t zsU;
    __device__ __forceinline__ void operator()(const f32x4 (&acc)[2][2][4][2], const Unit& u, int wr, int wc, int fr, int fq) const {
        const int row0 = u.pm * BM + wr * 64 + fr; const int col0 = u.pn * BM + wc * 32 + 8 * fq;
#pragma unroll
        for (int ai = 0; ai < 2; ++ai)
#pragma unroll
            for (int m = 0; m < 4; ++m) { const size_t row = (size_t)(row0 + ai * HALF + m * 16); bf16_t* rowp = U + (ACCUM ? (size_t)0 : (size_t)u.z * zsU) + row * ldc + col0; const bf16_t* gp = GT + row * ldg + (size_t)u.z * 2048 + col0;
#pragma unroll
                for (int bj = 0; bj < 2; ++bj) { const u32x4 gw = *(const u32x4*)(gp + bj * HALF); u32x4 pw = (u32x4){0u, 0u, 0u, 0u}; if (ACCUM && u.z > 0) pw = *(const u32x4*)(rowp + bj * HALF);
                    const f32x4 v0 = acc[ai][bj][m][0], v1 = acc[ai][bj][m][1]; const float a[8] = {v0[0], v0[1], v0[2], v0[3], v1[0], v1[1], v1[2], v1[3]};
                    float o[8];
#pragma unroll
                    for (int j = 0; j < 4; ++j) { const unsigned g2 = gw[j], p2 = pw[j];
                        const float s0 = __builtin_amdgcn_rcpf(1.f + __expf(-bf_lo(g2))), s1 = __builtin_amdgcn_rcpf(1.f + __expf(-bf_hi(g2)));
                        o[2 * j] = bf_lo(p2) + s0 * a[2 * j]; o[2 * j + 1] = bf_hi(p2) + s1 * a[2 * j + 1]; }
                    u32x4 w; w.x = cvt_pk_bf16(o[0], o[1]); w.y = cvt_pk_bf16(o[2], o[3]); w.z = cvt_pk_bf16(o[4], o[5]); w.w = cvt_pk_bf16(o[6], o[7]);
                    *(u32x4*)(rowp + bj * HALF) = w; } }
    }
};

template <class Epi, class Sched, bool ALIGN_EPI = false, bool SP2 = false>
__device__ __forceinline__ void gemm_phase(PG8_LAS unsigned char* lds, const Gemm g, const Sched& S, const Epi& E, const int wave0) {
    int tid_ = wave0 * 64 + xb_lane_pg8();
    const int tid = tid_, wid = __builtin_amdgcn_readfirstlane(tid >> 6), lane = tid & 63, wr = wid >> 2, wc = wid & 3, fr = lane & 15, fq = lane >> 4;
    const int K = g.K, nt = K / BK;
    unsigned voffA[2], voffB[2];
#pragma unroll
    for (int i = 0; i < 2; ++i) { int R, C; stage_rc(tid * 16 + i * 8192, R, C); const int Rb = Epi::PERM ? ((R & ~31) + perm32(R & 31)) : R;
        voffA[i] = (unsigned)(R * g.lda + C) * 2u; voffB[i] = (unsigned)(Rb * g.ldb + C) * 2u; }
    const size_t kstep = (size_t)(BK * 2);
    const size_t hstepA = (size_t)HALF * g.lda * 2, hstepB = (size_t)HALF * g.ldb * 2;
    const size_t tstepA = 2 * hstepA, tstepB = 2 * hstepB;
    const unsigned ldsw = (unsigned)wid * 1024u;
    const int aoff = lds_byte(wr * 64 + fr, fq * 8), boff = lds_byte(wc * 32 + fr, fq * 8);
#define PG8_SA(b, h) (((b) * 2 + (h)) * HTB)
#define PG8_SB(b, h) ((4 + (b) * 2 + (h)) * HTB)
#define PG8_STAGE(bufoff, gbase, voff) do { _Pragma("unroll") for (int _i = 0; _i < 2; ++_i) \
        __builtin_amdgcn_global_load_lds((const unsigned*)((const char*)(gbase) + (voff)[_i]), (PG8_LAS unsigned*)(lds + (bufoff) + ldsw + _i * 8192), 16, 0, 0); } while (0)
#define PG8_LDA(dst, b, h) do { _Pragma("unroll") for (int m = 0; m < 4; ++m) _Pragma("unroll") for (int k = 0; k < 2; ++k) dst[m][k] = *(const PG8_LAS bf16x8*)(lds + PG8_SA(b, h) + aoff + m * 2048 + k * 1024); } while (0)
#define PG8_LDB(dst, b, h) do { _Pragma("unroll") for (int n = 0; n < 2; ++n) _Pragma("unroll") for (int k = 0; k < 2; ++k) dst[n][k] = *(const PG8_LAS bf16x8*)(lds + PG8_SB(b, h) + boff + n * 2048 + k * 1024); } while (0)
#define PG8_MMA(ai, bj, At, Bt) do { __builtin_amdgcn_s_setprio(1); _Pragma("unroll") for (int m = 0; m < 4; ++m) _Pragma("unroll") for (int n = 0; n < 2; ++n) _Pragma("unroll") for (int k = 0; k < 2; ++k) \
        acc[ai][bj][m][n] = __builtin_amdgcn_mfma_f32_16x16x32_bf16(Bt[n][k], At[m][k], acc[ai][bj][m][n], 0, 0, 0); __builtin_amdgcn_s_setprio(0); } while (0)
#define PG8_WAIT_V(n) asm volatile("s_waitcnt vmcnt(" #n ")" ::: "memory")
#define PG8_WAIT_L(n) asm volatile("s_waitcnt lgkmcnt(" #n ")" ::: "memory")
#define PG8_BAR __builtin_amdgcn_s_barrier()
#define PG8_SCHED __builtin_amdgcn_sched_barrier(0)
    Unit cur, nxt; int ui = 0;
    if (!S.next(0, cur)) return;
    f32x4 acc[2][2][4][2];
#pragma unroll
    for (int a = 0; a < 2; ++a)
#pragma unroll
        for (int b = 0; b < 2; ++b)
#pragma unroll
            for (int m = 0; m < 4; ++m)
#pragma unroll
                for (int n = 0; n < 2; ++n) acc[a][b][m][n] = (f32x4){0.f, 0.f, 0.f, 0.f};
    bf16x8 At[4][2], B0[2][2], B1[2][2];
    const char* cA = (const char*)g.A + (size_t)cur.z * g.zsA + (size_t)cur.pm * tstepA + (size_t)cur.k0 * 2; const char* cB = (const char*)g.Bt + (size_t)cur.z * g.zsB + (size_t)cur.pn * tstepB + (size_t)cur.k0 * 2;
    S.a_ready(cur);
    if constexpr (SP2) {
        PG8_STAGE(PG8_SB(0, 0), cB, voffB); PG8_STAGE(PG8_SB(0, 1), cB + hstepB, voffB); PG8_STAGE(PG8_SA(0, 0), cA, voffA); PG8_STAGE(PG8_SA(0, 1), cA + hstepA, voffA);
        if (wr == 1) PG8_BAR;
        PG8_WAIT_V(2); PG8_BAR;
        PG8_STAGE(PG8_SB(1, 0), cB + kstep, voffB); PG8_STAGE(PG8_SA(1, 0), cA + kstep, voffA); PG8_STAGE(PG8_SB(1, 1), cB + hstepB + kstep, voffB);
        PG8_WAIT_V(6); PG8_BAR;
    } else {
        PG8_STAGE(PG8_SB(0, 0), cB, voffB); PG8_STAGE(PG8_SA(0, 0), cA, voffA); PG8_STAGE(PG8_SB(0, 1), cB + hstepB, voffB); PG8_STAGE(PG8_SA(0, 1), cA + hstepA, voffA);
        if (wr == 1) PG8_BAR;
        PG8_WAIT_V(4); PG8_BAR;
        PG8_STAGE(PG8_SB(1, 0), cB + kstep, voffB); PG8_STAGE(PG8_SA(1, 0), cA + kstep, voffA); PG8_STAGE(PG8_SB(1, 1), cB + hstepB + kstep, voffB);
        PG8_WAIT_V(6); PG8_BAR;
    }
    for (;;) {
        const bool has_next = S.next(ui + 1, nxt);
        const char* nA = has_next ? (const char*)g.A + (size_t)nxt.z * g.zsA + (size_t)nxt.pm * tstepA + (size_t)nxt.k0 * 2 : cA; const char* nB = has_next ? (const char*)g.Bt + (size_t)nxt.z * g.zsB + (size_t)nxt.pn * tstepB + (size_t)nxt.k0 * 2 : cB;
        for (int t = 0; t < nt; t += 2) {
            const bool last = (t == nt - 2);
            const char* a1 = cA + (size_t)(t + 1) * kstep;
            const char* a2 = last ? nA : cA + (size_t)(t + 2) * kstep; const char* b2 = last ? nB : cB + (size_t)(t + 2) * kstep;
            const char* a3 = a2 + kstep; const char* b3 = b2 + kstep;
            if (last && has_next) S.a_ready(nxt);
            if constexpr (SP2) {
            PG8_LDB(B0, 0, 0); PG8_LDB(B1, 0, 1); PG8_SCHED; PG8_LDA(At, 0, 0); PG8_STAGE(PG8_SA(1, 1), a1 + hstepA, voffA);
            PG8_WAIT_V(8); PG8_WAIT_L(0); PG8_BAR; PG8_MMA(0, 0, At, B0); PG8_MMA(0, 1, At, B1); PG8_BAR; PG8_SCHED;
            PG8_LDA(At, 0, 1); PG8_STAGE(PG8_SB(0, 0), b2, voffB); PG8_STAGE(PG8_SB(0, 1), b2 + hstepB, voffB); PG8_STAGE(PG8_SA(0, 0), a2, voffA);
            PG8_WAIT_V(8); PG8_WAIT_L(0); PG8_BAR; PG8_MMA(1, 0, At, B0); PG8_MMA(1, 1, At, B1); PG8_BAR; PG8_SCHED;
            PG8_LDB(B0, 1, 0); PG8_LDB(B1, 1, 1); PG8_SCHED; PG8_LDA(At, 1, 0); PG8_STAGE(PG8_SA(0, 1), a2 + hstepA, voffA);
            PG8_WAIT_V(8); PG8_WAIT_L(0); PG8_BAR; PG8_MMA(0, 0, At, B0); PG8_MMA(0, 1, At, B1); PG8_BAR; PG8_SCHED;
            PG8_LDA(At, 1, 1); PG8_STAGE(PG8_SB(1, 0), b3, voffB); PG8_STAGE(PG8_SB(1, 1), b3 + hstepB, voffB); PG8_STAGE(PG8_SA(1, 0), a3, voffA);
            PG8_WAIT_V(8); PG8_WAIT_L(0); PG8_BAR; PG8_MMA(1, 0, At, B0); PG8_MMA(1, 1, At, B1); PG8_BAR; PG8_SCHED;
            } else {
            PG8_LDB(B0, 0, 0); PG8_SCHED; PG8_LDA(At, 0, 0); PG8_STAGE(PG8_SA(1, 1), a1 + hstepA, voffA);
            PG8_WAIT_L(8); PG8_BAR; PG8_WAIT_L(0); PG8_MMA(0, 0, At, B0); PG8_BAR; PG8_SCHED;
            PG8_LDB(B1, 0, 1); PG8_STAGE(PG8_SB(0, 0), b2, voffB);
            PG8_BAR; PG8_WAIT_L(0); PG8_MMA(0, 1, At, B1); PG8_BAR;
            PG8_LDA(At, 0, 1); PG8_STAGE(PG8_SA(0, 0), a2, voffA);
            PG8_BAR; PG8_WAIT_L(0); PG8_MMA(1, 0, At, B0); PG8_BAR; PG8_SCHED;
            PG8_STAGE(PG8_SB(0, 1), b2 + hstepB, voffB);
            PG8_WAIT_V(6); PG8_BAR; PG8_MMA(1, 1, At, B1); PG8_BAR;
            PG8_LDB(B0, 1, 0); PG8_SCHED; PG8_LDA(At, 1, 0); PG8_STAGE(PG8_SA(0, 1), a2 + hstepA, voffA);
            PG8_WAIT_L(8); PG8_BAR; PG8_WAIT_L(0); PG8_MMA(0, 0, At, B0); PG8_BAR; PG8_SCHED;
            PG8_LDB(B1, 1, 1); PG8_STAGE(PG8_SB(1, 0), b3, voffB);
            PG8_BAR; PG8_WAIT_L(0); PG8_MMA(0, 1, At, B1); PG8_BAR;
            PG8_LDA(At, 1, 1); PG8_STAGE(PG8_SA(1, 0), a3, voffA);
            PG8_BAR; PG8_WAIT_L(0); PG8_MMA(1, 0, At, B0); PG8_BAR; PG8_SCHED;
            PG8_STAGE(PG8_SB(1, 1), b3 + hstepB, voffB);
            PG8_WAIT_V(6); PG8_BAR; PG8_MMA(1, 1, At, B1); PG8_BAR;
            }
        }
        if constexpr (ALIGN_EPI) { if (wr == 0) PG8_BAR; }
        if constexpr (!Epi::AFTER_DRAIN) { E(acc, cur, wr, wc, fr, fq); S.done(cur); }
        if (!has_next) break;
#pragma unroll
        for (int a = 0; a < 2; ++a)
#pragma unroll
            for (int b = 0; b < 2; ++b)
#pragma unroll
                for (int m = 0; m < 4; ++m)
#pragma unroll
                    for (int n = 0; n < 2; ++n) acc[a][b][m][n] = (f32x4){0.f, 0.f, 0.f, 0.f};
        cur = nxt; cA = nA; cB = nB; ++ui;
        if constexpr (ALIGN_EPI) { if (wr == 1) PG8_BAR; }
    }
    PG8_WAIT_V(0);
    if constexpr (!ALIGN_EPI) { if (wr == 0) PG8_BAR; }
    PG8_BAR;
    if constexpr (Epi::AFTER_DRAIN) { E.fused(acc, cur, wr, wc, fr, fq, lds, wid, lane); S.done(cur); }
#undef PG8_SA
#undef PG8_SB
#undef PG8_STAGE
#undef PG8_LDA
#undef PG8_LDB
#undef PG8_MMA
#undef PG8_WAIT_V
#undef PG8_WAIT_L
#undef PG8_BAR
#undef PG8_SCHED
}
}

constexpr int DM = 2048, NB = 4, SEQ = 2048, DEPTH = 4, GW = 64, CTXL = 256, DFF = 8192;
constexpr int ML = NB * SEQ, MC = NB * CTXL, MT = ML + MC;
constexpr int NIN = 17440, NINP = 17664;
constexpr int NHEAD = 8;
constexpr float LN_EPS = 1e-5f, RMS_EPS = 1e-6f;
constexpr float DN_ALPHA = 1.6817928305074290f;
constexpr int PC_AQ = 0, PC_AI = 1024, PC_AG = 2048, PC_AFF = 3072, PC_AFB = 4096, PC_BQ = 5120, PC_BK = 5632, PC_BV = 6144, PC_BG = 7168,
              PC_CQ = 8192, PC_CK = 9216, PC_CV = 10240, PC_GT = 11264, PC_GK = 17408;
__host__ __device__ __forceinline__ int in_src_col(int n) { return n < 8192 ? n : (n < 17408 ? n + 32 : (n < 17440 ? 8192 + (n - 17408) : -1)); }

constexpr size_t MiB = 1u << 20;
constexpr size_t WS_CTL = 0, CTL_ZERO_BYTES = 1 * MiB;
constexpr size_t WS_MODP = 1 * MiB;
constexpr size_t WS_MOD = WS_MODP + 16 * MiB;
constexpr size_t WS_TAB = WS_MOD + 1 * MiB;
constexpr size_t TAB_LB = 0, TAB_RR = 32768, TAB_RC = 32768 + 4096;
constexpr size_t WS_WIN = WS_TAB + 1 * MiB;
constexpr size_t WS_WBR = WS_WIN + 277 * MiB;
constexpr size_t WS_WOUT = WS_WBR + 48 * MiB;
constexpr size_t WS_WM1 = WS_WOUT + 32 * MiB;
constexpr size_t WS_WM2 = WS_WM1 + 128 * MiB;
constexpr size_t WS_XS = WS_WM2 + 128 * MiB;
constexpr size_t WS_H = WS_XS + 72 * MiB;
constexpr size_t WS_P = WS_H + 36 * MiB;
constexpr size_t WS_Y = WS_P + 311 * MiB;
constexpr size_t WS_U = WS_Y + 54 * MiB;
constexpr size_t WS_MIX = WS_U + 36 * MiB;
constexpr size_t WS_HM = WS_MIX + 72 * MiB;
constexpr size_t WS_SCAN = WS_HM + 144 * MiB;
constexpr size_t WS_PART = WS_SCAN + 400 * MiB;
constexpr size_t WS_UC = WS_PART + 96 * MiB;
constexpr size_t WS_END = WS_UC + 12 * MiB;
static_assert((size_t)4 * NINP * 2048 * 2 <= 277 * MiB && (size_t)MT * NINP * 2 <= 311 * MiB, "ws map");

constexpr int RING_OFF = 0, RING_BYTES = 131072;
constexpr int LDS_BYTES = 163840;
constexpr int LDSCTL_OFF = LDS_BYTES - 1024, MISC_OFF = LDSCTL_OFF + 320;
constexpr int NWAVES = 8;

#define GAS __attribute__((address_space(1)))
#define LAS __attribute__((address_space(3)))
typedef unsigned short bf16;
typedef unsigned v4u __attribute__((ext_vector_type(4)));
typedef unsigned v2u __attribute__((ext_vector_type(2)));
typedef float f32x4 __attribute__((ext_vector_type(4)));
typedef float f32x2 __attribute__((ext_vector_type(2)));
typedef short bf16x8 __attribute__((ext_vector_type(8)));
typedef GAS unsigned gu32;
#define RLX_AGENT __ATOMIC_RELAXED, __HIP_MEMORY_SCOPE_AGENT
#define LDS_WAIT() asm volatile("s_waitcnt lgkmcnt(0)" ::: "memory")
#define VM_WAIT() asm volatile("s_waitcnt vmcnt(0)" ::: "memory")
typedef float f32x2_t __attribute__((ext_vector_type(2))); typedef __bf16 bf16x2_t __attribute__((ext_vector_type(2)));
__device__ __forceinline__ unsigned pk2(float lo, float hi) { const f32x2_t v = {lo, hi}; const bf16x2_t b = __builtin_convertvector(v, bf16x2_t); return __builtin_bit_cast(unsigned, b); }
__device__ __forceinline__ unsigned f2bf(float f) { return pk2(f, 0.f) & 0xffffu; }
__device__ __forceinline__ float bflo(unsigned w) { return __uint_as_float(w << 16); }
__device__ __forceinline__ float bfhi(unsigned w) { return __uint_as_float(w & 0xffff0000u); }
__device__ __forceinline__ float bf2f(bf16 h) { return __uint_as_float(((unsigned)h) << 16); }
__device__ __forceinline__ float sigmoidf_(float x) { return __builtin_amdgcn_rcpf(1.f + __expf(-x)); }
__device__ __forceinline__ float wave_sum(float v) {
#pragma unroll
    for (int o = 1; o < 64; o <<= 1) v += __shfl_xor(v, o);
    return v;
}
constexpr int CW_TMO = 0, CW_CODE = 1, CW_BAR = 4096, CW_QUEUE = 16384;

#define XB_TMO      128
#define XB_XCNT(j)  (256  + 64 * (j))
#define XB_XSUB(j)  (1280 + 64 * (j))
#define XB_XGEN(j)  (2304 + 64 * (j))
#define XB_TOP      3328
#define XB_TOPGEN   3392
#define XCD_BAR_WORDS 3456
#define XB_SPIN_CAP (1u << 18)

__device__ __forceinline__ unsigned xb_ld(unsigned* p)              { return __hip_atomic_load(p, __ATOMIC_RELAXED, __HIP_MEMORY_SCOPE_AGENT); }
__device__ __forceinline__ unsigned xb_add(unsigned* p, unsigned v) { return __hip_atomic_fetch_add(p, v, __ATOMIC_RELAXED, __HIP_MEMORY_SCOPE_AGENT); }
__device__ __forceinline__ unsigned xb_xcc_id() { return (unsigned)__builtin_amdgcn_s_getreg((3 << 11) | 20) & 0xFu; }
#define XB_SPIN(cond, bar) do { unsigned _sp = 0; while (cond) { __builtin_amdgcn_s_sleep(1); \
    if ((++_sp & 255u) == 0u) { if (xb_ld(&(bar)[XB_TMO])) break; if (_sp > XB_SPIN_CAP) { atomicAdd(&(bar)[XB_TMO], 1u); break; } } } } while (0)

__device__ __forceinline__ int xb_lane() { int z = 0; asm volatile("" : "+v"(z)); return (int)__builtin_amdgcn_mbcnt_hi(~0u, __builtin_amdgcn_mbcnt_lo(~0u, (unsigned)z)); }
struct XcdBarrier {
    unsigned* bar; unsigned x;
    int wave;
    volatile LAS unsigned* st;
};

__device__ __forceinline__ XcdBarrier xcd_barrier_post(unsigned* bar, volatile LAS unsigned* st) {
    XcdBarrier b; b.bar = bar; b.x = xb_xcc_id(); b.st = st; b.wave = __builtin_amdgcn_readfirstlane((int)threadIdx.x >> 6);
    if (threadIdx.x == 0) (void)xb_add(&bar[XB_XCNT(b.x)], 1u);
    return b;
}
__device__ __forceinline__ void xcd_barrier_complete(unsigned* bar, unsigned x, unsigned& nloc, unsigned& nx) {
    const unsigned G = gridDim.x * gridDim.y * gridDim.z;
    unsigned sum, cnt, mine, sp = 0u;
    for (;;) {
        sum = 0u; cnt = 0u; mine = 0u;
#pragma unroll
        for (unsigned j = 0; j < 16; ++j) { const unsigned c = xb_ld(&bar[XB_XCNT(j)]); sum += c; cnt += (c > 0u) ? 1u : 0u; mine = (j == x) ? c : mine; }
        if (sum == G) break;
        __builtin_amdgcn_s_sleep(1);
        if ((++sp & 255u) == 0u) { if (xb_ld(&bar[XB_TMO])) break; if (sp > XB_SPIN_CAP) { atomicAdd(&bar[XB_TMO], 1u); break; } }
    }
    nloc = mine > 0u ? mine : 1u; nx = cnt > 0u ? cnt : 1u;
}

__device__ __forceinline__ void xcd_barrier(const XcdBarrier& b) {
    asm volatile("s_waitcnt vmcnt(0)" ::: "memory");
    __syncthreads();
    if (b.wave == 0 && xb_lane() == 0) {
        unsigned* bar = b.bar;
        __builtin_amdgcn_s_waitcnt(0);
        unsigned nloc = b.st[0], nx = b.st[1];
        if (nloc == 0u) { xcd_barrier_complete(bar, b.x, nloc, nx); b.st[0] = nloc; b.st[1] = nx; }
        const unsigned old = xb_add(&bar[XB_XSUB(b.x)], 1u);
        const unsigned gen = old / nloc;
        if (old + 1u == (gen + 1u) * nloc) {
            __builtin_amdgcn_fence(__ATOMIC_RELEASE, "agent");
            asm volatile("s_waitcnt vmcnt(0)" ::: "memory");
            const unsigned og = xb_add(&bar[XB_TOP], 1u);
            const unsigned tg = og / nx;
            if (og + 1u == (tg + 1u) * nx) xb_add(&bar[XB_TOPGEN], 1u);
            else XB_SPIN(xb_ld(&bar[XB_TOPGEN]) == tg, bar);
            __builtin_amdgcn_fence(__ATOMIC_ACQUIRE, "agent");
            xb_add(&bar[XB_XGEN(b.x)], 1u);
            asm volatile("s_waitcnt vmcnt(0)" ::: "memory");
        } else {
            XB_SPIN(xb_ld(&bar[XB_XGEN(b.x)]) == gen, bar);
            __builtin_amdgcn_fence(__ATOMIC_ACQUIRE, "agent");
            asm volatile("s_waitcnt vmcnt(0)" ::: "memory");
        }
    }
    __syncthreads();
}


typedef const float* cfp_t; typedef __attribute__((address_space(4))) const cfp_t* kin_t;
__device__ __forceinline__ kin_t kin_launder(kin_t p) { asm volatile("" : "+s"(p)); return p; }
#define FIN(k) (kin_launder(F.kin)[k])
struct Frame {
    LAS unsigned char* lds;
    volatile LAS unsigned* MISC;
    gu32* ctl;
    int tid, lane, wave;
    int vcu, G;
    unsigned char* ws;
    kin_t kin;
    float* out;
};

__device__ __forceinline__ void p0_transpose_item(const float* W, int ldw, int src_col0, int k0, bf16* WT, int K, int dst_row0, LAS float* scr, int lane) {
    const int kr = lane >> 3, nc = lane & 7;
    f32x4 v[8];
    if (src_col0 >= 0) { const float* wp = W + (size_t)(k0 + kr) * ldw + src_col0 + 4 * nc;
#pragma unroll
        for (int i = 0; i < 8; ++i) v[i] = *(const GAS f32x4*)(wp + (size_t)(8 * i) * ldw);
    } else {
#pragma unroll
        for (int i = 0; i < 8; ++i) v[i] = (f32x4){0.f, 0.f, 0.f, 0.f};
    }
#pragma unroll
    for (int i = 0; i < 8; ++i) { LAS float* d = scr + (8 * i + kr) * 33 + 4 * nc; d[0] = v[i][0]; d[1] = v[i][1]; d[2] = v[i][2]; d[3] = v[i][3]; }
    LDS_WAIT(); asm volatile("" ::: "memory");
    const int c = lane & 7;
#pragma unroll
    for (int j = 0; j < 4; ++j) { const int n = (lane >> 3) + 8 * j; const LAS float* s = scr + (8 * c) * 33 + n;
        v4u o; o.x = pk2(s[0 * 33], s[1 * 33]); o.y = pk2(s[2 * 33], s[3 * 33]); o.z = pk2(s[4 * 33], s[5 * 33]); o.w = pk2(s[6 * 33], s[7 * 33]);
        *(GAS v4u*)(WT + (size_t)(dst_row0 + n) * K + k0 + 8 * c) = o; }
    LDS_WAIT(); asm volatile("" ::: "memory");
}
constexpr int CV_IIN = 32 * (NINP / 32), CV_IBR = 3 * 16 * 64, CV_IOUT = 32 * 64, CV_IM1 = 32 * 256, CV_IM2 = 128 * 64, CV_IL = CV_IIN + CV_IBR + CV_IOUT + CV_IM1 + CV_IM2;
constexpr int CV_P0 = 11168, CV_P1 = 18168, CV_P2 = 27168;
__device__ __forceinline__ void convert_items(Frame& F, int l, int r_lo, int r_hi, int widx, int nw) {
    LAS float* scr = (LAS float*)(F.lds + RING_OFF + F.wave * 8448); const int lane = xb_lane();
    for (int it = r_lo + widx; it < r_hi; it += nw) { int r = it;
        if (r < CV_IIN) { const int nbk = NINP / 32, kb = r / nbk, nb = r % nbk; p0_transpose_item(FIN(6) + (size_t)l * 2048 * NIN, NIN, in_src_col(32 * nb), 64 * kb, (bf16*)(F.ws + WS_WIN) + (size_t)l * NINP * 2048, 2048, 32 * nb, scr, lane); continue; } r -= CV_IIN;
        if (r < CV_IBR) { const int n = r / 1024, rr = r % 1024, kb = rr / 64, nb = rr % 64; p0_transpose_item(FIN(13) + (size_t)(l * 3 + n) * 1024 * 2048, 2048, 32 * nb, 64 * kb, (bf16*)(F.ws + WS_WBR) + (size_t)(l * 3 + n) * 2048 * 1024, 1024, 32 * nb, scr, lane); continue; } r -= CV_IBR;
        if (r < CV_IOUT) { const int kb = r / 64, nb = r % 64; p0_transpose_item(FIN(14) + (size_t)l * 2048 * 2048, 2048, 32 * nb, 64 * kb, (bf16*)(F.ws + WS_WOUT) + (size_t)l * 2048 * 2048, 2048, 32 * nb, scr, lane); continue; } r -= CV_IOUT;
        if (r < CV_IM1) { const int kb = r / 256, nb = r % 256; p0_transpose_item(FIN(19) + (size_t)l * 2048 * 8192, 8192, 32 * nb, 64 * kb, (bf16*)(F.ws + WS_WM1) + (size_t)l * 8192 * 2048, 2048, 32 * nb, scr, lane); continue; } r -= CV_IM1;
        { const int kb = r / 64, nb = r % 64; p0_transpose_item(FIN(20) + (size_t)l * 8192 * 2048, 2048, 32 * nb, 64 * kb, (bf16*)(F.ws + WS_WM2) + (size_t)l * 2048 * 8192, 8192, 32 * nb, scr, lane); }
    }
}
__device__ __forceinline__ void convert_pocket(Frame& F, int lnext, int r_lo, int r_hi, int first_idle) {
    const int c = (int)blockIdx.x; if (lnext >= DEPTH || c < first_idle) return;
    convert_items(F, lnext, r_lo, r_hi, (c - first_idle) * NWAVES + F.wave, ((int)gridDim.x - first_idle) * NWAVES);
}
__device__ __forceinline__ void p0_prologue(Frame& FF) {
    Frame F = FF; F.lane = xb_lane(); F.tid = F.wave * 64 + F.lane;
    LAS float* scr = (LAS float*)(F.lds + RING_OFF + F.wave * 8448);
    LAS float* sil = (LAS float*)(F.lds + RING_OFF + 69632);
    const int gw = F.vcu * NWAVES + F.wave, NGW = F.G * NWAVES;
    for (int i = F.tid; i < 5 * 2048; i += NWAVES * 64) { const int b = i >> 11, k = i & 2047; const float v = (b < 4) ? FIN(1)[b * 2048 + k] : FIN(3)[k]; sil[i] = v * sigmoidf_(v); }
    { float* LB = (float*)(F.ws + WS_TAB + TAB_LB);
      for (int i = gw * 64 + F.lane; i < 2048; i += NGW * 64) { float e[4], mx = -1e30f;
#pragma unroll
          for (int l = 0; l < 4; ++l) { e[l] = FIN(7)[l * 2048 + i]; mx = fmaxf(mx, e[l]); }
          float s = 0.f;
#pragma unroll
          for (int l = 0; l < 4; ++l) { e[l] = expf(e[l] - mx); s += e[l]; }
          const float inv = 1.f / s; float cum = 0.f;
#pragma unroll
          for (int l = 0; l < 4; ++l) { LB[l * 2048 + i] = cum; cum += e[l] * inv; } }
      f32x2* RR = (f32x2*)(F.ws + WS_TAB + TAB_RR); f32x2* RC = (f32x2*)(F.ws + WS_TAB + TAB_RC);
      for (int i = gw * 64 + F.lane; i < 96 * 16; i += NGW * 64) { const int p = i >> 4, j = i & 15; const int pos = p < 32 ? p : p - 32;
          const float fr = expf(-(float)j * (9.210340371976184f / 16.f)); const float ang = (float)pos * fr; const f32x2 cs = {cosf(ang), sinf(ang)};
          if (p < 32) RR[p * 16 + j] = cs; else RC[(p - 32) * 16 + j] = cs; } }
    __syncthreads();
    for (int u = gw; u < 3072; u += NGW) { const int l = u / 768, r = u % 768, cb = r >> 4, ks = r & 15; const int c0 = cb * 256 + 4 * F.lane;
        f32x4 acc[5];
#pragma unroll
        for (int b = 0; b < 5; ++b) acc[b] = (f32x4){0.f, 0.f, 0.f, 0.f};
        const float* wp = FIN(4) + ((size_t)l * 2048 + ks * 128) * 12288 + c0;
#pragma unroll 8
        for (int k = 0; k < 128; ++k) { const f32x4 w = *(const GAS f32x4*)(wp + (size_t)k * 12288);
#pragma unroll
            for (int b = 0; b < 5; ++b) acc[b] += w * sil[b * 2048 + ks * 128 + k]; }
        float* mp = (float*)(F.ws + WS_MODP) + ((size_t)(ks * 4 + l) * 5) * 12288 + c0;
#pragma unroll
        for (int b = 0; b < 5; ++b) *(GAS f32x4*)(mp + (size_t)b * 12288) = acc[b]; }
    convert_items(F, 0, 0, CV_IL, gw, NGW);
    for (int l = 1; l < DEPTH; ++l) convert_items(F, l, 0, F.G == 256 ? CV_P0 : CV_IL, gw, NGW);
}
__device__ __forceinline__ void p0b_modreduce(Frame& FF) {
    Frame F = FF; F.lane = xb_lane(); F.tid = F.wave * 64 + F.lane;
    const float* mp = (const float*)(F.ws + WS_MODP); float* mo = (float*)(F.ws + WS_MOD);
    for (int i = (F.vcu * NWAVES + F.wave) * 64 + F.lane; i < 4 * 5 * 12288; i += F.G * NWAVES * 64) { const int l = i / (5 * 12288), c = i % 12288;
        float s = FIN(5)[l * 12288 + c];
#pragma unroll
        for (int ks = 0; ks < 16; ++ks) s += mp[(size_t)ks * (4 * 5 * 12288) + i];
        mo[i] = s; }
}
__device__ __forceinline__ int row_modb(int row) { return row < ML ? (row >> 11) : 4; }
__device__ __forceinline__ const float* row_input(const Frame& F, int row) { return row < ML ? FIN(0) + (size_t)row * DM : FIN(2) + (size_t)(row - ML) * DM; }
__device__ __forceinline__ void store_modulated(const f32x4 (&v)[8], const float* sc, const float* sh, bf16* hrow, int lane) {
#pragma unroll
    for (int j = 0; j < 8; ++j) { const int c = 4 * lane + 256 * j; const f32x4 s = *(const GAS f32x4*)(sc + c), t = *(const GAS f32x4*)(sh + c);
        const f32x4 o = v[j] * (s + 1.0f) + t; v2u w; w.x = pk2(o[0], o[1]); w.y = pk2(o[2], o[3]); *(GAS v2u*)(hrow + c) = w; }
}
__device__ __forceinline__ void p0c_modulate(Frame& FF) {
    Frame F = FF; F.lane = xb_lane(); F.tid = F.wave * 64 + F.lane;
    const float* mo = (const float*)(F.ws + WS_MOD); bf16* H = (bf16*)(F.ws + WS_H);
    for (int row = F.vcu * NWAVES + F.wave; row < MT; row += F.G * NWAVES) { const float* xr = row_input(F, row); const float* mb = mo + (size_t)row_modb(row) * 12288;
        f32x4 v[8];
#pragma unroll
        for (int j = 0; j < 8; ++j) v[j] = *(const GAS f32x4*)(xr + 4 * F.lane + 256 * j);
        store_modulated(v, mb + 1 * 2048, mb + 0 * 2048, H + (size_t)row * DM, F.lane); }
}
__device__ __forceinline__ void ln_rows(Frame& F, const float* xbase, const float* mixbase, int nslab, float* obase, bf16* hbase, int row0, int nr, bool hm, LAS float* V, int lane, int wave) {
    f32x4 xn[8], mn[8];
    const bool part = nslab > 0;
    const unsigned ol = (unsigned)(16 * lane);
#define LN_UB(p) ([&]() -> const char* { const char* b_ = (const char*)(p); asm volatile("" : "+s"(b_)); return b_; }())
#define LN_LOAD(row) do { const char* xr_ = LN_UB(xbase + (size_t)(row) * DM); _Pragma("unroll") for (int j = 0; j < 8; ++j) xn[j] = *(const GAS f32x4*)(xr_ + ol + 1024 * j); \
        if (!part) { const char* mr_ = LN_UB((const bf16*)mixbase + (size_t)(row) * DM); _Pragma("unroll") for (int j = 0; j < 8; ++j) { const v2u w_ = *(const GAS v2u*)(mr_ + (ol >> 1) + 512 * j); mn[j] = (f32x4){bflo(w_.x), bfhi(w_.x), bflo(w_.y), bfhi(w_.y)}; } } \
        else { const bf16* pr0_ = (const bf16*)mixbase + (size_t)((row) - ML) * DM; _Pragma("unroll") for (int j = 0; j < 8; ++j) mn[j] = (f32x4){0.f, 0.f, 0.f, 0.f}; \
            _Pragma("nounroll") for (int ks = 0; ks < nslab; ++ks) { const char* ps_ = LN_UB(pr0_ + (size_t)ks * MC * DM); _Pragma("unroll") for (int j = 0; j < 8; ++j) { const v2u w_ = *(const GAS v2u*)(ps_ + (ol >> 1) + 512 * j); mn[j] += (f32x4){bflo(w_.x), bfhi(w_.x), bflo(w_.y), bfhi(w_.y)}; } } } } while (0)
    if (nr > 0) LN_LOAD(row0 + wave);
    for (int i = 0; i < nr; ++i) { const int row = row0 + wave + 8 * i;
        f32x4 v[8]; float s = 0.f;
#pragma unroll
        for (int j = 0; j < 8; ++j) { const f32x4 g = *(const LAS f32x4*)(V + 0 * 2048 + 4 * lane + 256 * j); v[j] = xn[j] * DN_ALPHA + g * mn[j]; s += (v[j][0] + v[j][1]) + (v[j][2] + v[j][3]); }
        __builtin_amdgcn_sched_barrier(0);
        if (i + 1 < nr) LN_LOAD(row + 8);
        __builtin_amdgcn_sched_barrier(0);
        const float mean = wave_sum(s) * (1.f / DM); float q = 0.f;
#pragma unroll
        for (int j = 0; j < 8; ++j) { v[j] = v[j] - mean; q += (v[j][0] * v[j][0] + v[j][1] * v[j][1]) + (v[j][2] * v[j][2] + v[j][3] * v[j][3]); }
        const float rstd = 1.0f / sqrtf(wave_sum(q) * (1.f / DM) + LN_EPS);
        char* orow = (char*)(obase + (size_t)row * DM) + ol; char* hrow = (char*)(hbase + (size_t)row * DM) + (ol >> 1);
#pragma unroll
        for (int j = 0; j < 8; ++j) { const f32x4 g = *(const LAS f32x4*)(V + 1 * 2048 + 4 * lane + 256 * j), b = *(const LAS f32x4*)(V + 2 * 2048 + 4 * lane + 256 * j);
            v[j] = v[j] * rstd * g + b; *(GAS f32x4*)(orow + 1024 * j) = v[j];
            if (hm) { const f32x4 sc = *(const LAS f32x4*)(V + 3 * 2048 + 4 * lane + 256 * j), sh = *(const LAS f32x4*)(V + 4 * 2048 + 4 * lane + 256 * j); const f32x4 o = v[j] * sc + sh;
                v2u w; w.x = pk2(o[0], o[1]); w.y = pk2(o[2], o[3]); *(GAS v2u*)(hrow + 512 * j) = w; }
            if (j & 1) __builtin_amdgcn_sched_barrier(0); }
    }
#undef LN_LOAD
#undef LN_UB
}
__device__ __forceinline__ void ln_phase(Frame& FF, int l, int gi, const float* lng, const float* lnb, int lh, int hmod, bool first, bool to_out, int nrows, bool dry, int nslab) {
    Frame F = FF; F.lane = xb_lane(); F.tid = F.wave * 64 + F.lane;
    const float* mo = (const float*)(F.ws + WS_MOD); float* XS = (float*)(F.ws + WS_XS); const float* MIX = (const float*)(F.ws + WS_MIX); bf16* H = dry ? (bf16*)(F.ws + WS_HM + 72 * MiB) : (bf16*)(F.ws + WS_H);
    LAS float* V = (LAS float*)(F.lds + RING_OFF);
    if (F.G != 256) {
        for (int row = F.vcu * NWAVES + F.wave; row < nrows; row += F.G * NWAVES) { const int mb = row_modb(row);
            const float* xr = first ? row_input(F, row) : XS + (size_t)row * DM; const float* gv = mo + ((size_t)l * 5 + mb) * 12288 + gi * 2048;
            f32x4 v[8]; float s = 0.f;
#pragma unroll
            for (int j = 0; j < 8; ++j) { const int c = 4 * F.lane + 256 * j; const f32x4 xv = *(const GAS f32x4*)(xr + c), g = *(const GAS f32x4*)(gv + c); f32x4 mv;
                if (row < ML) { const v2u w_ = *(const GAS v2u*)((const bf16*)MIX + (size_t)row * DM + c); mv = (f32x4){bflo(w_.x), bfhi(w_.x), bflo(w_.y), bfhi(w_.y)}; }
                else { const bf16* pr = (const bf16*)(F.ws + WS_PART) + (size_t)(row - ML) * DM + c; mv = (f32x4){0.f, 0.f, 0.f, 0.f}; for (int ks = 0; ks < nslab; ++ks) { const v2u w_ = *(const GAS v2u*)(pr + (size_t)ks * MC * DM); mv += (f32x4){bflo(w_.x), bfhi(w_.x), bflo(w_.y), bfhi(w_.y)}; } }
                v[j] = xv * DN_ALPHA + g * mv; s += (v[j][0] + v[j][1]) + (v[j][2] + v[j][3]); }
            const float mean = wave_sum(s) * (1.f / DM); float q = 0.f;
#pragma unroll
            for (int j = 0; j < 8; ++j) { v[j] = v[j] - mean; q += (v[j][0] * v[j][0] + v[j][1] * v[j][1]) + (v[j][2] * v[j][2] + v[j][3] * v[j][3]); }
            const float rstd = 1.0f / sqrtf(wave_sum(q) * (1.f / DM) + LN_EPS);
            float* orow = dry ? (float*)(F.ws + WS_HM) + (size_t)row * DM : (to_out ? F.out + (size_t)row * DM : XS + (size_t)row * DM);
#pragma unroll
            for (int j = 0; j < 8; ++j) { const int c = 4 * F.lane + 256 * j; const f32x4 g = *(const GAS f32x4*)(lng + c), b = *(const GAS f32x4*)(lnb + c); v[j] = v[j] * rstd * g + b; *(GAS f32x4*)(orow + c) = v[j]; }
            if (hmod >= 0) { const float* mh = mo + ((size_t)lh * 5 + mb) * 12288; store_modulated(v, mh + (hmod + 1) * 2048, mh + hmod * 2048, H + (size_t)row * DM, F.lane); } }
        return;
    }
    float* obase = dry ? (float*)(F.ws + WS_HM) : (to_out ? F.out : XS);
#pragma unroll 1
    for (int seg = 0; seg < 2; ++seg) {
        if (seg == 1 && nrows <= ML) break;
        const int mb = seg == 0 ? (F.vcu >> 6) : 4;
        __syncthreads();
        { const float* gv = mo + ((size_t)l * 5 + mb) * 12288 + gi * 2048; const float* mh = mo + ((size_t)(hmod >= 0 ? lh : l) * 5 + mb) * 12288; const int c = 4 * F.tid;
          *(LAS f32x4*)(V + 0 * 2048 + c) = *(const GAS f32x4*)(gv + c); *(LAS f32x4*)(V + 1 * 2048 + c) = *(const GAS f32x4*)(lng + c); *(LAS f32x4*)(V + 2 * 2048 + c) = *(const GAS f32x4*)(lnb + c);
          if (hmod >= 0) { *(LAS f32x4*)(V + 3 * 2048 + c) = *(const GAS f32x4*)(mh + (hmod + 1) * 2048 + c) + 1.0f; *(LAS f32x4*)(V + 4 * 2048 + c) = *(const GAS f32x4*)(mh + hmod * 2048 + c); } }
        LDS_WAIT(); __syncthreads();
        if (seg == 0) ln_rows(F, first ? FIN(0) : XS, MIX, 0, obase, H, 32 * F.vcu, 4, hmod >= 0, V, F.lane, F.wave);
        else ln_rows(F, first ? FIN(2) - (size_t)ML * DM : XS, (const float*)(F.ws + WS_PART), nslab, obase, H, ML + 4 * F.vcu, F.wave < 4 ? 1 : 0, hmod >= 0, V, F.lane, F.wave);
    }
}

typedef float f32x16 __attribute__((ext_vector_type(16)));
constexpr int NCH = 144;
constexpr size_t SC_QA = 0, SC_KA = SC_QA + 18 * MiB, SC_EA = SC_KA + 36 * MiB, SC_KTA = SC_EA + 72 * MiB, SC_AEA = SC_KTA + 36 * MiB, SC_BEA = SC_AEA + 2 * MiB, SC_VTA = SC_BEA + 2 * MiB, SC_SPA = SC_VTA + 18 * MiB,
                 SC_QB = SC_SPA + 72 * MiB, SC_KB = SC_QB + 9 * MiB, SC_EB = SC_KB + 9 * MiB, SC_KTB = SC_EB + 36 * MiB, SC_AEB = SC_KTB + 18 * MiB, SC_BEB = SC_AEB + 1 * MiB, SC_VTB = SC_BEB + 1 * MiB, SC_SPB = SC_VTB + 18 * MiB, SC_END = SC_SPB + 36 * MiB;
static_assert(SC_END <= 400 * MiB, "scan scratch");
template <int DK> struct ScanBufs {
    bf16* Q;
    bf16* K;
    unsigned short* E;
    bf16* KT;
    float* AE;
    float* BE;
    bf16* VT;
    bf16* SP;
};
__device__ __forceinline__ ScanBufs<128> bufsA(unsigned char* ws) { unsigned char* s = ws + WS_SCAN; return ScanBufs<128>{(bf16*)(s + SC_QA), (bf16*)(s + SC_KA), (unsigned short*)(s + SC_EA), (bf16*)(s + SC_KTA), (float*)(s + SC_AEA), (float*)(s + SC_BEA), (bf16*)(s + SC_VTA), (bf16*)(s + SC_SPA)}; }
__device__ __forceinline__ ScanBufs<64> bufsB(unsigned char* ws) { unsigned char* s = ws + WS_SCAN; return ScanBufs<64>{(bf16*)(s + SC_QB), (bf16*)(s + SC_QB)  , (unsigned short*)(s + SC_EB), (bf16*)(s + SC_KTB), (float*)(s + SC_AEB), (float*)(s + SC_BEB), (bf16*)(s + SC_VTB), (bf16*)(s + SC_SPB)}; }
typedef _Float16 h2_t __attribute__((ext_vector_type(2)));
__device__ __forceinline__ unsigned pkh2(float a, float b) { const h2_t v = {(_Float16)a, (_Float16)b}; return __builtin_bit_cast(unsigned, v); }
__device__ __forceinline__ float hlo(unsigned w) { return (float)__builtin_bit_cast(h2_t, w)[0]; }
__device__ __forceinline__ float hhi(unsigned w) { return (float)__builtin_bit_cast(h2_t, w)[1]; }
__device__ __forceinline__ float ex2(float x) { return __builtin_amdgcn_exp2f(x); }
__device__ __forceinline__ float clampe(float x) { return __builtin_amdgcn_fmed3f(x, -115.f, 115.f); }
__device__ __forceinline__ float bfe(const v4u& w, int c) { return (c & 1) ? bfhi(w[c >> 1]) : bflo(w[c >> 1]); }
__device__ __forceinline__ float bfe2(const v2u& w, int c) { return (c & 1) ? bfhi(w[c >> 1]) : bflo(w[c >> 1]); }

template <int NC, int CPH> __device__ __forceinline__ void store_groups(LAS v4u* Wl, const v4u (&o)[NC], bf16* hb, size_t HS, int lane) {
#pragma unroll
    for (int c = 0; c < NC; ++c) Wl[lane * NC + c] = o[c];
    LDS_WAIT();
#pragma unroll
    for (int i = 0; i < NC; ++i) { const int sidx = i * 64 + lane; const v4u v = Wl[sidx]; *(GAS v4u*)(hb + (size_t)(sidx / CPH) * HS + (size_t)(sidx % CPH) * 8) = v; }
    LDS_WAIT();
}
template <int DIR> __device__ __forceinline__ void prep_hgrn_f(const ScanBufs<128>& A, const bf16* P, const float* LB, int g, int half, int lane, LAS v4u* Wl) {
    const int ch = half * 512 + 8 * lane, h = ch >> 7, d = ch & 127; const size_t row0 = (size_t)g * 64;
    const bf16* fp = P + row0 * NINP + (DIR ? PC_AFB : PC_AFF) + ch; const bf16* qp = P + row0 * NINP + PC_AQ + ch;
    float lb[8], cum[8];
    { const f32x4 a = *(const GAS f32x4*)(LB + DIR * 1024 + ch), b = *(const GAS f32x4*)(LB + DIR * 1024 + ch + 4);
#pragma unroll
      for (int c = 0; c < 4; ++c) { lb[c] = a[c]; lb[4 + c] = b[c]; } }
#pragma unroll
    for (int c = 0; c < 8; ++c) cum[c] = 0.f;
    unsigned short* Ep = A.E + ((size_t)DIR * MT + row0) * 1024 + ch; bf16* Kp = A.K + ((size_t)DIR * MT + row0) * 1024 + ch;
    bf16* kt = A.KT + (((((size_t)DIR * NCH + g) * 8 + half * 4) * 8) * 128) * 8;
    v4u fn[4], qn[4];
#pragma unroll
    for (int j = 0; j < 4; ++j) { fn[j] = *(const GAS v4u*)(fp + (size_t)((DIR ? 0 : 60) + j) * NINP); qn[j] = *(const GAS v4u*)(qp + (size_t)((DIR ? 0 : 60) + j) * NINP); }
    for (int i8 = 0; i8 < 8; ++i8) { const int t8 = DIR ? i8 : 7 - i8;
        float kp[8][8];
#pragma unroll
        for (int hh = 0; hh < 2; ++hh) { const int hf = DIR ? hh : 1 - hh;
            v4u f[4], qf[4];
#pragma unroll
            for (int j = 0; j < 4; ++j) { f[j] = fn[j]; qf[j] = qn[j]; }
            { const int hgn = 2 * i8 + hh + 1; if (hgn < 16) { const int tb = DIR ? 4 * hgn : 60 - 4 * hgn;
#pragma unroll
                for (int j = 0; j < 4; ++j) { fn[j] = *(const GAS v4u*)(fp + (size_t)(tb + j) * NINP); qn[j] = *(const GAS v4u*)(qp + (size_t)(tb + j) * NINP); } } }
#pragma unroll
            for (int jj = 0; jj < 4; ++jj) { const int j = DIR ? jj : 3 - jj; const int t = t8 * 8 + hf * 4 + j; float ev[8], kv[8];
#pragma unroll
                for (int c = 0; c < 8; ++c) { const float x = bfe(f[j], c); const float sg = sigmoidf_(x); const float la = __log2f(lb[c] + (1.f - lb[c]) * sg); const float k = (1.f - lb[c]) * (1.f - sg);
                    const float xq = bfe(qf[j], c); const float qv = xq * sigmoidf_(xq) * 0.08838834764831845f;
                    const float e = cum[c]; cum[c] += la; kv[c] = k * ex2(e); kp[hf * 4 + j][c] = kv[c]; ev[c] = qv * ex2(fminf(-e, 126.f)); }
                { v4u ew; ew.x = pk2(ev[0], ev[1]); ew.y = pk2(ev[2], ev[3]); ew.z = pk2(ev[4], ev[5]); ew.w = pk2(ev[6], ev[7]); *(GAS v4u*)(Ep + (size_t)t * 1024) = ew; }
                v4u kw; kw.x = pk2(kv[0], kv[1]); kw.y = pk2(kv[2], kv[3]); kw.z = pk2(kv[4], kv[5]); kw.w = pk2(kv[6], kv[7]); *(GAS v4u*)(Kp + (size_t)t * 1024) = kw; } }
        { v4u og[8];
#pragma unroll
          for (int c = 0; c < 8; ++c) { og[c].x = pk2(kp[0][c], kp[1][c]); og[c].y = pk2(kp[2][c], kp[3][c]); og[c].z = pk2(kp[4][c], kp[5][c]); og[c].w = pk2(kp[6][c], kp[7][c]); }
          store_groups<8, 128>(Wl, og, kt + (size_t)t8 * 128 * 8, (size_t)8 * 128 * 8, lane); }
    }
    float* be = A.BE + (((size_t)DIR * NCH + g) * 8 + h) * 128 + d; float* ae = A.AE + (((size_t)DIR * NCH + g) * 8 + h) * 128 + d;
    *(GAS f32x4*)be = (f32x4){cum[0], cum[1], cum[2], cum[3]}; *(GAS f32x4*)(be + 4) = (f32x4){cum[4], cum[5], cum[6], cum[7]};
    *(GAS f32x4*)ae = (f32x4){ex2(cum[0]), ex2(cum[1]), ex2(cum[2]), ex2(cum[3])}; *(GAS f32x4*)(ae + 4) = (f32x4){ex2(cum[4]), ex2(cum[5]), ex2(cum[6]), ex2(cum[7])};
}
template <int DIR> __device__ __forceinline__ void prep_gla_k(const ScanBufs<64>& B, const bf16* P, const float* w2g, const float* b2g, const f32x2* RR, const f32x2* RC, int g, int half, int lane, LAS v4u* Wl) {
    const int ch = half * 256 + 4 * lane, h = ch >> 6, d = ch & 63; const size_t row0 = (size_t)g * 64;
    float w2[16][4];
#pragma unroll
    for (int r = 0; r < 16; ++r) { const f32x4 w = *(const GAS f32x4*)(w2g + ((size_t)DIR * 16 + r) * 512 + ch); w2[r][0] = w[0]; w2[r][1] = w[1]; w2[r][2] = w[2]; w2[r][3] = w[3]; }
    const f32x4 b2 = *(const GAS f32x4*)(b2g + (size_t)DIR * 512 + ch);
    const bool lat = g < 128; const int grow = g & 31; const int j0 = d & 15; const bool isrow = d < 32; const bool second = (d & 16) != 0;
    f32x2 csr[4];
#pragma unroll
    for (int c = 0; c < 4; ++c) csr[c] = RR[grow * 16 + j0 + c];
    float cum[4] = {0.f, 0.f, 0.f, 0.f};
    const bf16* kp0 = P + row0 * NINP + PC_BK + ch; const bf16* lp0 = P + row0 * NINP + PC_GK + 16 * DIR; const bf16* qp0 = P + row0 * NINP + PC_BQ + ch;
    unsigned short* Ep = B.E + ((size_t)DIR * MT + row0) * 512 + ch; bf16* Kp = B.K + ((size_t)DIR * MT + row0) * 512 + ch;
    bf16* kt = B.KT + (((((size_t)DIR * NCH + g) * 8 + half * 4) * 8) * 64) * 8;
    for (int i8 = 0; i8 < 8; ++i8) { const int t8 = DIR ? i8 : 7 - i8;
        float kp[8][4];
#pragma unroll
        for (int hh = 0; hh < 2; ++hh) { const int hf = DIR ? hh : 1 - hh;
            v2u kr[4], qr2[4]; v4u l0[4], l1[4];
#pragma unroll
            for (int j = 0; j < 4; ++j) { const size_t ro = (size_t)(t8 * 8 + hf * 4 + j) * NINP; kr[j] = *(const GAS v2u*)(kp0 + ro); qr2[j] = *(const GAS v2u*)(qp0 + ro); l0[j] = *(const GAS v4u*)(lp0 + ro); l1[j] = *(const GAS v4u*)(lp0 + ro + 8); }
#pragma unroll
            for (int jj = 0; jj < 4; ++jj) { const int j = DIR ? jj : 3 - jj; const int t = t8 * 8 + hf * 4 + j; float ev[4], kv[4];
#pragma unroll
                for (int c = 0; c < 4; ++c) { float x = b2[c];
#pragma unroll
                    for (int r = 0; r < 8; ++r) { x += bfe(l0[j], r) * w2[r][c]; x += bfe(l1[j], r) * w2[8 + r][c]; }
                    const float la = (fminf(x, 0.f) * 1.4426950408889634f - __log2f(1.f + __expf(-fabsf(x)))) * 0.0625f;
                    float k = bfe2(kr[j], c), q = bfe2(qr2[j], c);
                    if (lat) { const f32x2 cs = isrow ? csr[c] : RC[t * 16 + j0 + c]; const float pt = __shfl_xor(k, 4), pq = __shfl_xor(q, 4); k = k * cs.x + (second ? pt : -pt) * cs.y; q = q * cs.x + (second ? pq : -pq) * cs.y; }
                    const float e = cum[c]; cum[c] += la; kv[c] = k * ex2(e); kp[hf * 4 + j][c] = kv[c]; ev[c] = q * 0.125f * ex2(fminf(-e, 126.f)); }
                { v2u ew; ew.x = pk2(ev[0], ev[1]); ew.y = pk2(ev[2], ev[3]); *(GAS v2u*)(Ep + (size_t)t * 512) = ew; }
                { v2u kw; kw.x = pk2(kv[0], kv[1]); kw.y = pk2(kv[2], kv[3]); *(GAS v2u*)(Kp + (size_t)t * 512) = kw; } } }
        { v4u og[4];
#pragma unroll
          for (int c = 0; c < 4; ++c) { og[c].x = pk2(kp[0][c], kp[1][c]); og[c].y = pk2(kp[2][c], kp[3][c]); og[c].z = pk2(kp[4][c], kp[5][c]); og[c].w = pk2(kp[6][c], kp[7][c]); }
          store_groups<4, 64>(Wl, og, kt + (size_t)t8 * 64 * 8, (size_t)8 * 64 * 8, lane); }
    }
    float* be = B.BE + (((size_t)DIR * NCH + g) * 8 + h) * 64 + d; float* ae = B.AE + (((size_t)DIR * NCH + g) * 8 + h) * 64 + d;
    *(GAS f32x4*)be = (f32x4){cum[0], cum[1], cum[2], cum[3]}; *(GAS f32x4*)ae = (f32x4){ex2(cum[0]), ex2(cum[1]), ex2(cum[2]), ex2(cum[3])};
}
__device__ __forceinline__ void prep_vt(const bf16* P, int vcol, bf16* VT, int g, int half, int lane, LAS v4u* Wl) {
    const int ch = half * 512 + 8 * lane, h = ch >> 7, d = ch & 127; const size_t row0 = (size_t)g * 64; const bf16* vp = P + row0 * NINP + vcol + ch; bf16* vt = VT + ((((size_t)g * 8 + half * 4) * 8) * 128) * 8;
    for (int t8 = 0; t8 < 8; ++t8) { v4u f[8];
#pragma unroll
        for (int j = 0; j < 8; ++j) f[j] = *(const GAS v4u*)(vp + (size_t)(t8 * 8 + j) * NINP);
        v4u og[8];
#pragma unroll
        for (int c = 0; c < 8; ++c) {
#pragma unroll
            for (int q = 0; q < 4; ++q) { const unsigned a = f[2 * q][c >> 1], b = f[2 * q + 1][c >> 1]; og[c][q] = (c & 1) ? ((a >> 16) | (b & 0xffff0000u)) : ((a & 0xffffu) | (b << 16)); } }
        store_groups<8, 128>(Wl, og, vt + (size_t)t8 * 128 * 8, (size_t)8 * 128 * 8, lane); }
}
__device__ __forceinline__ void mixer_phase1(Frame& FF, int l) {
    Frame F = FF; F.lane = xb_lane(); F.tid = F.wave * 64 + F.lane;
    const bf16* P = (const bf16*)(F.ws + WS_P);
    const ScanBufs<128> A = bufsA(F.ws); const ScanBufs<64> B = bufsB(F.ws);
    const float* LB = (const float*)(F.ws + WS_TAB + TAB_LB) + (size_t)l * 2048;
    const f32x2* RR = (const f32x2*)(F.ws + WS_TAB + TAB_RR); const f32x2* RC = (const f32x2*)(F.ws + WS_TAB + TAB_RC);
    const int gw = F.vcu * NWAVES + F.wave, NGW = F.G * NWAVES;
    LAS v4u* Wl = (LAS v4u*)(F.lds + F.wave * 8192);
    constexpr int U_F = NCH * 4, U_K = NCH * 4, U_V = NCH * 4, U_QA = 0, U_QB = 0, U_ALL = U_F + U_K + U_V + U_QA + U_QB;
    int u0 = -1;
    const bool deal = (F.G == 256); if (deal) { const int w = F.wave, cu = F.vcu;
        if (w < 4) u0 = w * 256 + cu;
        else if (w == 4 && cu < 128) u0 = 1024 + cu;
        else { const int li = cu < 128 ? cu * 3 + (w - 5) : 384 + (cu - 128) * 4 + (w - 4); if (U_F + U_K + li < U_ALL) u0 = U_F + U_K + li; }
    }
    const int ustep = deal ? 1 : NGW; const int uend = deal ? 1 : U_ALL;
    for (int ui = deal ? 0 : gw; ui < uend; ui += ustep) { const int u = deal ? u0 : ui; if (u < 0) continue;
        int r = u; const int lane = xb_lane();
        if (r < U_F) { const int half = r & 1, dir = (r >> 1) & 1, g = r >> 2; if (dir == 0) prep_hgrn_f<0>(A, P, LB, g, half, lane, Wl); else prep_hgrn_f<1>(A, P, LB, g, half, lane, Wl); continue; } r -= U_F;
        if (r < U_K) { const int half = r & 1, dir = (r >> 1) & 1, g = r >> 2; const float* w2g = FIN(9) + (size_t)l * 2 * 16 * 512; const float* b2g = FIN(10) + (size_t)l * 2 * 512;
            if (dir == 0) prep_gla_k<0>(B, P, w2g, b2g, RR, RC, g, half, lane, Wl); else prep_gla_k<1>(B, P, w2g, b2g, RR, RC, g, half, lane, Wl); continue; } r -= U_K;
        if (r < U_V) { const int half = r & 1, mix = (r >> 1) & 1, g = r >> 2; if (mix == 0) prep_vt(P, PC_AI, A.VT, g, half, lane, Wl); else prep_vt(P, PC_BV, B.VT, g, half, lane, Wl); continue; } r -= U_V;
        if (r < U_QA) { const int half = r & 1, g = r >> 1; const int ch = half * 512 + 8 * lane; const size_t row0 = (size_t)g * 64;
            for (int t8 = 0; t8 < 8; ++t8) { v4u f[8];
#pragma unroll
                for (int j = 0; j < 8; ++j) f[j] = *(const GAS v4u*)(P + (row0 + t8 * 8 + j) * NINP + PC_AQ + ch);
#pragma unroll
                for (int j = 0; j < 8; ++j) { float q[8];
#pragma unroll
                    for (int c = 0; c < 8; ++c) { const float x = bfe(f[j], c); q[c] = x * sigmoidf_(x) * 0.08838834764831845f; }
                    v4u o; o.x = pk2(q[0], q[1]); o.y = pk2(q[2], q[3]); o.z = pk2(q[4], q[5]); o.w = pk2(q[6], q[7]); *(GAS v4u*)(A.Q + (row0 + t8 * 8 + j) * 1024 + ch) = o; } }
            continue; } r -= U_QA;
        { const int g = r; const int ch = 8 * lane, d = ch & 63; const size_t row0 = (size_t)g * 64;
          const bool lat = g < 128; const int grow = g & 31; const int j0 = d & 15; const bool isrow = d < 32; const bool second = (d & 16) != 0;
          f32x2 csr[8];
#pragma unroll
          for (int c = 0; c < 8; ++c) csr[c] = RR[grow * 16 + j0 + c];
          for (int t8 = 0; t8 < 8; ++t8) { v4u f[8];
#pragma unroll
              for (int j = 0; j < 8; ++j) f[j] = *(const GAS v4u*)(P + (row0 + t8 * 8 + j) * NINP + PC_BQ + ch);
#pragma unroll
              for (int j = 0; j < 8; ++j) { float q[8]; const int t = t8 * 8 + j;
#pragma unroll
                  for (int c = 0; c < 8; ++c) { float x = bfe(f[j], c);
                      if (lat) { const f32x2 cs = isrow ? csr[c] : RC[t * 16 + j0 + c]; const float pt = __shfl_xor(x, 2); x = x * cs.x + (second ? pt : -pt) * cs.y; }
                      q[c] = x * 0.125f; }
                  v4u o; o.x = pk2(q[0], q[1]); o.y = pk2(q[2], q[3]); o.z = pk2(q[4], q[5]); o.w = pk2(q[6], q[7]); *(GAS v4u*)(B.Q + (row0 + t) * 512 + ch) = o; } } }
    }
}

__device__ __forceinline__ int scan_chunk(int b, int dir, int s) { return s < 4 ? 128 + 4 * b + (dir ? 3 - s : s) : 32 * b + (dir ? 31 - (s - 4) : (s - 4)); }
template <int DK> struct P2Frag { bf16x8 a[4]; bf16x8 bv[2][4]; f32x4 ae[4]; };
template <int DK> __device__ __forceinline__ void p2_load(P2Frag<DK>& f, const ScanBufs<DK>& S, int dir, int g, int h, int dkb, int dvb, int r, int hi) {
    const bf16* kt = S.KT + (((((size_t)dir * NCH + g) * 8 + h) * 8 + hi) * DK + dkb * 32 + r) * 8;
    const bf16* vt = S.VT + ((((size_t)g * 8 + h) * 8 + hi) * 128 + dvb * 64 + r) * 8;
    const float* ae = S.AE + (((size_t)dir * NCH + g) * 8 + h) * DK + dkb * 32 + 4 * hi;
#pragma unroll
    for (int kk = 0; kk < 4; ++kk) { f.a[kk] = *(const GAS bf16x8*)(kt + (size_t)kk * 2 * DK * 8); f.bv[0][kk] = *(const GAS bf16x8*)(vt + (size_t)kk * 2 * 128 * 8); f.bv[1][kk] = *(const GAS bf16x8*)(vt + (size_t)kk * 2 * 128 * 8 + 32 * 8); f.ae[kk] = *(const GAS f32x4*)(ae + 8 * kk); }
}
template <int DK> __device__ __forceinline__ void scan_state_unit(const ScanBufs<DK>& S, int unit, int lane, bool skip_ctx_store) {
    constexpr int NKB = DK / 32;
    const int dvb = unit & 1, dkb = (unit >> 1) % NKB, rest = (unit >> 1) / NKB; const int dir = rest & 1, h = (rest >> 1) & 7, b = rest >> 4;
    const int r = lane & 31, hi = lane >> 5;
    f32x16 acc[2]; acc[0] = f32x16{}; acc[1] = f32x16{};
    P2Frag<DK> cur, nxt; p2_load<DK>(cur, S, dir, scan_chunk(b, dir, 0), h, dkb, dvb, r, hi);
    for (int s = 0; s < 36; ++s) {
        const int g = scan_chunk(b, dir, s);
        if (s + 1 < 36) p2_load<DK>(nxt, S, dir, scan_chunk(b, dir, s + 1), h, dkb, dvb, r, hi);
        if (!(skip_ctx_store && s < 4)) {
            bf16* sp = S.SP + (((((size_t)dir * NCH + g) * 8 + h) * (DK / 8) + dkb * 4) * 128 + dvb * 64 + r) * 8 + 4 * hi;
#pragma unroll
            for (int j = 0; j < 2; ++j)
#pragma unroll
                for (int q = 0; q < 4; ++q) { v2u o; o.x = pk2(acc[j][4 * q], acc[j][4 * q + 1]); o.y = pk2(acc[j][4 * q + 2], acc[j][4 * q + 3]); *(GAS v2u*)(sp + ((size_t)q * 128 + j * 32) * 8) = o; }
        }
#pragma unroll
        for (int j = 0; j < 2; ++j)
#pragma unroll
            for (int q = 0; q < 4; ++q)
#pragma unroll
                for (int i = 0; i < 4; ++i) acc[j][4 * q + i] *= cur.ae[q][i];
#pragma unroll
        for (int kk = 0; kk < 4; ++kk) { acc[0] = __builtin_amdgcn_mfma_f32_32x32x16_bf16(cur.a[kk], cur.bv[0][kk], acc[0], 0, 0, 0); acc[1] = __builtin_amdgcn_mfma_f32_32x32x16_bf16(cur.a[kk], cur.bv[1][kk], acc[1], 0, 0, 0); }
        cur = nxt;
    }
}

template <int DK> struct P2Stg { static constexpr int NC = DK == 128 ? 1 : 2, NKT = NC * DK * 128 / 8192, NVT = NC * 16384 / 8192; v4u kt[NKT]; v4u vt[NVT]; v4u ae; };
template <int DK> __device__ __forceinline__ void p2b_load(P2Stg<DK>& R, const ScanBufs<DK>& S, int blk, int s, int tid) {
    constexpr int NC = P2Stg<DK>::NC, KTB = DK * 128, VTB = 16384, AEB = DK * 4;
#pragma unroll
    for (int i = 0; i < P2Stg<DK>::NKT; ++i) { const int k = NC == 2 ? i : 0; const int c = blk * NC + k, dir = c & 1, h = (c >> 1) & 7, b = c >> 4; const int g = scan_chunk(b, dir, s);
        const char* base = (const char*)S.KT + (size_t)((dir * NCH + g) * 8 + h) * KTB + (NC == 2 ? 0 : i * 8192); R.kt[i] = *(const GAS v4u*)(base + tid * 16); }
#pragma unroll
    for (int i = 0; i < P2Stg<DK>::NVT; ++i) { const int k = NC == 2 ? (i >> 1) : 0; const int c = blk * NC + k, dir = c & 1, h = (c >> 1) & 7, b = c >> 4; const int g = scan_chunk(b, dir, s);
        const char* base = (const char*)S.VT + (size_t)(g * 8 + h) * VTB + (i & 1) * 8192; R.vt[i] = *(const GAS v4u*)(base + tid * 16); }
    { const int t5 = tid & 31; const int k = NC == 2 ? (t5 >> 4) : 0; const int c = blk * NC + k, dir = c & 1, h = (c >> 1) & 7, b = c >> 4; const int g = scan_chunk(b, dir, s);
        const char* base = (const char*)S.AE + (size_t)((dir * NCH + g) * 8 + h) * AEB; R.ae = *(const GAS v4u*)(base + (NC == 2 ? (t5 & 15) : t5) * 16); }
}
template <int DK> __device__ __forceinline__ void p2b_write(const P2Stg<DK>& R, LAS unsigned char* Lb, int tid) {
    constexpr int NC = P2Stg<DK>::NC, OFF_VT = NC * DK * 128, OFF_AE = OFF_VT + NC * 16384;
#pragma unroll
    for (int i = 0; i < P2Stg<DK>::NKT; ++i) *(LAS v4u*)(Lb + (tid + 512 * i) * 16) = R.kt[i];
#pragma unroll
    for (int i = 0; i < P2Stg<DK>::NVT; ++i) *(LAS v4u*)(Lb + OFF_VT + (tid + 512 * i) * 16) = R.vt[i];
    if (tid < 32) *(LAS v4u*)(Lb + OFF_AE + tid * 16) = R.ae;
}
template <int DK> __device__ __forceinline__ void scan_state_block(const ScanBufs<DK>& S, int blk, int wave, int lane, int tid, LAS unsigned char* L, bool skip_ctx_store) {
    constexpr int NC = P2Stg<DK>::NC, KTB = DK * 128, VTB = 16384, AEB = DK * 4, OFF_VT = NC * KTB, OFF_AE = OFF_VT + NC * VTB, STAGE = OFF_AE + NC * AEB;
    const int ci = NC == 2 ? (wave >> 2) : 0, wl = NC == 2 ? (wave & 3) : wave, dvb = wl & 1, dkb = wl >> 1;
    const int cc = blk * NC + ci, dir = cc & 1, h = (cc >> 1) & 7, b = cc >> 4;
    const int r = lane & 31, hi = lane >> 5;
    f32x16 acc[2]; acc[0] = f32x16{}; acc[1] = f32x16{};
    P2Stg<DK> R0, R1, R2;
#define P2B_ZSTORE() do { bf16* sp = S.SP + (((((size_t)dir * NCH + scan_chunk(b, dir, 0)) * 8 + h) * (DK / 8) + dkb * 4) * 128 + dvb * 64 + r) * 8 + 4 * hi; \
        _Pragma("unroll") for (int j = 0; j < 2; ++j) _Pragma("unroll") for (int q = 0; q < 4; ++q) *(GAS v2u*)(sp + ((size_t)q * 128 + j * 32) * 8) = (v2u){0u, 0u}; __builtin_amdgcn_sched_barrier(0); } while (0)
    p2b_load<DK>(R0, S, blk, 0, tid); __builtin_amdgcn_sched_barrier(0); P2B_ZSTORE(); p2b_load<DK>(R1, S, blk, 1, tid); __builtin_amdgcn_sched_barrier(0); P2B_ZSTORE(); p2b_load<DK>(R2, S, blk, 2, tid); __builtin_amdgcn_sched_barrier(0); P2B_ZSTORE();
#undef P2B_ZSTORE
#define P2B_STEP(R, s_) do { const int s = (s_); LAS unsigned char* Lb = L + (s & 1) * STAGE; p2b_write<DK>(R, Lb, tid); __builtin_amdgcn_sched_barrier(0); p2b_load<DK>(R, S, blk, min(s + 3, 35), tid); __builtin_amdgcn_sched_barrier(0);     \
        LDS_WAIT(); __builtin_amdgcn_s_barrier(); asm volatile("" ::: "memory"); \
        bf16x8 a_[4], bv_[2][4]; f32x4 ae_[4]; \
        { const LAS unsigned char* ka = Lb + ci * KTB + (hi * DK + dkb * 32 + r) * 16; const LAS unsigned char* va = Lb + OFF_VT + ci * VTB + (hi * 128 + dvb * 64 + r) * 16; const LAS unsigned char* ea = Lb + OFF_AE + ci * AEB + (dkb * 32 + 4 * hi) * 4; \
          _Pragma("unroll") for (int kk = 0; kk < 4; ++kk) { a_[kk] = *(const LAS bf16x8*)(ka + kk * 2 * DK * 16); bv_[0][kk] = *(const LAS bf16x8*)(va + kk * 2 * 128 * 16); bv_[1][kk] = *(const LAS bf16x8*)(va + kk * 2 * 128 * 16 + 32 * 16); ae_[kk] = *(const LAS f32x4*)(ea + 32 * kk); } } \
        const int g = scan_chunk(b, dir, s); \
        { bf16* sp = S.SP + (((((size_t)dir * NCH + g) * 8 + h) * (DK / 8) + dkb * 4) * 128 + dvb * 64 + r) * 8 + 4 * hi; \
            _Pragma("unroll") for (int j = 0; j < 2; ++j) _Pragma("unroll") for (int q = 0; q < 4; ++q) { v2u o; o.x = pk2(acc[j][4 * q], acc[j][4 * q + 1]); o.y = pk2(acc[j][4 * q + 2], acc[j][4 * q + 3]); *(GAS v2u*)(sp + ((size_t)q * 128 + j * 32) * 8) = o; } } \
        _Pragma("unroll") for (int j = 0; j < 2; ++j) _Pragma("unroll") for (int q = 0; q < 4; ++q) _Pragma("unroll") for (int i = 0; i < 4; ++i) acc[j][4 * q + i] *= ae_[q][i]; \
        _Pragma("unroll") for (int kk = 0; kk < 4; ++kk) { acc[0] = __builtin_amdgcn_mfma_f32_32x32x16_bf16(a_[kk], bv_[0][kk], acc[0], 0, 0, 0); acc[1] = __builtin_amdgcn_mfma_f32_32x32x16_bf16(a_[kk], bv_[1][kk], acc[1], 0, 0, 0); } } while (0)
#pragma nounroll
    for (int s3 = 0; s3 < 36; s3 += 3) { P2B_STEP(R0, s3); P2B_STEP(R1, s3 + 1); P2B_STEP(R2, s3 + 2); }
#undef P2B_STEP
}

constexpr int P3_ALP = 144, P3_WBYTES = 4 * 32 * P3_ALP, P3_STP = 272;
static_assert(32 * P3_STP <= 2 * 32 * P3_ALP, "output staging fits a t block's score rows");
template <int DK> __device__ __forceinline__ void scan_out_wave(const ScanBufs<DK>& S, int g, int h, const bf16* P, int gcol, const float* gain, bf16* Y, LAS unsigned char* W, int lane) {
    const int r = lane & 31, hi = lane >> 5;
    constexpr int NK = DK / 16, HD = 8 * DK;
    const size_t row0 = (size_t)g * 64;
    const unsigned oRow = (unsigned)((r * HD + 8 * hi) * 2);
    const unsigned oGrp = (unsigned)(((hi * 128 + r) * 8) * 2);
    const unsigned oHi4 = (unsigned)(8 * hi * 4), oHi2 = (unsigned)(8 * hi * 2);
#define UB(base) ([&]() -> const char* { const char* b_ = (const char*)(base); asm volatile("" : "+s"(b_)); return b_; }())
#define LDV(ub, off) (*(const GAS v4u*)((ub) + (off)))
#define LD16(base, off) ([&]() -> v4u { const char* b_ = (const char*)(base); asm volatile("" : "+s"(b_)); return *(const GAS v4u*)(b_ + (off)); }())
#define LD16F(base, off) ([&]() -> f32x4 { const char* b_ = (const char*)(base); asm volatile("" : "+s"(b_)); return *(const GAS f32x4*)(b_ + (off)); }())
#define P3_BLOCK(ti, si, DIAG, KA, QA) do { f32x16 acc_ = f32x16{}; _Pragma("unroll") for (int kk = 0; kk < NK; ++kk) acc_ = __builtin_amdgcn_mfma_f32_32x32x16_bf16(__builtin_bit_cast(bf16x8, KA[kk]), __builtin_bit_cast(bf16x8, QA[kk]), acc_, 0, 0, 0); \
            if (DIAG) { _Pragma("unroll") for (int e = 0; e < 16; ++e) { const int sl_ = (e & 3) + 8 * (e >> 2) + 4 * hi; const bool keep_ = dir == 0 ? (sl_ <= r) : (sl_ >= r); acc_[e] = keep_ ? acc_[e] : 0.f; } } \
            LAS unsigned char* ap_ = W + (((ti) * 2 + dir) * 32 + r) * P3_ALP + (32 * (si) + 4 * hi) * 2; \
            _Pragma("unroll") for (int q = 0; q < 4; ++q) { v2u o_; o_.x = pk2(acc_[4 * q], acc_[4 * q + 1]); o_.y = pk2(acc_[4 * q + 2], acc_[4 * q + 3]); *(LAS v2u*)(ap_ + 16 * q) = o_; } } while (0)
#define P3_ZERO(ti, si) do { LAS unsigned char* ap_ = W + (((ti) * 2 + dir) * 32 + r) * P3_ALP + (32 * (si) + 4 * hi) * 2; _Pragma("unroll") for (int q = 0; q < 4; ++q) *(LAS v2u*)(ap_ + 16 * q) = (v2u){0u, 0u}; } while (0)
#pragma unroll
    for (int dir = 0; dir < 2; ++dir) {
        const char* Qh = (const char*)(S.E + ((size_t)dir * MT + row0) * HD + h * DK); const char* Ku = (const char*)(S.K + ((size_t)dir * MT + row0) * HD + h * DK);
        v4u ka0[NK], ka1[NK], qa0[NK], qa1[NK];
        { const char* k0_ = UB(Ku); const char* k1_ = UB(Ku + (size_t)32 * HD * 2); const char* q0_ = UB(Qh); const char* q1_ = UB(Qh + (size_t)32 * HD * 2);
#pragma unroll
          for (int kk = 0; kk < NK; ++kk) { ka0[kk] = LDV(k0_ + 32 * kk, oRow); qa0[kk] = LDV(q0_ + 32 * kk, oRow); }
#pragma unroll
          for (int kk = 0; kk < NK; ++kk) { ka1[kk] = LDV(k1_ + 32 * kk, oRow); qa1[kk] = LDV(q1_ + 32 * kk, oRow); } }
        P3_BLOCK(0, 0, true, ka0, qa0);
        if (dir == 0) { P3_BLOCK(1, 0, false, ka0, qa1); P3_ZERO(0, 1); } else { P3_BLOCK(0, 1, false, ka1, qa0); P3_ZERO(1, 0); }
        P3_BLOCK(1, 1, true, ka1, qa1);
    }
#undef P3_BLOCK
#undef P3_ZERO
    LDS_WAIT();
    const char* VTu = (const char*)(S.VT + (((size_t)g * 8 + h) * 8) * 128 * 8);
    for (int tt = 0; tt < 2; ++tt) {
        f32x16 acc[4];
#pragma unroll
        for (int dvt = 0; dvt < 4; ++dvt) acc[dvt] = f32x16{};
        const LAS unsigned char* Wt = W + (size_t)tt * 2 * 32 * P3_ALP;
        const int tl = lane >> 3, seg = lane & 7; const size_t rowt = row0 + 32 * tt;
        const char* Gu = (const char*)(P + rowt * NINP + gcol + h * 128); const unsigned og = (unsigned)((tl * NINP + seg * 8) * 2);
        struct Raw8 { v4u x[8]; }; Raw8 A0, A1;
        constexpr int NST = 2 * (2 + NK);
#define P3_SLOAD(R, st) do { constexpr int dir_ = (st) / (2 + NK), j_ = (st) % (2 + NK); \
            if ((st) >= NST) { _Pragma("unroll") for (int j = 0; j < 8; ++j) { const char* gb_ = UB(Gu + ((size_t)(8 * (j >> 1)) * NINP + (j & 1) * 64) * 2); R.x[j] = LDV(gb_, og); } } \
            else if (j_ < 2) { _Pragma("unroll") for (int k2 = 0; k2 < 2; ++k2) { const char* vb_ = UB(VTu + (size_t)(2 * j_ + k2) * 2 * 128 * 16); _Pragma("unroll") for (int dvt = 0; dvt < 4; ++dvt) R.x[k2 * 4 + dvt] = LDV(vb_ + 32 * dvt * 16, oGrp); } } \
            else { constexpr int kk_ = j_ - 2; const char* sb_ = UB((const char*)(S.SP + ((((size_t)dir_ * NCH + g) * 8 + h) * (DK / 8)) * 128 * 8) + (size_t)kk_ * 2 * 128 * 16); \
                const char* qb_ = UB((const char*)(S.E + ((size_t)dir_ * MT + rowt) * HD + h * DK) + 32 * kk_); const char* bb_ = UB((const char*)(S.AE + (((size_t)dir_ * NCH + g) * 8 + h) * DK) + 64 * kk_); \
                _Pragma("unroll") for (int dvt = 0; dvt < 4; ++dvt) R.x[dvt] = LDV(sb_ + 32 * dvt * 16, oGrp); \
                R.x[4] = LDV(qb_, oRow); R.x[5] = R.x[4]; R.x[6] = LDV(bb_, oHi4); R.x[7] = LDV(bb_ + 16, oHi4); } \
            __builtin_amdgcn_sched_barrier(0); } while (0)
#define P3_SCOMP(R, st) do { constexpr int dir_ = (st) / (2 + NK), j_ = (st) % (2 + NK); \
            if (j_ < 2) { const LAS unsigned char* ap_ = Wt + (dir_ * 32 + r) * P3_ALP + (8 * hi) * 2; \
                _Pragma("unroll") for (int k2 = 0; k2 < 2; ++k2) { const bf16x8 af_ = *(const LAS bf16x8*)(ap_ + 32 * (2 * j_ + k2)); \
                    _Pragma("unroll") for (int dvt = 0; dvt < 4; ++dvt) acc[dvt] = __builtin_amdgcn_mfma_f32_32x32x16_bf16(__builtin_bit_cast(bf16x8, R.x[k2 * 4 + dvt]), af_, acc[dvt], 0, 0, 0); } } \
            else { const v4u qw_ = R.x[4]; const f32x4 b0_ = __builtin_bit_cast(f32x4, R.x[6]), b1_ = __builtin_bit_cast(f32x4, R.x[7]); v4u qa_;     \
                qa_.x = pk2(bflo(qw_.x) * b0_[0], bfhi(qw_.x) * b0_[1]); qa_.y = pk2(bflo(qw_.y) * b0_[2], bfhi(qw_.y) * b0_[3]); qa_.z = pk2(bflo(qw_.z) * b1_[0], bfhi(qw_.z) * b1_[1]); qa_.w = pk2(bflo(qw_.w) * b1_[2], bfhi(qw_.w) * b1_[3]); \
                _Pragma("unroll") for (int dvt = 0; dvt < 4; ++dvt) acc[dvt] = __builtin_amdgcn_mfma_f32_32x32x16_bf16(__builtin_bit_cast(bf16x8, R.x[dvt]), __builtin_bit_cast(bf16x8, qa_), acc[dvt], 0, 0, 0); } \
            __builtin_amdgcn_sched_barrier(0); } while (0)
#define P3_STEP2(st) do { P3_SLOAD(A1, (st) + 1); P3_SCOMP(A0, (st)); P3_SLOAD(A0, (st) + 2); P3_SCOMP(A1, (st) + 1); } while (0)
        P3_SLOAD(A0, 0);
        P3_STEP2(0); P3_STEP2(2); P3_STEP2(4); P3_STEP2(6); P3_STEP2(8); P3_STEP2(10);
        if (NK == 8) { P3_STEP2(12); P3_STEP2(14); P3_STEP2(16); P3_STEP2(18); }
#undef P3_SLOAD
#undef P3_SCOMP
#undef P3_STEP2
        float ss = 0.f;
#pragma unroll
        for (int dvt = 0; dvt < 4; ++dvt)
#pragma unroll
            for (int e = 0; e < 16; ++e) ss += acc[dvt][e] * acc[dvt][e];
        ss += __shfl_xor(ss, 32);
        const float rstd = 1.0f / sqrtf(ss * (1.f / 128.f) + RMS_EPS);
        LAS unsigned char* st = W + (size_t)tt * 2 * 32 * P3_ALP;
#pragma unroll
        for (int dvt = 0; dvt < 4; ++dvt)
#pragma unroll
            for (int q = 0; q < 4; ++q) { v2u o; o.x = pk2(acc[dvt][4 * q] * rstd, acc[dvt][4 * q + 1] * rstd); o.y = pk2(acc[dvt][4 * q + 2] * rstd, acc[dvt][4 * q + 3] * rstd); *(LAS v2u*)(st + r * P3_STP + (32 * dvt + 8 * q + 4 * hi) * 2) = o; }
        LDS_WAIT();
        { char* Yu = (char*)(Y + rowt * 1024 + h * 128); const unsigned oy = (unsigned)((tl * 1024 + seg * 8) * 2);
#pragma unroll
          for (int j = 0; j < 8; ++j) { const int rr = 8 * (j >> 1), hf = j & 1; const v4u ow = *(const LAS v4u*)(st + (tl + rr) * P3_STP + hf * 128 + seg * 16); const v4u gw = A0.x[j];
              const float* gn = gain + hf * 64 + seg * 8; const f32x4 n0 = *(const GAS f32x4*)gn, n1 = *(const GAS f32x4*)(gn + 4); v4u y;
#pragma unroll
              for (int c = 0; c < 4; ++c) { const float z0 = bflo(gw[c]), z1 = bfhi(gw[c]); const float na = c < 2 ? n0[2 * c] : n1[2 * c - 4], nb = c < 2 ? n0[2 * c + 1] : n1[2 * c - 3];
                  y[c] = pk2(bflo(ow[c]) * na * z0 * sigmoidf_(z0), bfhi(ow[c]) * nb * z1 * sigmoidf_(z1)); }
              *(GAS v4u*)(Yu + oy + ((size_t)rr * 1024 + hf * 64) * 2) = y; } }
        LDS_WAIT();
    }
#undef LD16
#undef LD16F
#undef UB
#undef LDV
}
__device__ __forceinline__ void mixer_phase3(Frame& FF, int l) {
    Frame F = FF; F.lane = xb_lane(); F.tid = F.wave * 64 + F.lane; const int lane = F.lane;
    const bf16* P = (const bf16*)(F.ws + WS_P); bf16* Y = (bf16*)(F.ws + WS_Y);
    const ScanBufs<128> A = bufsA(F.ws); const ScanBufs<64> B = bufsB(F.ws);
    const int nch = (l == DEPTH - 1) ? 128 : NCH;
    const int nu = nch * 8;
    LAS unsigned char* W = F.lds + F.wave * P3_WBYTES;
    const int NGW = F.G * NWAVES; const int gw0 = F.wave * F.G + F.vcu; const int gw1 = (F.G == 256) ? ((F.wave == 5) ? NGW + F.vcu : 2 * nu) : gw0 + NGW;
    for (int ui = 0; ui < 16; ++ui) { const int u = ui == 0 ? gw0 : (F.G == 256 ? (ui == 1 ? gw1 : 2 * nu) : gw0 + ui * NGW); if (u >= 2 * nu) break;
        const int ln = xb_lane();
        if (u < nu) scan_out_wave<128>(A, u >> 3, u & 7, P, PC_AG, FIN(8) + l * 128, Y, W, ln);
        else { const int v = u - nu; scan_out_wave<64>(B, v >> 3, v & 7, P, PC_BG, FIN(11) + l * 128, Y + (size_t)MT * 1024, W, ln); }
    }
}
namespace nat {
using s16x4 = __attribute__((ext_vector_type(4))) short; using u32x4 = __attribute__((ext_vector_type(4))) unsigned;
#define KSWZ(row, colB) ((row) * 256 + ((colB) ^ (((row) & 7) << 4)))
#define SBAR() __builtin_amdgcn_sched_barrier(0)
__device__ __forceinline__ int crow(int r, int hi) { return (r & 3) + 8 * (r >> 2) + 4 * hi; }
__device__ __forceinline__ unsigned cvtpk(float lo, float hi) {
  unsigned r; asm volatile("v_cvt_pk_bf16_f32 %0, %1, %2" : "=v"(r) : "v"(lo), "v"(hi)); return r;
}
__device__ __forceinline__ void finishSM(f32x16& p0, f32x16& p1, float alpha, float& l_reg, bf16x8& pa0, bf16x8& pa1, bf16x8& pa2, bf16x8& pa3) {
  for (int r = 0; r < 16; ++r) p1[r] = __builtin_amdgcn_exp2f(p1[r]);
  float ps = 0; for (int r = 0; r < 16; ++r) ps += p0[r]; for (int r = 0; r < 16; ++r) ps += p1[r];
  { auto rr = __builtin_amdgcn_permlane32_swap(__float_as_uint(ps), __float_as_uint(ps), false, false);
    ps = __uint_as_float(rr[0]) + __uint_as_float(rr[1]); }
  l_reg = l_reg * alpha + ps;
#define PK4(P, BASE, OUT) do { unsigned a0 = cvtpk(P[BASE + 0], P[BASE + 1]), a1 = cvtpk(P[BASE + 2], P[BASE + 3]);   \
    unsigned b0 = cvtpk(P[BASE + 4], P[BASE + 5]), b1 = cvtpk(P[BASE + 6], P[BASE + 7]);                              \
    auto r0 = __builtin_amdgcn_permlane32_swap(a0, b0, false, false); auto r1 = __builtin_amdgcn_permlane32_swap(a1, b1, false, false); \
    u32x4 w = {r0[0], r1[0], r0[1], r1[1]}; OUT = *reinterpret_cast<bf16x8*>(&w); } while (0)
  PK4(p0, 0, pa0); PK4(p0, 8, pa1); PK4(p1, 0, pa2); PK4(p1, 8, pa3);
#undef PK4
}
__device__ __forceinline__ void qkt(f32x16& p0, f32x16& p1, const bf16* Ks, const bf16x8* qr, int r32, int hi) {
  p0 = f32x16{}; p1 = f32x16{};
  for (int d0 = 0; d0 < 8; ++d0) { int cb = (d0 * 16 + hi * 8) * 2;
    bf16x8 b0 = *reinterpret_cast<const bf16x8*>((const char*)Ks + KSWZ(r32, cb));
    bf16x8 b1 = *reinterpret_cast<const bf16x8*>((const char*)Ks + KSWZ(32 + r32, cb));
    p0 = __builtin_amdgcn_mfma_f32_32x32x16_bf16(b0, qr[d0], p0, 0, 0, 0);
    p1 = __builtin_amdgcn_mfma_f32_32x32x16_bf16(b1, qr[d0], p1, 0, 0, 0); }
}
__device__ __forceinline__ int v_st(int k, int c) { const int kk = (k & ~0xC) | ((k & 4) << 1) | ((k & 8) >> 1); return ((kk >> 3) * 4 + (c >> 5)) * 512 + ((kk & 7) * 32 + (c & 31)) * 2; }
__device__ __forceinline__ int v_rd_base(int lane) { return ((lane & 3) << 3) | (((lane >> 2) & 3) << 6) | (((lane >> 4) & 1) << 5) | (((lane >> 5) & 1) << 8); }
constexpr int v_rd_off(int d0, int ks, int half) { return d0 * 512 + ks * 4096 + half * 2048; }
template <int OFF> __device__ __forceinline__ s16x4 tr_read(int vb) {
  s16x4 r; asm volatile("ds_read_b64_tr_b16 %0, %1 offset:%2" : "=&v"(r) : "v"(vb), "i"(OFF) : "memory"); return r;
}
template <int D0> __device__ __forceinline__ void pv_one(f32x16& od, int vb, bf16x8 pa0, bf16x8 pa1, bf16x8 pa2, bf16x8 pa3) {
  const s16x4 l0 = tr_read<v_rd_off(D0, 0, 0)>(vb), h0 = tr_read<v_rd_off(D0, 0, 1)>(vb), l1 = tr_read<v_rd_off(D0, 1, 0)>(vb), h1 = tr_read<v_rd_off(D0, 1, 1)>(vb);
  const s16x4 l2 = tr_read<v_rd_off(D0, 2, 0)>(vb), h2 = tr_read<v_rd_off(D0, 2, 1)>(vb), l3 = tr_read<v_rd_off(D0, 3, 0)>(vb), h3 = tr_read<v_rd_off(D0, 3, 1)>(vb);
  asm volatile("s_waitcnt lgkmcnt(0)" ::: "memory"); SBAR();
#define PK(L, H) (bf16x8){L[0], L[1], L[2], L[3], H[0], H[1], H[2], H[3]}
  od = __builtin_amdgcn_mfma_f32_32x32x16_bf16(pa0, PK(l0, h0), od, 0, 0, 0);
  od = __builtin_amdgcn_mfma_f32_32x32x16_bf16(pa1, PK(l1, h1), od, 0, 0, 0);
  od = __builtin_amdgcn_mfma_f32_32x32x16_bf16(pa2, PK(l2, h2), od, 0, 0, 0);
  od = __builtin_amdgcn_mfma_f32_32x32x16_bf16(pa3, PK(l3, h3), od, 0, 0, 0);
#undef PK
}
__device__ __forceinline__ void pv_d0(f32x16* o, int vb, bf16x8 pa0, bf16x8 pa1, bf16x8 pa2, bf16x8 pa3) {
  pv_one<0>(o[0], vb, pa0, pa1, pa2, pa3); pv_one<1>(o[1], vb, pa0, pa1, pa2, pa3); pv_one<2>(o[2], vb, pa0, pa1, pa2, pa3); pv_one<3>(o[3], vb, pa0, pa1, pa2, pa3);
}

constexpr int SHM_V = 64 * 128 * 2, SHM_K = 64 * 128 * 2, SHM_ATTN = 2 * SHM_V + 2 * SHM_K + 8 * 64 * 4;
constexpr int NAT_TAB = SHM_ATTN, NAT_TABW = 128, NAT_MISC = NAT_TAB + 15 * NAT_TABW * 4, NAT_LDS = NAT_MISC + 16;
constexpr float C2 = 0.088388347648318440f * 1.4426950408889634f;
constexpr float THR2 = 8.f * 1.4426950408889634f;
constexpr float NEGB = -1e30f;
template <bool WIN> __device__ __forceinline__ void partialSM(f32x16& p0, f32x16& p1, float& m_reg, float& mn, float& alpha, bool rowok, const float* tb, int t0) {
  if (WIN) {
    if (rowok) {
#pragma unroll
      for (int r = 0; r < 16; ++r) { const int cr = (r & 3) + 8 * (r >> 2);
        const float b0 = tb[cr], b1 = tb[cr + 32];
        p0[r] = ((unsigned)(cr + t0) < 16u) ? fmaf(p0[r], C2, b0) : NEGB;
        p1[r] = ((unsigned)(cr + 32 + t0) < 16u) ? fmaf(p1[r], C2, b1) : NEGB; }
    } else {
#pragma unroll
      for (int r = 0; r < 16; ++r) { p0[r] = NEGB; p1[r] = NEGB; }
    }
  } else {
#pragma unroll
    for (int r = 0; r < 16; ++r) { p0[r] *= C2; p1[r] *= C2; }
  }
  float pmax = p0[0];
#pragma unroll
  for (int r = 1; r < 16; ++r) pmax = fmaxf(pmax, p0[r]);
#pragma unroll
  for (int r = 0; r < 16; ++r) pmax = fmaxf(pmax, p1[r]);
  { auto rr = __builtin_amdgcn_permlane32_swap(__float_as_uint(pmax), __float_as_uint(pmax), false, false);
    pmax = fmaxf(__uint_as_float(rr[0]), __uint_as_float(rr[1])); }
  if (__builtin_expect(__all(pmax - m_reg <= THR2), 1)) { mn = m_reg; alpha = 1.f; }
  else { mn = fmaxf(m_reg, pmax); alpha = __builtin_amdgcn_exp2f(m_reg - mn); m_reg = mn; }
#pragma unroll
  for (int r = 0; r < 16; ++r) { p0[r] -= mn; p1[r] -= mn; }
#pragma unroll
  for (int r = 0; r < 16; ++r) p0[r] = __builtin_amdgcn_exp2f(p0[r]);
}
__device__ __forceinline__ void natten_unit(const bf16* __restrict__ P, bf16* __restrict__ Y, const float* __restrict__ rpbh, long qrow0, long crow0, long wrow0, int h, int NT, bool win, int r0, int ws0, char* lds, int tid) {
  const int wid = __builtin_amdgcn_readfirstlane(tid >> 6), lane = tid & 63, r32 = lane & 31, hi = lane >> 5;
  bf16* V_lds = (bf16*)lds; bf16* K_lds = (bf16*)(lds + 2 * SHM_V);
  float* ws = (float*)(lds + 2 * SHM_V + 2 * SHM_K) + wid * 64; float* li_l = ws; float* al_l = ws + 32;
  float* tab = (float*)(lds + NAT_TAB);
  __syncthreads();
  if (win) { for (int i = tid; i < 15 * NAT_TABW; i += 512) { const int dr = i >> 7, dc = (i & 127) - 48; tab[i] = (dc >= 0 && dc <= 30) ? rpbh[dr * 31 + dc] * 1.4426950408889634f : 0.f; } }
  float m_reg = -1e30f, l_reg = 0; f32x16 o[4] = {}; bf16x8 qr[8];
  { const char* Qb = (const char*)(P + (size_t)(qrow0 + wid * 32) * NINP + PC_CQ + h * 128); const unsigned qoff = (unsigned)((r32 * NINP + hi * 8) * 2);
#pragma unroll
    for (int d0 = 0; d0 < 8; ++d0) qr[d0] = *(const GAS bf16x8*)(Qb + qoff + d0 * 32); }
  const int sr = tid >> 4, sc = (tid & 15) * 8, vst0 = v_st(sr, sc), vst1 = v_st(32 + sr, sc);
  const int vb0 = (int)(uintptr_t)V_lds + v_rd_base(lane);
  const unsigned kvoff = (unsigned)((sr * NINP + h * 128 + sc) * 2);
  const char* Pk = (const char*)(P + PC_CK); const char* Pv = (const char*)(P + PC_CV);
  const int qgr = r0 + (wid >> 1), qc = 32 * (wid & 1) + r32;
  const int rs = min(max(qgr - 4, 0), 24), cs = min(max(qc - 8, 0), 48);
  const int t0 = 4 * hi - cs; const float* tbl = tab + 63 - qc + 4 * hi;
  bf16x8 vs0, vs1, ks0, ks1;
#define TROW(t) ((t) < 4 ? crow0 + 64 * (t) : wrow0 + 64 * ((t) - 4))
#define SLOAD(t) do { const size_t rb_ = (size_t)(TROW(t)) * (NINP * 2); const char* kb_ = Pk + rb_; const char* vb_ = Pv + rb_; \
    vs0 = *(const GAS bf16x8*)(vb_ + kvoff); vs1 = *(const GAS bf16x8*)(vb_ + (size_t)32 * NINP * 2 + kvoff); \
    ks0 = *(const GAS bf16x8*)(kb_ + kvoff); ks1 = *(const GAS bf16x8*)(kb_ + (size_t)32 * NINP * 2 + kvoff); } while (0)
#define SWRITE(b) do { *(bf16x8*)((char*)V_lds + (b) * SHM_V + vst0) = vs0; *(bf16x8*)((char*)V_lds + (b) * SHM_V + vst1) = vs1; const int kc = sc * 2; \
    *(bf16x8*)((char*)K_lds + (b) * SHM_K + KSWZ(sr, kc)) = ks0; *(bf16x8*)((char*)K_lds + (b) * SHM_K + KSWZ(32 + sr, kc)) = ks1; } while (0)
#define RESC(a) do { if (__any((a) < 1.f)) { if (hi == 0) al_l[r32] = (a); asm volatile("s_waitcnt lgkmcnt(0)" ::: "memory"); \
    for (int d = 0; d < 4; ++d) for (int r = 0; r < 16; ++r) o[d][r] *= al_l[crow(r, hi)]; } } while (0)
  f32x16 p0, p1; float mn, al; bf16x8 pa0, pa1, pa2, pa3;
  SLOAD(0); asm volatile("s_waitcnt vmcnt(0)" ::: "memory"); SWRITE(0); SLOAD(1);
  for (int t = 0; t < NT; ++t) {
    const int buf = t & 1;
    asm volatile("s_waitcnt lgkmcnt(0)" ::: "memory"); __syncthreads();
    if (t + 1 < NT) { asm volatile("s_waitcnt vmcnt(0)" ::: "memory"); SWRITE(buf ^ 1); if (t + 2 < NT) SLOAD(t + 2); }
    const int kr_ = ws0 + t - 4; const bool wtile = win && t >= 4; const bool ok_ = (unsigned)(kr_ - rs) < 8u;
    if (!wtile || ok_) {
        SBAR(); qkt(p0, p1, (bf16*)((char*)K_lds + buf * SHM_K), qr, r32, hi);
        if (!wtile) partialSM<false>(p0, p1, m_reg, mn, al, true, tbl, t0);
        else { const int dr_ = min(max(kr_ - qgr + 7, 0), 14); partialSM<true>(p0, p1, m_reg, mn, al, true, tbl + dr_ * NAT_TABW, t0); }
        finishSM(p0, p1, al, l_reg, pa0, pa1, pa2, pa3); SBAR();
        RESC(al);
        pv_d0(o, vb0 + buf * (int)SHM_V, pa0, pa1, pa2, pa3);
    }
  }
  if (hi == 0) li_l[r32] = l_reg; asm volatile("s_waitcnt lgkmcnt(0)" ::: "memory");
  float rli[16];
#pragma unroll
  for (int r = 0; r < 16; ++r) rli[r] = __builtin_amdgcn_rcpf(li_l[crow(r, hi)]);
  char* Ob = (char*)(Y + (size_t)(qrow0 + wid * 32) * 1024 + h * 128); const unsigned ooff = (unsigned)((4 * hi * 1024 + r32) * 2);
#pragma unroll
  for (int r = 0; r < 16; ++r) { const int orow = (r & 3) + 8 * (r >> 2);
#pragma unroll
    for (int d0 = 0; d0 < 4; ++d0) *(GAS bf16*)(Ob + ooff + (orow * 1024 + d0 * 32) * 2) = (bf16)f2bf(o[d0][r] * rli[r]); }
  asm volatile("s_waitcnt vmcnt(0)" ::: "memory");
#undef TROW
#undef SLOAD
#undef SWRITE
#undef RESC
}
}

__device__ __forceinline__ void mixer_phase2(Frame& FF, int l, int rep) {
    Frame F = FF; F.lane = xb_lane(); F.tid = F.wave * 64 + F.lane; const int lane = F.lane, tid = F.tid;
    { const ScanBufs<128> A = bufsA(F.ws); const ScanBufs<64> B = bufsB(F.ws);
      const int gw = F.vcu * NWAVES + F.wave; const bool lastl = (l == DEPTH - 1);
      if (F.vcu < 64) scan_state_block<128>(A, F.vcu, F.wave, lane, tid, F.lds, lastl);
      else if (F.vcu < 96) scan_state_block<64>(B, F.vcu - 64, F.wave, lane, tid, F.lds, lastl); }
    const bf16* P = (const bf16*)(F.ws + WS_P); bf16* Y = (bf16*)(F.ws + WS_Y) + (size_t)2 * MT * 1024;
    const float* rpb = FIN(12) + (size_t)l * 8 * 15 * 31;
    const int total = (l == DEPTH - 1) ? 256 : 288;
    volatile LAS unsigned* slot = (volatile LAS unsigned*)(F.lds + nat::NAT_MISC);
    gu32* qhead = F.ctl + CW_QUEUE + 64 * (l + 4 * rep);
    for (;;) {
        __syncthreads();
        if (tid == 0) *slot = __hip_atomic_fetch_add(qhead, 1u, RLX_AGENT);
        __syncthreads();
        const int idx = (int)__builtin_amdgcn_readfirstlane(*slot);
        if (idx >= total) break;
        if (idx < 256) { int bh, r0;
            if (idx < 192) { bh = idx / 6; r0 = 4 + 4 * (idx % 6); } else { const int i = idx - 192; bh = i >> 1; r0 = (i & 1) ? 28 : 0; }
            const int b = bh >> 3, h = bh & 7; const int ws0 = (r0 == 0) ? 0 : (r0 == 28 ? 24 : min(r0 - 4, 20)); const int nwin = (r0 == 0 || r0 == 28) ? 8 : 12;
            nat::natten_unit(P, Y, rpb + h * 15 * 31, (long)b * 2048 + 64 * r0, (long)ML + b * 256, (long)b * 2048 + 64 * ws0, h, 4 + nwin, true, r0, ws0, (char*)F.lds, tid);
        } else { const int bh = idx - 256, b = bh >> 3, h = bh & 7;
            nat::natten_unit(P, Y, rpb, (long)ML + b * 256, (long)ML + b * 256, 0, h, 4, false, 0, 0, (char*)F.lds, tid); }
    }
}


#ifndef WGM_IN
#define WGM_IN 4
#endif
#ifndef WGM_BR
#define WGM_BR 4
#endif
#ifndef WGM_OUT
#define WGM_OUT 4
#endif
#ifndef WGM_M1
#define WGM_M1 4
#endif
#ifndef WGM_M2
#define WGM_M2 2
#endif
constexpr int NPH_PRE = 3, NPH_LAYER = 10, NPH = NPH_PRE + DEPTH * NPH_LAYER;
struct Args { const float* in[21]; float* out; unsigned char* ws; int ph_lo, ph_hi, use_bar, pad; };
__global__ void __launch_bounds__(NWAVES * 64, 2) fwd_kernel(Args args) {
    extern __shared__ __attribute__((aligned(16))) unsigned char lds[];
    Frame F;
    F.lds = (LAS unsigned char*)lds;
    F.MISC = (volatile LAS unsigned*)(F.lds + MISC_OFF);
    F.wave = __builtin_amdgcn_readfirstlane((int)threadIdx.x >> 6); F.lane = xb_lane(); F.tid = F.wave * 64 + F.lane;
    F.G = gridDim.x; { const int bx = blockIdx.x; F.vcu = (F.G % 8 == 0) ? (bx % 8) * (F.G / 8) + bx / 8 : bx; }
    F.ws = args.ws; F.ctl = (gu32*)(args.ws + WS_CTL); F.out = args.out;
    F.kin = (kin_t)__builtin_amdgcn_kernarg_segment_ptr();
    for (int u = F.tid; u < (LDS_BYTES - LDSCTL_OFF) / 4; u += NWAVES * 64) ((LAS unsigned*)(F.lds + LDSCTL_OFF))[u] = 0u;
    __syncthreads();
    const bool use_bar = args.use_bar != 0;
    XcdBarrier bar; bar.bar = (unsigned*)(F.ctl + CW_BAR); bar.x = 0; bar.st = nullptr; bar.wave = F.wave;
    if (use_bar) bar = xcd_barrier_post((unsigned*)(F.ctl + CW_BAR), F.MISC + 8);
    const int lo = args.ph_lo, hi = args.ph_hi;
#define IN(k) (lo <= (k) && (k) < hi)
#ifndef REP_KIND
#define REP_KIND -1
#endif
#define RUN(kind, ...) do { _Pragma("nounroll") for (int rep_ = 0; rep_ < ((REP_KIND == (kind)) ? 2 : 1); ++rep_) { __VA_ARGS__; } } while (0)
#define SEAM(k) do { if (IN((k) + 1)) { if (use_bar) { xcd_barrier(bar); if (REP_KIND == 9) xcd_barrier(bar); } else if (F.tid == 0) __hip_atomic_store(F.ctl + CW_TMO, 0xBADBA0u, RLX_AGENT); } } while (0)
    unsigned char* ws = args.ws;
    if (IN(0)) { RUN(0, p0_prologue(F)); SEAM(0); }
    if (IN(1)) { p0b_modreduce(F); SEAM(1); }
    if (IN(2)) { p0c_modulate(F); SEAM(2); }
    for (int l = 0; l < DEPTH; ++l) {
        const int pb = NPH_PRE + l * NPH_LAYER;
        const bool lastl = (l == DEPTH - 1);
        const int Mg = lastl ? ML : MT;
        if (IN(pb + 0)) {
            RUN(1, { pg8::Gemm g{(const bf16*)(ws + WS_H), (const bf16*)(ws + WS_WIN) + (size_t)l * NINP * 2048, MT, NINP, 2048, 0, 0, 2048, 2048}; pg8::StaticOrder S; S.init(MT, NINP, F.G, (int)blockIdx.x, WGM_IN);
            pg8::EpiBf16<0> E{(bf16*)(ws + WS_P), NINP, 0};
            pg8::gemm_phase<pg8::EpiBf16<0>, pg8::StaticOrder, true, true>(F.lds + RING_OFF, g, S, E, F.wave); });
            if (F.G == 256) convert_pocket(F, l + 1, CV_P0, CV_P1, (MT / 256) * (NINP / 256) - 9 * 256);
            SEAM(pb + 0);
        }
        if (IN(pb + 1)) { RUN(2, mixer_phase1(F, l)); SEAM(pb + 1); }
        if (IN(pb + 2)) { mixer_phase2(F, l, 0); if (REP_KIND == 3) mixer_phase2(F, l, 1); SEAM(pb + 2); }
        if (IN(pb + 3)) { RUN(4, mixer_phase3(F, l)); SEAM(pb + 3); }
        if (IN(pb + 4)) {
            RUN(5, { pg8::Gemm g{(const bf16*)(ws + WS_Y), (const bf16*)(ws + WS_WBR) + (size_t)l * 3 * 2048 * 1024, ML, 2048, 1024, (size_t)MT * 1024 * 2, (size_t)2048 * 1024 * 2, 1024, 1024}; pg8::SlabOrder<3> S; S.init(ML, 2048, F.G, (int)blockIdx.x, WGM_BR);
            pg8::EpiGate<true> E{(bf16*)(ws + WS_U), 2048, (const bf16*)(ws + WS_P) + PC_GT, NINP, 0};
            pg8::gemm_phase<pg8::EpiGate<true>, pg8::SlabOrder<3>, true, true>(F.lds + RING_OFF, g, S, E, F.wave);
            if (!lastl) { pg8::Gemm g2 = g; g2.M = MC; pg8::SplitKOrder<1, 3> S2; S2.init(MC, 2048, F.G, (int)blockIdx.x, ML / 256, 1024);
                pg8::EpiGate<false> E2{(bf16*)(ws + WS_UC) - (size_t)ML * 2048, 2048, (const bf16*)(ws + WS_P) + PC_GT, NINP, (size_t)MC * 2048};
                pg8::gemm_phase<pg8::EpiGate<false>, pg8::SplitKOrder<1, 3>, true, true>(F.lds + RING_OFF, g2, S2, E2, F.wave); } });
            if (F.G == 256 && !lastl) convert_pocket(F, l + 1, CV_P1, CV_P2, 96);
            SEAM(pb + 4);
        }
        if (IN(pb + 5)) {
            RUN(6, { pg8::Gemm g{(const bf16*)(ws + WS_U), (const bf16*)(ws + WS_WOUT) + (size_t)l * 2048 * 2048, ML, 2048, 2048, 0, 0, 2048, 2048}; pg8::StaticOrder S; S.init(ML, 2048, F.G, (int)blockIdx.x, WGM_OUT);
            pg8::EpiBf16<0> E{(bf16*)(ws + WS_MIX), 2048, 0};
            pg8::gemm_phase<pg8::EpiBf16<0>, pg8::StaticOrder, true, true>(F.lds + RING_OFF, g, S, E, F.wave);
            if (!lastl) { pg8::Gemm g2{(const bf16*)(ws + WS_UC) - (size_t)ML * 2048, (const bf16*)(ws + WS_WOUT) + (size_t)l * 2048 * 2048, MC, 2048, 1024, (size_t)MC * 2048 * 2, 0, 2048, 2048}; pg8::SplitKOrder<2, 3> S2; S2.init(MC, 2048, F.G, (int)blockIdx.x, ML / 256, 1024);
                pg8::EpiBf16<0> E2{(bf16*)(ws + WS_PART) - (size_t)ML * 2048, 2048, (size_t)MC * 2048};
                pg8::gemm_phase<pg8::EpiBf16<0>, pg8::SplitKOrder<2, 3>, true, true>(F.lds + RING_OFF, g2, S2, E2, F.wave); } });
            SEAM(pb + 5);
        }
        if (IN(pb + 6)) { if (REP_KIND == 10) ln_phase(F, l, 2, FIN(15) + l * DM, FIN(16) + l * DM, l, 3, l == 0, false, Mg, true, 6); ln_phase(F, l, 2, FIN(15) + l * DM, FIN(16) + l * DM, l, 3, l == 0, false, Mg, false, 6); SEAM(pb + 6); }
        if (IN(pb + 7)) {
            RUN(7, { pg8::Gemm g{(const bf16*)(ws + WS_H), (const bf16*)(ws + WS_WM1) + (size_t)l * 8192 * 2048, Mg, DFF, 2048, 0, 0, 2048, 2048}; pg8::StaticOrder S; S.init(Mg, DFF, F.G, (int)blockIdx.x, WGM_M1);
            pg8::EpiBf16<2> E{(bf16*)(ws + WS_HM), DFF, 0};
            pg8::gemm_phase<pg8::EpiBf16<2>, pg8::StaticOrder, true, true>(F.lds + RING_OFF, g, S, E, F.wave); });
            if (F.G == 256 && !lastl) convert_pocket(F, l + 1, CV_P2, CV_IL, 128);
            SEAM(pb + 7);
        }
        if (IN(pb + 8)) {
            RUN(8, { pg8::Gemm g{(const bf16*)(ws + WS_HM), (const bf16*)(ws + WS_WM2) + (size_t)l * 2048 * 8192, ML, 2048, DFF, 0, 0, DFF, DFF}; pg8::StaticOrder S; S.init(ML, 2048, F.G, (int)blockIdx.x, WGM_M2);
            pg8::EpiBf16<0> E{(bf16*)(ws + WS_MIX), 2048, 0};
            pg8::gemm_phase<pg8::EpiBf16<0>, pg8::StaticOrder, true, true>(F.lds + RING_OFF, g, S, E, F.wave);
            if (!lastl) { pg8::Gemm g2{(const bf16*)(ws + WS_HM), (const bf16*)(ws + WS_WM2) + (size_t)l * 2048 * 8192, MC, 2048, 1024, 0, 0, DFF, DFF}; pg8::SplitKOrder<8> S2; S2.init(MC, 2048, F.G, (int)blockIdx.x, ML / 256, 1024);
                pg8::EpiBf16<0> E2{(bf16*)(ws + WS_PART) - (size_t)ML * 2048, 2048, (size_t)MC * 2048};
                pg8::gemm_phase<pg8::EpiBf16<0>, pg8::SplitKOrder<8>, true, true>(F.lds + RING_OFF, g2, S2, E2, F.wave); } });
            SEAM(pb + 8);
        }
        if (IN(pb + 9)) { if (REP_KIND == 10) ln_phase(F, l, 5, FIN(17) + l * DM, FIN(18) + l * DM, l + 1, lastl ? -1 : 0, false, lastl, Mg, true, 8); ln_phase(F, l, 5, FIN(17) + l * DM, FIN(18) + l * DM, l + 1, lastl ? -1 : 0, false, lastl, Mg, false, 8); SEAM(pb + 9); }
    }
#undef IN
#undef SEAM
}

#ifndef MK_LAUNCHES
#define MK_LAUNCHES 1
#endif
extern "C" void kernel_launch(void* const* d_in, const int* in_sizes, int n_in, void* d_out, int out_size, void* d_ws, size_t ws_size, hipStream_t stream) {
    static int grid = 0;
    if (grid == 0) {
        if (n_in != 21 || out_size != ML * DM || ws_size < WS_END) { fprintf(stderr, "kernel_launch: unexpected shapes: n_in %d out %d ws %zu (need %zu)\n", n_in, out_size, ws_size, (size_t)WS_END); grid = -1; return; }
        int dev = 0, cus = 0, per_cu = 0;
        if (hipGetDevice(&dev) != hipSuccess || hipDeviceGetAttribute(&cus, hipDeviceAttributeMultiprocessorCount, dev) != hipSuccess) { grid = -1; return; }
        if (hipFuncSetAttribute((const void*)fwd_kernel, hipFuncAttributeMaxDynamicSharedMemorySize, LDS_BYTES) != hipSuccess) { fprintf(stderr, "kernel_launch: hipFuncSetAttribute failed\n"); grid = -1; return; }
        if (hipOccupancyMaxActiveBlocksPerMultiprocessor(&per_cu, (const void*)fwd_kernel, NWAVES * 64, LDS_BYTES) != hipSuccess || per_cu < 1) { fprintf(stderr, "kernel_launch: occupancy query reports %d\n", per_cu); }
        (void)hipGetLastError();
        grid = cus;
    }
    if (grid < 0) return;
    if (hipMemsetAsync((char*)d_ws + WS_CTL, 0, CTL_ZERO_BYTES, stream) != hipSuccess) return;
    Args a{};
    for (int i = 0; i < 21; ++i) a.in[i] = (const float*)d_in[i];
    a.out = (float*)d_out; a.ws = (unsigned char*)d_ws; a.pad = 0;
#if MK_LAUNCHES == 1
    a.ph_lo = 0; a.ph_hi = NPH; a.use_bar = 1;
    hipLaunchKernelGGL(fwd_kernel, dim3(grid), dim3(NWAVES * 64), LDS_BYTES, stream, a);
#else
    for (int p = 0; p < NPH; ++p) { a.ph_lo = p; a.ph_hi = p + 1; a.use_bar = 0; hipLaunchKernelGGL(fwd_kernel, dim3(grid), dim3(NWAVES * 64), LDS_BYTES, stream, a); }
#endif
    const hipError_t le = hipPeekAtLastError();
    if (le != hipSuccess) fprintf(stderr, "kernel_launch: launch failed: %s\n", hipGetErrorName(le));
}
```

```cpp
#define MK_LAUNCHES 1
#include <hip/hip_runtime.h>
#include <hip/hip_bf16.h>
#include <cstdio>
#include <cstdint>

namespace pg8 {
#define PG8_LAS __attribute__((address_space(3)))
typedef unsigned short bf16_t;
typedef short bf16x8 __attribute__((ext_vector_type(8)));
typedef float f32x4 __attribute__((ext_vector_type(4)));
typedef unsigned u32x4 __attribute__((ext_vector_type(4)));
constexpr int BM = 256, BK = 64, HALF = 128, HTB = HALF * BK * 2  , STAGE_BYTES = 8 * HTB, NXCD = 8, WGM = 4;

__host__ __device__ __forceinline__ int lds_byte(int r, int c) { const int st = (r >> 4) * 2 + (c >> 5), rr = r & 15, cc = c & 31, ob = rr * 64 + cc * 2; return st * 1024 + (ob ^ (((ob >> 9) & 1) << 5)); }
__host__ __device__ __forceinline__ void stage_rc(int b, int& R, int& C) { const int st = b / 1024, sb = b % 1024, swz = sb ^ (((sb >> 9) & 1) << 5); R = (st >> 1) * 16 + swz / 64; C = (st & 1) * 32 + (swz % 64) / 2; }
__host__ __device__ __forceinline__ int perm32(int rho) { const int n = rho >> 4, i = rho & 15; return 8 * (i >> 2) + 4 * n + (i & 3); }

__device__ __forceinline__ int xb_lane_pg8() { int z = 0; asm volatile("" : "+v"(z)); return (int)__builtin_amdgcn_mbcnt_hi(~0u, __builtin_amdgcn_mbcnt_lo(~0u, (unsigned)z)); }
struct Unit { int pm, pn, z, k0, zo; };
struct Gemm { const bf16_t* A; const bf16_t* Bt; int M, N, K; size_t zsA, zsB; int lda, ldb; };

struct StaticOrder {
    int nM, nN, nwg, G, c, wgm;
    __host__ __device__ void init(int M, int N, int G_, int c_, int wgm_ = WGM) { nM = M / BM; nN = N / BM; nwg = nM * nN; G = G_; c = c_; wgm = wgm_; }
    __host__ __device__ bool tile(long L, Unit& u) const {
        if (L >= nwg) return false;
        int wgid = (int)L; { const int q = nwg / NXCD, r = nwg % NXCD, xcd = wgid % NXCD, off = wgid / NXCD; wgid = (xcd < r ? xcd * (q + 1) : r * (q + 1) + (xcd - r) * q) + off; }
        const int nig = wgm * nN, gid = wgid / nig, fm = gid * wgm, gsz = (nM - fm) < wgm ? (nM - fm) : wgm;
        u.pm = fm + ((wgid % nig) % gsz); u.pn = (wgid % nig) / gsz; u.z = 0; u.k0 = 0; u.zo = 0; return true;
    }
    __host__ __device__ bool next(int i, Unit& u) const { return tile((long)i * G + c, u); }
    __device__ __forceinline__ void a_ready(const Unit&) const {}
    __device__ __forceinline__ void done(const Unit&) const {}
};
template <int NZ> struct SlabOrder : StaticOrder {
    __host__ __device__ bool next(int i, Unit& u) const { if (!tile((long)(i / NZ) * G + c, u)) return false; u.z = i % NZ; return true; }
};

template <int NS, int NZ = 1> struct SplitKOrder {
    int nM, nN, nwg, G, c, pm0, Kc;
    __host__ __device__ void init(int M, int N, int G_, int c_, int pm0_, int Kc_) { nM = M / BM; nN = N / BM; nwg = nM * nN * NS * NZ; G = G_; c = c_; pm0 = pm0_; Kc = Kc_; }
    __host__ __device__ bool next(int i, Unit& u) const { const long L = (long)i * G + c; if (L >= nwg) return false; const int t = (int)L / (NS * NZ), rem = (int)L % (NS * NZ), z = rem / NS, ks = rem % NS;
        u.pm = pm0 + t / nN; u.pn = t % nN; u.z = z; u.k0 = ks * Kc; u.zo = z * NS + ks; return true; }
    __device__ __forceinline__ void a_ready(const Unit&) const {}
    __device__ __forceinline__ void done(const Unit&) const {}
};
typedef float f32x2_t __attribute__((ext_vector_type(2))); typedef __bf16 bf16x2_t __attribute__((ext_vector_type(2)));
__device__ __forceinline__ unsigned cvt_pk_bf16(float lo, float hi) { const f32x2_t v = {lo, hi}; const bf16x2_t b = __builtin_convertvector(v, bf16x2_t); return __builtin_bit_cast(unsigned, b); }
__device__ __forceinline__ float bf_lo(unsigned w) { return __uint_as_float(w << 16); }
__device__ __forceinline__ float bf_hi(unsigned w) { return __uint_as_float(w & 0xffff0000u); }

template <int ACT  > struct EpiBf16 {
    static constexpr bool PERM = true, AFTER_DRAIN = false;
    bf16_t* O; int ldc; size_t zsO;
    __device__ __forceinline__ void operator()(const f32x4 (&acc)[2][2][4][2], const Unit& u, int wr, int wc, int fr, int fq) const {
        const int row0 = u.pm * BM + wr * 64 + fr; const int col0 = u.pn * BM + wc * 32 + 8 * fq;
#pragma unroll
        for (int ai = 0; ai < 2; ++ai)
#pragma unroll
            for (int m = 0; m < 4; ++m) { bf16_t* rowp = O + (size_t)u.zo * zsO + (size_t)(row0 + ai * HALF + m * 16) * ldc + col0;
#pragma unroll
                for (int bj = 0; bj < 2; ++bj) { f32x4 v0 = acc[ai][bj][m][0], v1 = acc[ai][bj][m][1];
                    if (ACT == 2) {
#pragma unroll
                        for (int j = 0; j < 4; ++j) { const float a = fmaxf(v0[j], 0.f), b = fmaxf(v1[j], 0.f); v0[j] = a * a; v1[j] = b * b; } }
                    u32x4 w; w.x = cvt_pk_bf16(v0[0], v0[1]); w.y = cvt_pk_bf16(v0[2], v0[3]); w.z = cvt_pk_bf16(v1[0], v1[1]); w.w = cvt_pk_bf16(v1[2], v1[3]);
                    *(u32x4*)(rowp + bj * HALF) = w; } }
    }
};
struct EpiF32 {
    static constexpr bool PERM = false, AFTER_DRAIN = false;
    float* C; int ldc; size_t zsC;
    __device__ __forceinline__ void operator()(const f32x4 (&acc)[2][2][4][2], const Unit& u, int wr, int wc, int fr, int fq) const {
        const int row0 = u.pm * BM + wr * 64 + fr, col0 = u.pn * BM + wc * 32 + 4 * fq;
#pragma unroll
        for (int ai = 0; ai < 2; ++ai)
#pragma unroll
            for (int m = 0; m < 4; ++m) { float* rowp = C + (size_t)u.zo * zsC + (size_t)(row0 + ai * HALF + m * 16) * ldc + col0;
#pragma unroll
                for (int bj = 0; bj < 2; ++bj)
#pragma unroll
                    for (int n = 0; n < 2; ++n) *(f32x4*)(rowp + bj * HALF + n * 16) = acc[ai][bj][m][n]; }
    }
};
template <bool ACCUM> struct EpiGate {
    static constexpr bool PERM = true, AFTER_DRAIN = false;
    bf16_t* U; int ldc; const bf16_t* GT; int ldg; size_t zsU;
    __device__ __forceinline__ void operator()(const f32x4 (&acc)[2][2][4][2], const Unit& u, int wr, int wc, int fr, int fq) const {
        const int row0 = u.pm * BM + wr * 64 + fr; const int col0 = u.pn * BM + wc * 32 + 8 * fq;
#pragma unroll
        for (int ai = 0; ai < 2; ++ai)
#pragma unroll
            for (int m = 0; m < 4; ++m) { const size_t row = (size_t)(row0 + ai * HALF + m * 16); bf16_t* rowp = U + (ACCUM ? (size_t)0 : (size_t)u.z * zsU) + row * ldc + col0; const bf16_t* gp = GT + row * ldg + (size_t)u.z * 2048 + col0;
#pragma unroll
                for (int bj = 0; bj < 2; ++bj) { const u32x4 gw = *(const u32x4*)(gp + bj * HALF); u32x4 pw = (u32x4){0u, 0u, 0u, 0u}; if (ACCUM && u.z > 0) pw = *(const u32x4*)(rowp + bj * HALF);
                    const f32x4 v0 = acc[ai][bj][m][0], v1 = acc[ai][bj][m][1]; const float a[8] = {v0[0], v0[1], v0[2], v0[3], v1[0], v1[1], v1[2], v1[3]};
                    float o[8];
#pragma unroll
                    for (int j = 0; j < 4; ++j) { const unsigned g2 = gw[j], p2 = pw[j];
                        const float s0 = __builtin_amdgcn_rcpf(1.f + __expf(-bf_lo(g2))), s1 = __builtin_amdgcn_rcpf(1.f + __expf(-bf_hi(g2)));
                        o[2 * j] = bf_lo(p2) + s0 * a[2 * j]; o[2 * j + 1] = bf_hi(p2) + s1 * a[2 * j + 1]; }
                    u32x4 w; w.x = cvt_pk_bf16(o[0], o[1]); w.y = cvt_pk_bf16(o[2], o[3]); w.z = cvt_pk_bf16(o[4], o[5]); w.w = cvt_pk_bf16(o[6], o[7]);
                    *(u32x4*)(rowp + bj * HALF) = w; } }
    }
};

template <class Epi, class Sched, bool ALIGN_EPI = false, bool SP2 = false>
__device__ __forceinline__ void gemm_phase(PG8_LAS unsigned char* lds, const Gemm g, const Sched& S, const Epi& E, const int wave0) {
    int tid_ = wave0 * 64 + xb_lane_pg8();
    const int tid = tid_, wid = __builtin_amdgcn_readfirstlane(tid >> 6), lane = tid & 63, wr = wid >> 2, wc = wid & 3, fr = lane & 15, fq = lane >> 4;
    const int K = g.K, nt = K / BK;
    unsigned voffA[2], voffB[2];
#pragma unroll
    for (int i = 0; i < 2; ++i) { int R, C; stage_rc(tid * 16 + i * 8192, R, C); const int Rb = Epi::PERM ? ((R & ~31) + perm32(R & 31)) : R;
        voffA[i] = (unsigned)(R * g.lda + C) * 2u; voffB[i] = (unsigned)(Rb * g.ldb + C) * 2u; }
    const size_t kstep = (size_t)(BK * 2);
    const size_t hstepA = (size_t)HALF * g.lda * 2, hstepB = (size_t)HALF * g.ldb * 2;
    const size_t tstepA = 2 * hstepA, tstepB = 2 * hstepB;
    const unsigned ldsw = (unsigned)wid * 1024u;
    const int aoff = lds_byte(wr * 64 + fr, fq * 8), boff = lds_byte(wc * 32 + fr, fq * 8);
#define PG8_SA(b, h) (((b) * 2 + (h)) * HTB)
#define PG8_SB(b, h) ((4 + (b) * 2 + (h)) * HTB)
#define PG8_STAGE(bufoff, gbase, voff) do { _Pragma("unroll") for (int _i = 0; _i < 2; ++_i) \
        __builtin_amdgcn_global_load_lds((const unsigned*)((const char*)(gbase) + (voff)[_i]), (PG8_LAS unsigned*)(lds + (bufoff) + ldsw + _i * 8192), 16, 0, 0); } while (0)
#define PG8_LDA(dst, b, h) do { _Pragma("unroll") for (int m = 0; m < 4; ++m) _Pragma("unroll") for (int k = 0; k < 2; ++k) dst[m][k] = *(const PG8_LAS bf16x8*)(lds + PG8_SA(b, h) + aoff + m * 2048 + k * 1024); } while (0)
#define PG8_LDB(dst, b, h) do { _Pragma("unroll") for (int n = 0; n < 2; ++n) _Pragma("unroll") for (int k = 0; k < 2; ++k) dst[n][k] = *(const PG8_LAS bf16x8*)(lds + PG8_SB(b, h) + boff + n * 2048 + k * 1024); } while (0)
#define PG8_MMA(ai, bj, At, Bt) do { __builtin_amdgcn_s_setprio(1); _Pragma("unroll") for (int m = 0; m < 4; ++m) _Pragma("unroll") for (int n = 0; n < 2; ++n) _Pragma("unroll") for (int k = 0; k < 2; ++k) \
        acc[ai][bj][m][n] = __builtin_amdgcn_mfma_f32_16x16x32_bf16(Bt[n][k], At[m][k], acc[ai][bj][m][n], 0, 0, 0); __builtin_amdgcn_s_setprio(0); } while (0)
#define PG8_WAIT_V(n) asm volatile("s_waitcnt vmcnt(" #n ")" ::: "memory")
#define PG8_WAIT_L(n) asm volatile("s_waitcnt lgkmcnt(" #n ")" ::: "memory")
#define PG8_BAR __builtin_amdgcn_s_barrier()
#define PG8_SCHED __builtin_amdgcn_sched_barrier(0)
    Unit cur, nxt; int ui = 0;
    if (!S.next(0, cur)) return;
    f32x4 acc[2][2][4][2];
#pragma unroll
    for (int a = 0; a < 2; ++a)
#pragma unroll
        for (int b = 0; b < 2; ++b)
#pragma unroll
            for (int m = 0; m < 4; ++m)
#pragma unroll
                for (int n = 0; n < 2; ++n) acc[a][b][m][n] = (f32x4){0.f, 0.f, 0.f, 0.f};
    bf16x8 At[4][2], B0[2][2], B1[2][2];
    const char* cA = (const char*)g.A + (size_t)cur.z * g.zsA + (size_t)cur.pm * tstepA + (size_t)cur.k0 * 2; const char* cB = (const char*)g.Bt + (size_t)cur.z * g.zsB + (size_t)cur.pn * tstepB + (size_t)cur.k0 * 2;
    S.a_ready(cur);
    if constexpr (SP2) {
        PG8_STAGE(PG8_SB(0, 0), cB, voffB); PG8_STAGE(PG8_SB(0, 1), cB + hstepB, voffB); PG8_STAGE(PG8_SA(0, 0), cA, voffA); PG8_STAGE(PG8_SA(0, 1), cA + hstepA, voffA);
        if (wr == 1) PG8_BAR;
        PG8_WAIT_V(2); PG8_BAR;
        PG8_STAGE(PG8_SB(1, 0), cB + kstep, voffB); PG8_STAGE(PG8_SA(1, 0), cA + kstep, voffA); PG8_STAGE(PG8_SB(1, 1), cB + hstepB + kstep, voffB);
        PG8_WAIT_V(6); PG8_BAR;
    } else {
        PG8_STAGE(PG8_SB(0, 0), cB, voffB); PG8_STAGE(PG8_SA(0, 0), cA, voffA); PG8_STAGE(PG8_SB(0, 1), cB + hstepB, voffB); PG8_STAGE(PG8_SA(0, 1), cA + hstepA, voffA);
        if (wr == 1) PG8_BAR;
        PG8_WAIT_V(4); PG8_BAR;
        PG8_STAGE(PG8_SB(1, 0), cB + kstep, voffB); PG8_STAGE(PG8_SA(1, 0), cA + kstep, voffA); PG8_STAGE(PG8_SB(1, 1), cB + hstepB + kstep, voffB);
        PG8_WAIT_V(6); PG8_BAR;
    }
    for (;;) {
        const bool has_next = S.next(ui + 1, nxt);
        const char* nA = has_next ? (const char*)g.A + (size_t)nxt.z * g.zsA + (size_t)nxt.pm * tstepA + (size_t)nxt.k0 * 2 : cA; const char* nB = has_next ? (const char*)g.Bt + (size_t)nxt.z * g.zsB + (size_t)nxt.pn * tstepB + (size_t)nxt.k0 * 2 : cB;
        for (int t = 0; t < nt; t += 2) {
            const bool last = (t == nt - 2);
            const char* a1 = cA + (size_t)(t + 1) * kstep;
            const char* a2 = last ? nA : cA + (size_t)(t + 2) * kstep; const char* b2 = last ? nB : cB + (size_t)(t + 2) * kstep;
            const char* a3 = a2 + kstep; const char* b3 = b2 + kstep;
            if (last && has_next) S.a_ready(nxt);
            if constexpr (SP2) {
            PG8_LDB(B0, 0, 0); PG8_LDB(B1, 0, 1); PG8_SCHED; PG8_LDA(At, 0, 0); PG8_STAGE(PG8_SA(1, 1), a1 + hstepA, voffA);
            PG8_WAIT_V(8); PG8_WAIT_L(0); PG8_BAR; PG8_MMA(0, 0, At, B0); PG8_MMA(0, 1, At, B1); PG8_BAR; PG8_SCHED;
            PG8_LDA(At, 0, 1); PG8_STAGE(PG8_SB(0, 0), b2, voffB); PG8_STAGE(PG8_SB(0, 1), b2 + hstepB, voffB); PG8_STAGE(PG8_SA(0, 0), a2, voffA);
            PG8_WAIT_V(8); PG8_WAIT_L(0); PG8_BAR; PG8_MMA(1, 0, At, B0); PG8_MMA(1, 1, At, B1); PG8_BAR; PG8_SCHED;
            PG8_LDB(B0, 1, 0); PG8_LDB(B1, 1, 1); PG8_SCHED; PG8_LDA(At, 1, 0); PG8_STAGE(PG8_SA(0, 1), a2 + hstepA, voffA);
            PG8_WAIT_V(8); PG8_WAIT_L(0); PG8_BAR; PG8_MMA(0, 0, At, B0); PG8_MMA(0, 1, At, B1); PG8_BAR; PG8_SCHED;
            PG8_LDA(At, 1, 1); PG8_STAGE(PG8_SB(1, 0), b3, voffB); PG8_STAGE(PG8_SB(1, 1), b3 + hstepB, voffB); PG8_STAGE(PG8_SA(1, 0), a3, voffA);
            PG8_WAIT_V(8); PG8_WAIT_L(0); PG8_BAR; PG8_MMA(1, 0, At, B0); PG8_MMA(1, 1, At, B1); PG8_BAR; PG8_SCHED;
            } else {
            PG8_LDB(B0, 0, 0); PG8_SCHED; PG8_LDA(At, 0, 0); PG8_STAGE(PG8_SA(1, 1), a1 + hstepA, voffA);
            PG8_WAIT_L(8); PG8_BAR; PG8_WAIT_L(0); PG8_MMA(0, 0, At, B0); PG8_BAR; PG8_SCHED;
            PG8_LDB(B1, 0, 1); PG8_STAGE(PG8_SB(0, 0), b2, voffB);
            PG8_BAR; PG8_WAIT_L(0); PG8_MMA(0, 1, At, B1); PG8_BAR;
            PG8_LDA(At, 0, 1); PG8_STAGE(PG8_SA(0, 0), a2, voffA);
            PG8_BAR; PG8_WAIT_L(0); PG8_MMA(1, 0, At, B0); PG8_BAR; PG8_SCHED;
            PG8_STAGE(PG8_SB(0, 1), b2 + hstepB, voffB);
            PG8_WAIT_V(6); PG8_BAR; PG8_MMA(1, 1, At, B1); PG8_BAR;
            PG8_LDB(B0, 1, 0); PG8_SCHED; PG8_LDA(At, 1, 0); PG8_STAGE(PG8_SA(0, 1), a2 + hstepA, voffA);
            PG8_WAIT_L(8); PG8_BAR; PG8_WAIT_L(0); PG8_MMA(0, 0, At, B0); PG8_BAR; PG8_SCHED;
            PG8_LDB(B1, 1, 1); PG8_STAGE(PG8_SB(1, 0), b3, voffB);
            PG8_BAR; PG8_WAIT_L(0); PG8_MMA(0, 1, At, B1); PG8_BAR;
            PG8_LDA(At, 1, 1); PG8_STAGE(PG8_SA(1, 0), a3, voffA);
            PG8_BAR; PG8_WAIT_L(0); PG8_MMA(1, 0, At, B0); PG8_BAR; PG8_SCHED;
            PG8_STAGE(PG8_SB(1, 1), b3 + hstepB, voffB);
            PG8_WAIT_V(6); PG8_BAR; PG8_MMA(1, 1, At, B1); PG8_BAR;
            }
        }
        if constexpr (ALIGN_EPI) { if (wr == 0) PG8_BAR; }
        if constexpr (!Epi::AFTER_DRAIN) { E(acc, cur, wr, wc, fr, fq); S.done(cur); }
        if (!has_next) break;
#pragma unroll
        for (int a = 0; a < 2; ++a)
#pragma unroll
            for (int b = 0; b < 2; ++b)
#pragma unroll
                for (int m = 0; m < 4; ++m)
#pragma unroll
                    for (int n = 0; n < 2; ++n) acc[a][b][m][n] = (f32x4){0.f, 0.f, 0.f, 0.f};
        cur = nxt; cA = nA; cB = nB; ++ui;
        if constexpr (ALIGN_EPI) { if (wr == 1) PG8_BAR; }
    }
    PG8_WAIT_V(0);
    if constexpr (!ALIGN_EPI) { if (wr == 0) PG8_BAR; }
    PG8_BAR;
    if constexpr (Epi::AFTER_DRAIN) { E.fused(acc, cur, wr, wc, fr, fq, lds, wid, lane); S.done(cur); }
#undef PG8_SA
#undef PG8_SB
#undef PG8_STAGE
#undef PG8_LDA
#undef PG8_LDB
#undef PG8_MMA
#undef PG8_WAIT_V
#undef PG8_WAIT_L
#undef PG8_BAR
#undef PG8_SCHED
}
}

constexpr int DM = 2048, NB = 4, SEQ = 2048, DEPTH = 4, GW = 64, CTXL = 256, DFF = 8192;
constexpr int ML = NB * SEQ, MC = NB * CTXL, MT = ML + MC;
constexpr int NIN = 17440, NINP = 17664;
constexpr int NHEAD = 8;
constexpr float LN_EPS = 1e-5f, RMS_EPS = 1e-6f;
constexpr float DN_ALPHA = 1.6817928305074290f;
constexpr int PC_AQ = 0, PC_AI = 1024, PC_AG = 2048, PC_AFF = 3072, PC_AFB = 4096, PC_BQ = 5120, PC_BK = 5632, PC_BV = 6144, PC_BG = 7168,
              PC_CQ = 8192, PC_CK = 9216, PC_CV = 10240, PC_GT = 11264, PC_GK = 17408;
__host__ __device__ __forceinline__ int in_src_col(int n) { return n < 8192 ? n : (n < 17408 ? n + 32 : (n < 17440 ? 8192 + (n - 17408) : -1)); }

constexpr size_t MiB = 1u << 20;
constexpr size_t WS_CTL = 0, CTL_ZERO_BYTES = 1 * MiB;
constexpr size_t WS_MODP = 1 * MiB;
constexpr size_t WS_MOD = WS_MODP + 16 * MiB;
constexpr size_t WS_TAB = WS_MOD + 1 * MiB;
constexpr size_t TAB_LB = 0, TAB_RR = 32768, TAB_RC = 32768 + 4096;
constexpr size_t WS_WIN = WS_TAB + 1 * MiB;
constexpr size_t WS_WBR = WS_WIN + 277 * MiB;
constexpr size_t WS_WOUT = WS_WBR + 48 * MiB;
constexpr size_t WS_WM1 = WS_WOUT + 32 * MiB;
constexpr size_t WS_WM2 = WS_WM1 + 128 * MiB;
constexpr size_t WS_XS = WS_WM2 + 128 * MiB;
constexpr size_t WS_H = WS_XS + 72 * MiB;
constexpr size_t WS_P = WS_H + 36 * MiB;
constexpr size_t WS_Y = WS_P + 311 * MiB;
constexpr size_t WS_U = WS_Y + 54 * MiB;
constexpr size_t WS_MIX = WS_U + 36 * MiB;
constexpr size_t WS_HM = WS_MIX + 72 * MiB;
constexpr size_t WS_SCAN = WS_HM + 144 * MiB;
constexpr size_t WS_PART = WS_SCAN + 400 * MiB;
constexpr size_t WS_UC = WS_PART + 96 * MiB;
constexpr size_t WS_END = WS_UC + 12 * MiB;
static_assert((size_t)4 * NINP * 2048 * 2 <= 277 * MiB && (size_t)MT * NINP * 2 <= 311 * MiB, "ws map");

constexpr int RING_OFF = 0, RING_BYTES = 131072;
constexpr int LDS_BYTES = 163840;
constexpr int LDSCTL_OFF = LDS_BYTES - 1024, MISC_OFF = LDSCTL_OFF + 320;
constexpr int NWAVES = 8;

#define GAS __attribute__((address_space(1)))
#define LAS __attribute__((address_space(3)))
typedef unsigned short bf16;
typedef unsigned v4u __attribute__((ext_vector_type(4)));
typedef unsigned v2u __attribute__((ext_vector_type(2)));
typedef float f32x4 __attribute__((ext_vector_type(4)));
typedef float f32x2 __attribute__((ext_vector_type(2)));
typedef short bf16x8 __attribute__((ext_vector_type(8)));
typedef GAS unsigned gu32;
#define RLX_AGENT __ATOMIC_RELAXED, __HIP_MEMORY_SCOPE_AGENT
#define LDS_WAIT() asm volatile("s_waitcnt lgkmcnt(0)" ::: "memory")
#define VM_WAIT() asm volatile("s_waitcnt vmcnt(0)" ::: "memory")
typedef float f32x2_t __attribute__((ext_vector_type(2))); typedef __bf16 bf16x2_t __attribute__((ext_vector_type(2)));
__device__ __forceinline__ unsigned pk2(float lo, float hi) { const f32x2_t v = {lo, hi}; const bf16x2_t b = __builtin_convertvector(v, bf16x2_t); return __builtin_bit_cast(unsigned, b); }
__device__ __forceinline__ unsigned f2bf(float f) { return pk2(f, 0.f) & 0xffffu; }
__device__ __forceinline__ float bflo(unsigned w) { return __uint_as_float(w << 16); }
__device__ __forceinline__ float bfhi(unsigned w) { return __uint_as_float(w & 0xffff0000u); }
__device__ __forceinline__ float bf2f(bf16 h) { return __uint_as_float(((unsigned)h) << 16); }
__device__ __forceinline__ float sigmoidf_(float x) { return __builtin_amdgcn_rcpf(1.f + __expf(-x)); }
__device__ __forceinline__ float wave_sum(float v) {
#pragma unroll
    for (int o = 1; o < 64; o <<= 1) v += __shfl_xor(v, o);
    return v;
}
constexpr int CW_TMO = 0, CW_CODE = 1, CW_BAR = 4096, CW_QUEUE = 16384;

#define XB_TMO      128
#define XB_XCNT(j)  (256  + 64 * (j))
#define XB_XSUB(j)  (1280 + 64 * (j))
#define XB_XGEN(j)  (2304 + 64 * (j))
#define XB_TOP      3328
#define XB_TOPGEN   3392
#define XCD_BAR_WORDS 3456
#define XB_SPIN_CAP (1u << 18)

__device__ __forceinline__ unsigned xb_ld(unsigned* p)              { return __hip_atomic_load(p, __ATOMIC_RELAXED, __HIP_MEMORY_SCOPE_AGENT); }
__device__ __forceinline__ unsigned xb_add(unsigned* p, unsigned v) { return __hip_atomic_fetch_add(p, v, __ATOMIC_RELAXED, __HIP_MEMORY_SCOPE_AGENT); }
__device__ __forceinline__ unsigned xb_xcc_id() { return (unsigned)__builtin_amdgcn_s_getreg((3 << 11) | 20) & 0xFu; }
#define XB_SPIN(cond, bar) do { unsigned _sp = 0; while (cond) { __builtin_amdgcn_s_sleep(1); \
    if ((++_sp & 255u) == 0u) { if (xb_ld(&(bar)[XB_TMO])) break; if (_sp > XB_SPIN_CAP) { atomicAdd(&(bar)[XB_TMO], 1u); break; } } } } while (0)

__device__ __forceinline__ int xb_lane() { int z = 0; asm volatile("" : "+v"(z)); return (int)__builtin_amdgcn_mbcnt_hi(~0u, __builtin_amdgcn_mbcnt_lo(~0u, (unsigned)z)); }
struct XcdBarrier {
    unsigned* bar; unsigned x;
    int wave;
    volatile LAS unsigned* st;
};

__device__ __forceinline__ XcdBarrier xcd_barrier_post(unsigned* bar, volatile LAS unsigned* st) {
    XcdBarrier b; b.bar = bar; b.x = xb_xcc_id(); b.st = st; b.wave = __builtin_amdgcn_readfirstlane((int)threadIdx.x >> 6);
    if (threadIdx.x == 0) (void)xb_add(&bar[XB_XCNT(b.x)], 1u);
    return b;
}
__device__ __forceinline__ void xcd_barrier_complete(unsigned* bar, unsigned x, unsigned& nloc, unsigned& nx) {
    const unsigned G = gridDim.x * gridDim.y * gridDim.z;
    unsigned sum, cnt, mine, sp = 0u;
    for (;;) {
        sum = 0u; cnt = 0u; mine = 0u;
#pragma unroll
        for (unsigned j = 0; j < 16; ++j) { const unsigned c = xb_ld(&bar[XB_XCNT(j)]); sum += c; cnt += (c > 0u) ? 1u : 0u; mine = (j == x) ? c : mine; }
        if (sum == G) break;
        __builtin_amdgcn_s_sleep(1);
        if ((++sp & 255u) == 0u) { if (xb_ld(&bar[XB_TMO])) break; if (sp > XB_SPIN_CAP) { atomicAdd(&bar[XB_TMO], 1u); break; } }
    }
    nloc = mine > 0u ? mine : 1u; nx = cnt > 0u ? cnt : 1u;
}

__device__ __forceinline__ void xcd_barrier(const XcdBarrier& b) {
    asm volatile("s_waitcnt vmcnt(0)" ::: "memory");
    __syncthreads();
    if (b.wave == 0 && xb_lane() == 0) {
        unsigned* bar = b.bar;
        __builtin_amdgcn_s_waitcnt(0);
        unsigned nloc = b.st[0], nx = b.st[1];
        if (nloc == 0u) { xcd_barrier_complete(bar, b.x, nloc, nx); b.st[0] = nloc; b.st[1] = nx; }
        const unsigned old = xb_add(&bar[XB_XSUB(b.x)], 1u);
        const unsigned gen = old / nloc;
        if (old + 1u == (gen + 1u) * nloc) {
            __builtin_amdgcn_fence(__ATOMIC_RELEASE, "agent");
            asm volatile("s_waitcnt vmcnt(0)" ::: "memory");
            const unsigned og = xb_add(&bar[XB_TOP], 1u);
            const unsigned tg = og / nx;
            if (og + 1u == (tg + 1u) * nx) xb_add(&bar[XB_TOPGEN], 1u);
            else XB_SPIN(xb_ld(&bar[XB_TOPGEN]) == tg, bar);
            __builtin_amdgcn_fence(__ATOMIC_ACQUIRE, "agent");
            xb_add(&bar[XB_XGEN(b.x)], 1u);
            asm volatile("s_waitcnt vmcnt(0)" ::: "memory");
        } else {
            XB_SPIN(xb_ld(&bar[XB_XGEN(b.x)]) == gen, bar);
            __builtin_amdgcn_fence(__ATOMIC_ACQUIRE, "agent");
            asm volatile("s_waitcnt vmcnt(0)" ::: "memory");
        }
    }
    __syncthreads();
}


typedef const float* cfp_t; typedef __attribute__((address_space(4))) const cfp_t* kin_t;
__device__ __forceinline__ kin_t kin_launder(kin_t p) { asm volatile("" : "+s"(p)); return p; }
#define FIN(k) (kin_launder(F.kin)[k])
struct Frame {
    LAS unsigned char* lds;
    volatile LAS unsigned* MISC;
    gu32* ctl;
    int tid, lane, wave;
    int vcu, G;
    unsigned char* ws;
    kin_t kin;
    float* out;
};

__device__ __forceinline__ void p0_transpose_item(const float* W, int ldw, int src_col0, int k0, bf16* WT, int K, int dst_row0, LAS float* scr, int lane) {
    const int kr = lane >> 3, nc = lane & 7;
    f32x4 v[8];
    if (src_col0 >= 0) { const float* wp = W + (size_t)(k0 + kr) * ldw + src_col0 + 4 * nc;
#pragma unroll
        for (int i = 0; i < 8; ++i) v[i] = *(const GAS f32x4*)(wp + (size_t)(8 * i) * ldw);
    } else {
#pragma unroll
        for (int i = 0; i < 8; ++i) v[i] = (f32x4){0.f, 0.f, 0.f, 0.f};
    }
#pragma unroll
    for (int i = 0; i < 8; ++i) { LAS float* d = scr + (8 * i + kr) * 33 + 4 * nc; d[0] = v[i][0]; d[1] = v[i][1]; d[2] = v[i][2]; d[3] = v[i][3]; }
    LDS_WAIT(); asm volatile("" ::: "memory");
    const int c = lane & 7;
#pragma unroll
    for (int j = 0; j < 4; ++j) { const int n = (lane >> 3) + 8 * j; const LAS float* s = scr + (8 * c) * 33 + n;
        v4u o; o.x = pk2(s[0 * 33], s[1 * 33]); o.y = pk2(s[2 * 33], s[3 * 33]); o.z = pk2(s[4 * 33], s[5 * 33]); o.w = pk2(s[6 * 33], s[7 * 33]);
        *(GAS v4u*)(WT + (size_t)(dst_row0 + n) * K + k0 + 8 * c) = o; }
    LDS_WAIT(); asm volatile("" ::: "memory");
}
constexpr int CV_IIN = 32 * (NINP / 32), CV_IBR = 3 * 16 * 64, CV_IOUT = 32 * 64, CV_IM1 = 32 * 256, CV_IM2 = 128 * 64, CV_IL = CV_IIN + CV_IBR + CV_IOUT + CV_IM1 + CV_IM2;
constexpr int CV_P0 = 11168, CV_P1 = 18168, CV_P2 = 27168;
__device__ __forceinline__ void convert_items(Frame& F, int l, int r_lo, int r_hi, int widx, int nw) {
    LAS float* scr = (LAS float*)(F.lds + RING_OFF + F.wave * 8448); const int lane = xb_lane();
    for (int it = r_lo + widx; it < r_hi; it += nw) { int r = it;
        if (r < CV_IIN) { const int nbk = NINP / 32, kb = r / nbk, nb = r % nbk; p0_transpose_item(FIN(6) + (size_t)l * 2048 * NIN, NIN, in_src_col(32 * nb), 64 * kb, (bf16*)(F.ws + WS_WIN) + (size_t)l * NINP * 2048, 2048, 32 * nb, scr, lane); continue; } r -= CV_IIN;
        if (r < CV_IBR) { const int n = r / 1024, rr = r % 1024, kb = rr / 64, nb = rr % 64; p0_transpose_item(FIN(13) + (size_t)(l * 3 + n) * 1024 * 2048, 2048, 32 * nb, 64 * kb, (bf16*)(F.ws + WS_WBR) + (size_t)(l * 3 + n) * 2048 * 1024, 1024, 32 * nb, scr, lane); continue; } r -= CV_IBR;
        if (r < CV_IOUT) { const int kb = r / 64, nb = r % 64; p0_transpose_item(FIN(14) + (size_t)l * 2048 * 2048, 2048, 32 * nb, 64 * kb, (bf16*)(F.ws + WS_WOUT) + (size_t)l * 2048 * 2048, 2048, 32 * nb, scr, lane); continue; } r -= CV_IOUT;
        if (r < CV_IM1) { const int kb = r / 256, nb = r % 256; p0_transpose_item(FIN(19) + (size_t)l * 2048 * 8192, 8192, 32 * nb, 64 * kb, (bf16*)(F.ws + WS_WM1) + (size_t)l * 8192 * 2048, 2048, 32 * nb, scr, lane); continue; } r -= CV_IM1;
        { const int kb = r / 64, nb = r % 64; p0_transpose_item(FIN(20) + (size_t)l * 8192 * 2048, 2048, 32 * nb, 64 * kb, (bf16*)(F.ws + WS_WM2) + (size_t)l * 2048 * 8192, 8192, 32 * nb, scr, lane); }
    }
}
__device__ __forceinline__ void convert_pocket(Frame& F, int lnext, int r_lo, int r_hi, int first_idle) {
    const int c = (int)blockIdx.x; if (lnext >= DEPTH || c < first_idle) return;
    convert_items(F, lnext, r_lo, r_hi, (c - first_idle) * NWAVES + F.wave, ((int)gridDim.x - first_idle) * NWAVES);
}
__device__ __forceinline__ void p0_prologue(Frame& FF) {
    Frame F = FF; F.lane = xb_lane(); F.tid = F.wave * 64 + F.lane;
    LAS float* scr = (LAS float*)(F.lds + RING_OFF + F.wave * 8448);
    LAS float* sil = (LAS float*)(F.lds + RING_OFF + 69632);
    const int gw = F.vcu * NWAVES + F.wave, NGW = F.G * NWAVES;
    for (int i = F.tid; i < 5 * 2048; i += NWAVES * 64) { const int b = i >> 11, k = i & 2047; const float v = (b < 4) ? FIN(1)[b * 2048 + k] : FIN(3)[k]; sil[i] = v * sigmoidf_(v); }
    { float* LB = (float*)(F.ws + WS_TAB + TAB_LB);
      for (int i = gw * 64 + F.lane; i < 2048; i += NGW * 64) { float e[4], mx = -1e30f;
#pragma unroll
          for (int l = 0; l < 4; ++l) { e[l] = FIN(7)[l * 2048 + i]; mx = fmaxf(mx, e[l]); }
          float s = 0.f;
#pragma unroll
          for (int l = 0; l < 4; ++l) { e[l] = expf(e[l] - mx); s += e[l]; }
          const float inv = 1.f / s; float cum = 0.f;
#pragma unroll
          for (int l = 0; l < 4; ++l) { LB[l * 2048 + i] = cum; cum += e[l] * inv; } }
      f32x2* RR = (f32x2*)(F.ws + WS_TAB + TAB_RR); f32x2* RC = (f32x2*)(F.ws + WS_TAB + TAB_RC);
      for (int i = gw * 64 + F.lane; i < 96 * 16; i += NGW * 64) { const int p = i >> 4, j = i & 15; const int pos = p < 32 ? p : p - 32;
          const float fr = expf(-(float)j * (9.210340371976184f / 16.f)); const float ang = (float)pos * fr; const f32x2 cs = {cosf(ang), sinf(ang)};
          if (p < 32) RR[p * 16 + j] = cs; else RC[(p - 32) * 16 + j] = cs; } }
    __syncthreads();
    for (int u = gw; u < 3072; u += NGW) { const int l = u / 768, r = u % 768, cb = r >> 4, ks = r & 15; const int c0 = cb * 256 + 4 * F.lane;
        f32x4 acc[5];
#pragma unroll
        for (int b = 0; b < 5; ++b) acc[b] = (f32x4){0.f, 0.f, 0.f, 0.f};
        const float* wp = FIN(4) + ((size_t)l * 2048 + ks * 128) * 12288 + c0;
#pragma unroll 8
        for (int k = 0; k < 128; ++k) { const f32x4 w = *(const GAS f32x4*)(wp + (size_t)k * 12288);
#pragma unroll
            for (int b = 0; b < 5; ++b) acc[b] += w * sil[b * 2048 + ks * 128 + k]; }
        float* mp = (float*)(F.ws + WS_MODP) + ((size_t)(ks * 4 + l) * 5) * 12288 + c0;
#pragma unroll
        for (int b = 0; b < 5; ++b) *(GAS f32x4*)(mp + (size_t)b * 12288) = acc[b]; }
    convert_items(F, 0, 0, CV_IL, gw, NGW);
    for (int l = 1; l < DEPTH; ++l) convert_items(F, l, 0, F.G == 256 ? CV_P0 : CV_IL, gw, NGW);
}
__device__ __forceinline__ void p0b_modreduce(Frame& FF) {
    Frame F = FF; F.lane = xb_lane(); F.tid = F.wave * 64 + F.lane;
    const float* mp = (const float*)(F.ws + WS_MODP); float* mo = (float*)(F.ws + WS_MOD);
    for (int i = (F.vcu * NWAVES + F.wave) * 64 + F.lane; i < 4 * 5 * 12288; i += F.G * NWAVES * 64) { const int l = i / (5 * 12288), c = i % 12288;
        float s = FIN(5)[l * 12288 + c];
#pragma unroll
        for (int ks = 0; ks < 16; ++ks) s += mp[(size_t)ks * (4 * 5 * 12288) + i];
        mo[i] = s; }
}
__device__ __forceinline__ int row_modb(int row) { return row < ML ? (row >> 11) : 4; }
__device__ __forceinline__ const float* row_input(const Frame& F, int row) { return row < ML ? FIN(0) + (size_t)row * DM : FIN(2) + (size_t)(row - ML) * DM; }
__device__ __forceinline__ void store_modulated(const f32x4 (&v)[8], const float* sc, const float* sh, bf16* hrow, int lane) {
#pragma unroll
    for (int j = 0; j < 8; ++j) { const int c = 4 * lane + 256 * j; const f32x4 s = *(const GAS f32x4*)(sc + c), t = *(const GAS f32x4*)(sh + c);
        const f32x4 o = v[j] * (s + 1.0f) + t; v2u w; w.x = pk2(o[0], o[1]); w.y = pk2(o[2], o[3]); *(GAS v2u*)(hrow + c) = w; }
}
__device__ __forceinline__ void p0c_modulate(Frame& FF) {
    Frame F = FF; F.lane = xb_lane(); F.tid = F.wave * 64 + F.lane;
    const float* mo = (const float*)(F.ws + WS_MOD); bf16* H = (bf16*)(F.ws + WS_H);
    for (int row = F.vcu * NWAVES + F.wave; row < MT; row += F.G * NWAVES) { const float* xr = row_input(F, row); const float* mb = mo + (size_t)row_modb(row) * 12288;
        f32x4 v[8];
#pragma unroll
        for (int j = 0; j < 8; ++j) v[j] = *(const GAS f32x4*)(xr + 4 * F.lane + 256 * j);
        store_modulated(v, mb + 1 * 2048, mb + 0 * 2048, H + (size_t)row * DM, F.lane); }
}
__device__ __forceinline__ void ln_rows(Frame& F, const float* xbase, const float* mixbase, int nslab, float* obase, bf16* hbase, int row0, int nr, bool hm, LAS float* V, int lane, int wave) {
    f32x4 xn[8], mn[8];
    const bool part = nslab > 0;
    const unsigned ol = (unsigned)(16 * lane);
#define LN_UB(p) ([&]() -> const char* { const char* b_ = (const char*)(p); asm volatile("" : "+s"(b_)); return b_; }())
#define LN_LOAD(row) do { const char* xr_ = LN_UB(xbase + (size_t)(row) * DM); _Pragma("unroll") for (int j = 0; j < 8; ++j) xn[j] = *(const GAS f32x4*)(xr_ + ol + 1024 * j); \
        if (!part) { const char* mr_ = LN_UB((const bf16*)mixbase + (size_t)(row) * DM); _Pragma("unroll") for (int j = 0; j < 8; ++j) { const v2u w_ = *(const GAS v2u*)(mr_ + (ol >> 1) + 512 * j); mn[j] = (f32x4){bflo(w_.x), bfhi(w_.x), bflo(w_.y), bfhi(w_.y)}; } } \
        else { const bf16* pr0_ = (const bf16*)mixbase + (size_t)((row) - ML) * DM; _Pragma("unroll") for (int j = 0; j < 8; ++j) mn[j] = (f32x4){0.f, 0.f, 0.f, 0.f}; \
            _Pragma("nounroll") for (int ks = 0; ks < nslab; ++ks) { const char* ps_ = LN_UB(pr0_ + (size_t)ks * MC * DM); _Pragma("unroll") for (int j = 0; j < 8; ++j) { const v2u w_ = *(const GAS v2u*)(ps_ + (ol >> 1) + 512 * j); mn[j] += (f32x4){bflo(w_.x), bfhi(w_.x), bflo(w_.y), bfhi(w_.y)}; } } } } while (0)
    if (nr > 0) LN_LOAD(row0 + wave);
    for (int i = 0; i < nr; ++i) { const int row = row0 + wave + 8 * i;
        f32x4 v[8]; float s = 0.f;
#pragma unroll
        for (int j = 0; j < 8; ++j) { const f32x4 g = *(const LAS f32x4*)(V + 0 * 2048 + 4 * lane + 256 * j); v[j] = xn[j] * DN_ALPHA + g * mn[j]; s += (v[j][0] + v[j][1]) + (v[j][2] + v[j][3]); }
        __builtin_amdgcn_sched_barrier(0);
        if (i + 1 < nr) LN_LOAD(row + 8);
        __builtin_amdgcn_sched_barrier(0);
        const float mean = wave_sum(s) * (1.f / DM); float q = 0.f;
#pragma unroll
        for (int j = 0; j < 8; ++j) { v[j] = v[j] - mean; q += (v[j][0] * v[j][0] + v[j][1] * v[j][1]) + (v[j][2] * v[j][2] + v[j][3] * v[j][3]); }
        const float rstd = 1.0f / sqrtf(wave_sum(q) * (1.f / DM) + LN_EPS);
        char* orow = (char*)(obase + (size_t)row * DM) + ol; char* hrow = (char*)(hbase + (size_t)row * DM) + (ol >> 1);
#pragma unroll
        for (int j = 0; j < 8; ++j) { const f32x4 g = *(const LAS f32x4*)(V + 1 * 2048 + 4 * lane + 256 * j), b = *(const LAS f32x4*)(V + 2 * 2048 + 4 * lane + 256 * j);
            v[j] = v[j] * rstd * g + b; *(GAS f32x4*)(orow + 1024 * j) = v[j];
            if (hm) { const f32x4 sc = *(const LAS f32x4*)(V + 3 * 2048 + 4 * lane + 256 * j), sh = *(const LAS f32x4*)(V + 4 * 2048 + 4 * lane + 256 * j); const f32x4 o = v[j] * sc + sh;
                v2u w; w.x = pk2(o[0], o[1]); w.y = pk2(o[2], o[3]); *(GAS v2u*)(hrow + 512 * j) = w; }
            if (j & 1) __builtin_amdgcn_sched_barrier(0); }
    }
#undef LN_LOAD
#undef LN_UB
}
__device__ __forceinline__ void ln_phase(Frame& FF, int l, int gi, const float* lng, const float* lnb, int lh, int hmod, bool first, bool to_out, int nrows, bool dry, int nslab) {
    Frame F = FF; F.lane = xb_lane(); F.tid = F.wave * 64 + F.lane;
    const float* mo = (const float*)(F.ws + WS_MOD); float* XS = (float*)(F.ws + WS_XS); const float* MIX = (const float*)(F.ws + WS_MIX); bf16* H = dry ? (bf16*)(F.ws + WS_HM + 72 * MiB) : (bf16*)(F.ws + WS_H);
    LAS float* V = (LAS float*)(F.lds + RING_OFF);
    if (F.G != 256) {
        for (int row = F.vcu * NWAVES + F.wave; row < nrows; row += F.G * NWAVES) { const int mb = row_modb(row);
            const float* xr = first ? row_input(F, row) : XS + (size_t)row * DM; const float* gv = mo + ((size_t)l * 5 + mb) * 12288 + gi * 2048;
            f32x4 v[8]; float s = 0.f;
#pragma unroll
            for (int j = 0; j < 8; ++j) { const int c = 4 * F.lane + 256 * j; const f32x4 xv = *(const GAS f32x4*)(xr + c), g = *(const GAS f32x4*)(gv + c); f32x4 mv;
                if (row < ML) { const v2u w_ = *(const GAS v2u*)((const bf16*)MIX + (size_t)row * DM + c); mv = (f32x4){bflo(w_.x), bfhi(w_.x), bflo(w_.y), bfhi(w_.y)}; }
                else { const bf16* pr = (const bf16*)(F.ws + WS_PART) + (size_t)(row - ML) * DM + c; mv = (f32x4){0.f, 0.f, 0.f, 0.f}; for (int ks = 0; ks < nslab; ++ks) { const v2u w_ = *(const GAS v2u*)(pr + (size_t)ks * MC * DM); mv += (f32x4){bflo(w_.x), bfhi(w_.x), bflo(w_.y), bfhi(w_.y)}; } }
                v[j] = xv * DN_ALPHA + g * mv; s += (v[j][0] + v[j][1]) + (v[j][2] + v[j][3]); }
            const float mean = wave_sum(s) * (1.f / DM); float q = 0.f;
#pragma unroll
            for (int j = 0; j < 8; ++j) { v[j] = v[j] - mean; q += (v[j][0] * v[j][0] + v[j][1] * v[j][1]) + (v[j][2] * v[j][2] + v[j][3] * v[j][3]); }
            const float rstd = 1.0f / sqrtf(wave_sum(q) * (1.f / DM) + LN_EPS);
            float* orow = dry ? (float*)(F.ws + WS_HM) + (size_t)row * DM : (to_out ? F.out + (size_t)row * DM : XS + (size_t)row * DM);
#pragma unroll
            for (int j = 0; j < 8; ++j) { const int c = 4 * F.lane + 256 * j; const f32x4 g = *(const GAS f32x4*)(lng + c), b = *(const GAS f32x4*)(lnb + c); v[j] = v[j] * rstd * g + b; *(GAS f32x4*)(orow + c) = v[j]; }
            if (hmod >= 0) { const float* mh = mo + ((size_t)lh * 5 + mb) * 12288; store_modulated(v, mh + (hmod + 1) * 2048, mh + hmod * 2048, H + (size_t)row * DM, F.lane); } }
        return;
    }
    float* obase = dry ? (float*)(F.ws + WS_HM) : (to_out ? F.out : XS);
#pragma unroll 1
    for (int seg = 0; seg < 2; ++seg) {
        if (seg == 1 && nrows <= ML) break;
        const int mb = seg == 0 ? (F.vcu >> 6) : 4;
        __syncthreads();
        { const float* gv = mo + ((size_t)l * 5 + mb) * 12288 + gi * 2048; const float* mh = mo + ((size_t)(hmod >= 0 ? lh : l) * 5 + mb) * 12288; const int c = 4 * F.tid;
          *(LAS f32x4*)(V + 0 * 2048 + c) = *(const GAS f32x4*)(gv + c); *(LAS f32x4*)(V + 1 * 2048 + c) = *(const GAS f32x4*)(lng + c); *(LAS f32x4*)(V + 2 * 2048 + c) = *(const GAS f32x4*)(lnb + c);
          if (hmod >= 0) { *(LAS f32x4*)(V + 3 * 2048 + c) = *(const GAS f32x4*)(mh + (hmod + 1) * 2048 + c) + 1.0f; *(LAS f32x4*)(V + 4 * 2048 + c) = *(const GAS f32x4*)(mh + hmod * 2048 + c); } }
        LDS_WAIT(); __syncthreads();
        if (seg == 0) ln_rows(F, first ? FIN(0) : XS, MIX, 0, obase, H, 32 * F.vcu, 4, hmod >= 0, V, F.lane, F.wave);
        else ln_rows(F, first ? FIN(2) - (size_t)ML * DM : XS, (const float*)(F.ws + WS_PART), nslab, obase, H, ML + 4 * F.vcu, F.wave < 4 ? 1 : 0, hmod >= 0, V, F.lane, F.wave);
    }
}

typedef float f32x16 __attribute__((ext_vector_type(16)));
constexpr int NCH = 144;
constexpr size_t SC_QA = 0, SC_KA = SC_QA + 18 * MiB, SC_EA = SC_KA + 36 * MiB, SC_KTA = SC_EA + 72 * MiB, SC_AEA = SC_KTA + 36 * MiB, SC_BEA = SC_AEA + 2 * MiB, SC_VTA = SC_BEA + 2 * MiB, SC_SPA = SC_VTA + 18 * MiB,
                 SC_QB = SC_SPA + 72 * MiB, SC_KB = SC_QB + 9 * MiB, SC_EB = SC_KB + 9 * MiB, SC_KTB = SC_EB + 36 * MiB, SC_AEB = SC_KTB + 18 * MiB, SC_BEB = SC_AEB + 1 * MiB, SC_VTB = SC_BEB + 1 * MiB, SC_SPB = SC_VTB + 18 * MiB, SC_END = SC_SPB + 36 * MiB;
static_assert(SC_END <= 400 * MiB, "scan scratch");
template <int DK> struct ScanBufs {
    bf16* Q;
    bf16* K;
    unsigned short* E;
    bf16* KT;
    float* AE;
    float* BE;
    bf16* VT;
    bf16* SP;
};
__device__ __forceinline__ ScanBufs<128> bufsA(unsigned char* ws) { unsigned char* s = ws + WS_SCAN; return ScanBufs<128>{(bf16*)(s + SC_QA), (bf16*)(s + SC_KA), (unsigned short*)(s + SC_EA), (bf16*)(s + SC_KTA), (float*)(s + SC_AEA), (float*)(s + SC_BEA), (bf16*)(s + SC_VTA), (bf16*)(s + SC_SPA)}; }
__device__ __forceinline__ ScanBufs<64> bufsB(unsigned char* ws) { unsigned char* s = ws + WS_SCAN; return ScanBufs<64>{(bf16*)(s + SC_QB), (bf16*)(s + SC_QB)  , (unsigned short*)(s + SC_EB), (bf16*)(s + SC_KTB), (float*)(s + SC_AEB), (float*)(s + SC_BEB), (bf16*)(s + SC_VTB), (bf16*)(s + SC_SPB)}; }
typedef _Float16 h2_t __attribute__((ext_vector_type(2)));
__device__ __forceinline__ unsigned pkh2(float a, float b) { const h2_t v = {(_Float16)a, (_Float16)b}; return __builtin_bit_cast(unsigned, v); }
__device__ __forceinline__ float hlo(unsigned w) { return (float)__builtin_bit_cast(h2_t, w)[0]; }
__device__ __forceinline__ float hhi(unsigned w) { return (float)__builtin_bit_cast(h2_t, w)[1]; }
__device__ __forceinline__ float ex2(float x) { return __builtin_amdgcn_exp2f(x); }
__device__ __forceinline__ float clampe(float x) { return __builtin_amdgcn_fmed3f(x, -115.f, 115.f); }
__device__ __forceinline__ float bfe(const v4u& w, int c) { return (c & 1) ? bfhi(w[c >> 1]) : bflo(w[c >> 1]); }
__device__ __forceinline__ float bfe2(const v2u& w, int c) { return (c & 1) ? bfhi(w[c >> 1]) : bflo(w[c >> 1]); }

template <int NC, int CPH> __device__ __forceinline__ void store_groups(LAS v4u* Wl, const v4u (&o)[NC], bf16* hb, size_t HS, int lane) {
#pragma unroll
    for (int c = 0; c < NC; ++c) Wl[lane * NC + c] = o[c];
    LDS_WAIT();
#pragma unroll
    for (int i = 0; i < NC; ++i) { const int sidx = i * 64 + lane; const v4u v = Wl[sidx]; *(GAS v4u*)(hb + (size_t)(sidx / CPH) * HS + (size_t)(sidx % CPH) * 8) = v; }
    LDS_WAIT();
}
template <int DIR> __device__ __forceinline__ void prep_hgrn_f(const ScanBufs<128>& A, const bf16* P, const float* LB, int g, int half, int lane, LAS v4u* Wl) {
    const int ch = half * 512 + 8 * lane, h = ch >> 7, d = ch & 127; const size_t row0 = (size_t)g * 64;
    const bf16* fp = P + row0 * NINP + (DIR ? PC_AFB : PC_AFF) + ch; const bf16* qp = P + row0 * NINP + PC_AQ + ch;
    float lb[8], cum[8];
    { const f32x4 a = *(const GAS f32x4*)(LB + DIR * 1024 + ch), b = *(const GAS f32x4*)(LB + DIR * 1024 + ch + 4);
#pragma unroll
      for (int c = 0; c < 4; ++c) { lb[c] = a[c]; lb[4 + c] = b[c]; } }
#pragma unroll
    for (int c = 0; c < 8; ++c) cum[c] = 0.f;
    unsigned short* Ep = A.E + ((size_t)DIR * MT + row0) * 1024 + ch; bf16* Kp = A.K + ((size_t)DIR * MT + row0) * 1024 + ch;
    bf16* kt = A.KT + (((((size_t)DIR * NCH + g) * 8 + half * 4) * 8) * 128) * 8;
    v4u fn[4], qn[4];
#pragma unroll
    for (int j = 0; j < 4; ++j) { fn[j] = *(const GAS v4u*)(fp + (size_t)((DIR ? 0 : 60) + j) * NINP); qn[j] = *(const GAS v4u*)(qp + (size_t)((DIR ? 0 : 60) + j) * NINP); }
    for (int i8 = 0; i8 < 8; ++i8) { const int t8 = DIR ? i8 : 7 - i8;
        float kp[8][8];
#pragma unroll
        for (int hh = 0; hh < 2; ++hh) { const int hf = DIR ? hh : 1 - hh;
            v4u f[4], qf[4];
#pragma unroll
            for (int j = 0; j < 4; ++j) { f[j] = fn[j]; qf[j] = qn[j]; }
            { const int hgn = 2 * i8 + hh + 1; if (hgn < 16) { const int tb = DIR ? 4 * hgn : 60 - 4 * hgn;
#pragma unroll
                for (int j = 0; j < 4; ++j) { fn[j] = *(const GAS v4u*)(fp + (size_t)(tb + j) * NINP); qn[j] = *(const GAS v4u*)(qp + (size_t)(tb + j) * NINP); } } }
#pragma unroll
            for (int jj = 0; jj < 4; ++jj) { const int j = DIR ? jj : 3 - jj; const int t = t8 * 8 + hf * 4 + j; float ev[8], kv[8];
#pragma unroll
                for (int c = 0; c < 8; ++c) { const float x = bfe(f[j], c); const float sg = sigmoidf_(x); const float la = __log2f(lb[c] + (1.f - lb[c]) * sg); const float k = (1.f - lb[c]) * (1.f - sg);
                    const float xq = bfe(qf[j], c); const float qv = xq * sigmoidf_(xq) * 0.08838834764831845f;
                    const float e = cum[c]; cum[c] += la; kv[c] = k * ex2(e); kp[hf * 4 + j][c] = kv[c]; ev[c] = qv * ex2(fminf(-e, 126.f)); }
                { v4u ew; ew.x = pk2(ev[0], ev[1]); ew.y = pk2(ev[2], ev[3]); ew.z = pk2(ev[4], ev[5]); ew.w = pk2(ev[6], ev[7]); *(GAS v4u*)(Ep + (size_t)t * 1024) = ew; }
                v4u kw; kw.x = pk2(kv[0], kv[1]); kw.y = pk2(kv[2], kv[3]); kw.z = pk2(kv[4], kv[5]); kw.w = pk2(kv[6], kv[7]); *(GAS v4u*)(Kp + (size_t)t * 1024) = kw; } }
        { v4u og[8];
#pragma unroll
          for (int c = 0; c < 8; ++c) { og[c].x = pk2(kp[0][c], kp[1][c]); og[c].y = pk2(kp[2][c], kp[3][c]); og[c].z = pk2(kp[4][c], kp[5][c]); og[c].w = pk2(kp[6][c], kp[7][c]); }
          store_groups<8, 128>(Wl, og, kt + (size_t)t8 * 128 * 8, (size_t)8 * 128 * 8, lane); }
    }
    float* be = A.BE + (((size_t)DIR * NCH + g) * 8 + h) * 128 + d; float* ae = A.AE + (((size_t)DIR * NCH + g) * 8 + h) * 128 + d;
    *(GAS f32x4*)be = (f32x4){cum[0], cum[1], cum[2], cum[3]}; *(GAS f32x4*)(be + 4) = (f32x4){cum[4], cum[5], cum[6], cum[7]};
    *(GAS f32x4*)ae = (f32x4){ex2(cum[0]), ex2(cum[1]), ex2(cum[2]), ex2(cum[3])}; *(GAS f32x4*)(ae + 4) = (f32x4){ex2(cum[4]), ex2(cum[5]), ex2(cum[6]), ex2(cum[7])};
}
template <int DIR> __device__ __forceinline__ void prep_gla_k(const ScanBufs<64>& B, const bf16* P, const float* w2g, const float* b2g, const f32x2* RR, const f32x2* RC, int g, int half, int lane, LAS v4u* Wl) {
    const int ch = half * 256 + 4 * lane, h = ch >> 6, d = ch & 63; const size_t row0 = (size_t)g * 64;
    float w2[16][4];
#pragma unroll
    for (int r = 0; r < 16; ++r) { const f32x4 w = *(const GAS f32x4*)(w2g + ((size_t)DIR * 16 + r) * 512 + ch); w2[r][0] = w[0]; w2[r][1] = w[1]; w2[r][2] = w[2]; w2[r][3] = w[3]; }
    const f32x4 b2 = *(const GAS f32x4*)(b2g + (size_t)DIR * 512 + ch);
    const bool lat = g < 128; const int grow = g & 31; const int j0 = d & 15; const bool isrow = d < 32; const bool second = (d & 16) != 0;
    f32x2 csr[4];
#pragma unroll
    for (int c = 0; c < 4; ++c) csr[c] = RR[grow * 16 + j0 + c];
    float cum[4] = {0.f, 0.f, 0.f, 0.f};
    const bf16* kp0 = P + row0 * NINP + PC_BK + ch; const bf16* lp0 = P + row0 * NINP + PC_GK + 16 * DIR; const bf16* qp0 = P + row0 * NINP + PC_BQ + ch;
    unsigned short* Ep = B.E + ((size_t)DIR * MT + row0) * 512 + ch; bf16* Kp = B.K + ((size_t)DIR * MT + row0) * 512 + ch;
    bf16* kt = B.KT + (((((size_t)DIR * NCH + g) * 8 + half * 4) * 8) * 64) * 8;
    for (int i8 = 0; i8 < 8; ++i8) { const int t8 = DIR ? i8 : 7 - i8;
        float kp[8][4];
#pragma unroll
        for (int hh = 0; hh < 2; ++hh) { const int hf = DIR ? hh : 1 - hh;
            v2u kr[4], qr2[4]; v4u l0[4], l1[4];
#pragma unroll
            for (int j = 0; j < 4; ++j) { const size_t ro = (size_t)(t8 * 8 + hf * 4 + j) * NINP; kr[j] = *(const GAS v2u*)(kp0 + ro); qr2[j] = *(const GAS v2u*)(qp0 + ro); l0[j] = *(const GAS v4u*)(lp0 + ro); l1[j] = *(const GAS v4u*)(lp0 + ro + 8); }
#pragma unroll
            for (int jj = 0; jj < 4; ++jj) { const int j = DIR ? jj : 3 - jj; const int t = t8 * 8 + hf * 4 + j; float ev[4], kv[4];
#pragma unroll
                for (int c = 0; c < 4; ++c) { float x = b2[c];
#pragma unroll
                    for (int r = 0; r < 8; ++r) { x += bfe(l0[j], r) * w2[r][c]; x += bfe(l1[j], r) * w2[8 + r][c]; }
                    const float la = (fminf(x, 0.f) * 1.4426950408889634f - __log2f(1.f + __expf(-fabsf(x)))) * 0.0625f;
                    float k = bfe2(kr[j], c), q = bfe2(qr2[j], c);
                    if (lat) { const f32x2 cs = isrow ? csr[c] : RC[t * 16 + j0 + c]; const float pt = __shfl_xor(k, 4), pq = __shfl_xor(q, 4); k = k * cs.x + (second ? pt : -pt) * cs.y; q = q * cs.x + (second ? pq : -pq) * cs.y; }
                    const float e = cum[c]; cum[c] += la; kv[c] = k * ex2(e); kp[hf * 4 + j][c] = kv[c]; ev[c] = q * 0.125f * ex2(fminf(-e, 126.f)); }
                { v2u ew; ew.x = pk2(ev[0], ev[1]); ew.y = pk2(ev[2], ev[3]); *(GAS v2u*)(Ep + (size_t)t * 512) = ew; }
                { v2u kw; kw.x = pk2(kv[0], kv[1]); kw.y = pk2(kv[2], kv[3]); *(GAS v2u*)(Kp + (size_t)t * 512) = kw; } } }
        { v4u og[4];
#pragma unroll
          for (int c = 0; c < 4; ++c) { og[c].x = pk2(kp[0][c], kp[1][c]); og[c].y = pk2(kp[2][c], kp[3][c]); og[c].z = pk2(kp[4][c], kp[5][c]); og[c].w = pk2(kp[6][c], kp[7][c]); }
          store_groups<4, 64>(Wl, og, kt + (size_t)t8 * 64 * 8, (size_t)8 * 64 * 8, lane); }
    }
    float* be = B.BE + (((size_t)DIR * NCH + g) * 8 + h) * 64 + d; float* ae = B.AE + (((size_t)DIR * NCH + g) * 8 + h) * 64 + d;
    *(GAS f32x4*)be = (f32x4){cum[0], cum[1], cum[2], cum[3]}; *(GAS f32x4*)ae = (f32x4){ex2(cum[0]), ex2(cum[1]), ex2(cum[2]), ex2(cum[3])};
}
__device__ __forceinline__ void prep_vt(const bf16* P, int vcol, bf16* VT, int g, int half, int lane, LAS v4u* Wl) {
    const int ch = half * 512 + 8 * lane, h = ch >> 7, d = ch & 127; const size_t row0 = (size_t)g * 64; const bf16* vp = P + row0 * NINP + vcol + ch; bf16* vt = VT + ((((size_t)g * 8 + half * 4) * 8) * 128) * 8;
    for (int t8 = 0; t8 < 8; ++t8) { v4u f[8];
#pragma unroll
        for (int j = 0; j < 8; ++j) f[j] = *(const GAS v4u*)(vp + (size_t)(t8 * 8 + j) * NINP);
        v4u og[8];
#pragma unroll
        for (int c = 0; c < 8; ++c) {
#pragma unroll
            for (int q = 0; q < 4; ++q) { const unsigned a = f[2 * q][c >> 1], b = f[2 * q + 1][c >> 1]; og[c][q] = (c & 1) ? ((a >> 16) | (b & 0xffff0000u)) : ((a & 0xffffu) | (b << 16)); } }
        store_groups<8, 128>(Wl, og, vt + (size_t)t8 * 128 * 8, (size_t)8 * 128 * 8, lane); }
}
__device__ __forceinline__ void mixer_phase1(Frame& FF, int l) {
    Frame F = FF; F.lane = xb_lane(); F.tid = F.wave * 64 + F.lane;
    const bf16* P = (const bf16*)(F.ws + WS_P);
    const ScanBufs<128> A = bufsA(F.ws); const ScanBufs<64> B = bufsB(F.ws);
    const float* LB = (const float*)(F.ws + WS_TAB + TAB_LB) + (size_t)l * 2048;
    const f32x2* RR = (const f32x2*)(F.ws + WS_TAB + TAB_RR); const f32x2* RC = (const f32x2*)(F.ws + WS_TAB + TAB_RC);
    const int gw = F.vcu * NWAVES + F.wave, NGW = F.G * NWAVES;
    LAS v4u* Wl = (LAS v4u*)(F.lds + F.wave * 8192);
    constexpr int U_F = NCH * 4, U_K = NCH * 4, U_V = NCH * 4, U_QA = 0, U_QB = 0, U_ALL = U_F + U_K + U_V + U_QA + U_QB;
    int u0 = -1;
    const bool deal = (F.G == 256); if (deal) { const int w = F.wave, cu = F.vcu;
        if (w < 4) u0 = w * 256 + cu;
        else if (w == 4 && cu < 128) u0 = 1024 + cu;
        else { const int li = cu < 128 ? cu * 3 + (w - 5) : 384 + (cu - 128) * 4 + (w - 4); if (U_F + U_K + li < U_ALL) u0 = U_F + U_K + li; }
    }
    const int ustep = deal ? 1 : NGW; const int uend = deal ? 1 : U_ALL;
    for (int ui = deal ? 0 : gw; ui < uend; ui += ustep) { const int u = deal ? u0 : ui; if (u < 0) continue;
        int r = u; const int lane = xb_lane();
        if (r < U_F) { const int half = r & 1, dir = (r >> 1) & 1, g = r >> 2; if (dir == 0) prep_hgrn_f<0>(A, P, LB, g, half, lane, Wl); else prep_hgrn_f<1>(A, P, LB, g, half, lane, Wl); continue; } r -= U_F;
        if (r < U_K) { const int half = r & 1, dir = (r >> 1) & 1, g = r >> 2; const float* w2g = FIN(9) + (size_t)l * 2 * 16 * 512; const float* b2g = FIN(10) + (size_t)l * 2 * 512;
            if (dir == 0) prep_gla_k<0>(B, P, w2g, b2g, RR, RC, g, half, lane, Wl); else prep_gla_k<1>(B, P, w2g, b2g, RR, RC, g, half, lane, Wl); continue; } r -= U_K;
        if (r < U_V) { const int half = r & 1, mix = (r >> 1) & 1, g = r >> 2; if (mix == 0) prep_vt(P, PC_AI, A.VT, g, half, lane, Wl); else prep_vt(P, PC_BV, B.VT, g, half, lane, Wl); continue; } r -= U_V;
        if (r < U_QA) { const int half = r & 1, g = r >> 1; const int ch = half * 512 + 8 * lane; const size_t row0 = (size_t)g * 64;
            for (int t8 = 0; t8 < 8; ++t8) { v4u f[8];
#pragma unroll
                for (int j = 0; j < 8; ++j) f[j] = *(const GAS v4u*)(P + (row0 + t8 * 8 + j) * NINP + PC_AQ + ch);
#pragma unroll
                for (int j = 0; j < 8; ++j) { float q[8];
#pragma unroll
                    for (int c = 0; c < 8; ++c) { const float x = bfe(f[j], c); q[c] = x * sigmoidf_(x) * 0.08838834764831845f; }
                    v4u o; o.x = pk2(q[0], q[1]); o.y = pk2(q[2], q[3]); o.z = pk2(q[4], q[5]); o.w = pk2(q[6], q[7]); *(GAS v4u*)(A.Q + (row0 + t8 * 8 + j) * 1024 + ch) = o; } }
            continue; } r -= U_QA;
        { const int g = r; const int ch = 8 * lane, d = ch & 63; const size_t row0 = (size_t)g * 64;
          const bool lat = g < 128; const int grow = g & 31; const int j0 = d & 15; const bool isrow = d < 32; const bool second = (d & 16) != 0;
          f32x2 csr[8];
#pragma unroll
          for (int c = 0; c < 8; ++c) csr[c] = RR[grow * 16 + j0 + c];
          for (int t8 = 0; t8 < 8; ++t8) { v4u f[8];
#pragma unroll
              for (int j = 0; j < 8; ++j) f[j] = *(const GAS v4u*)(P + (row0 + t8 * 8 + j) * NINP + PC_BQ + ch);
#pragma unroll
              for (int j = 0; j < 8; ++j) { float q[8]; const int t = t8 * 8 + j;
#pragma unroll
                  for (int c = 0; c < 8; ++c) { float x = bfe(f[j], c);
                      if (lat) { const f32x2 cs = isrow ? csr[c] : RC[t * 16 + j0 + c]; const float pt = __shfl_xor(x, 2); x = x * cs.x + (second ? pt : -pt) * cs.y; }
                      q[c] = x * 0.125f; }
                  v4u o; o.x = pk2(q[0], q[1]); o.y = pk2(q[2], q[3]); o.z = pk2(q[4], q[5]); o.w = pk2(q[6], q[7]); *(GAS v4u*)(B.Q + (row0 + t) * 512 + ch) = o; } } }
    }
}

__device__ __forceinline__ int scan_chunk(int b, int dir, int s) { return s < 4 ? 128 + 4 * b + (dir ? 3 - s : s) : 32 * b + (dir ? 31 - (s - 4) : (s - 4)); }
template <int DK> struct P2Frag { bf16x8 a[4]; bf16x8 bv[2][4]; f32x4 ae[4]; };
template <int DK> __device__ __forceinline__ void p2_load(P2Frag<DK>& f, const ScanBufs<DK>& S, int dir, int g, int h, int dkb, int dvb, int r, int hi) {
    const bf16* kt = S.KT + (((((size_t)dir * NCH + g) * 8 + h) * 8 + hi) * DK + dkb * 32 + r) * 8;
    const bf16* vt = S.VT + ((((size_t)g * 8 + h) * 8 + hi) * 128 + dvb * 64 + r) * 8;
    const float* ae = S.AE + (((size_t)dir * NCH + g) * 8 + h) * DK + dkb * 32 + 4 * hi;
#pragma unroll
    for (int kk = 0; kk < 4; ++kk) { f.a[kk] = *(const GAS bf16x8*)(kt + (size_t)kk * 2 * DK * 8); f.bv[0][kk] = *(const GAS bf16x8*)(vt + (size_t)kk * 2 * 128 * 8); f.bv[1][kk] = *(const GAS bf16x8*)(vt + (size_t)kk * 2 * 128 * 8 + 32 * 8); f.ae[kk] = *(const GAS f32x4*)(ae + 8 * kk); }
}
template <int DK> __device__ __forceinline__ void scan_state_unit(const ScanBufs<DK>& S, int unit, int lane, bool skip_ctx_store) {
    constexpr int NKB = DK / 32;
    const int dvb = unit & 1, dkb = (unit >> 1) % NKB, rest = (unit >> 1) / NKB; const int dir = rest & 1, h = (rest >> 1) & 7, b = rest >> 4;
    const int r = lane & 31, hi = lane >> 5;
    f32x16 acc[2]; acc[0] = f32x16{}; acc[1] = f32x16{};
    P2Frag<DK> cur, nxt; p2_load<DK>(cur, S, dir, scan_chunk(b, dir, 0), h, dkb, dvb, r, hi);
    for (int s = 0; s < 36; ++s) {
        const int g = scan_chunk(b, dir, s);
        if (s + 1 < 36) p2_load<DK>(nxt, S, dir, scan_chunk(b, dir, s + 1), h, dkb, dvb, r, hi);
        if (!(skip_ctx_store && s < 4)) {
            bf16* sp = S.SP + (((((size_t)dir * NCH + g) * 8 + h) * (DK / 8) + dkb * 4) * 128 + dvb * 64 + r) * 8 + 4 * hi;
#pragma unroll
            for (int j = 0; j < 2; ++j)
#pragma unroll
                for (int q = 0; q < 4; ++q) { v2u o; o.x = pk2(acc[j][4 * q], acc[j][4 * q + 1]); o.y = pk2(acc[j][4 * q + 2], acc[j][4 * q + 3]); *(GAS v2u*)(sp + ((size_t)q * 128 + j * 32) * 8) = o; }
        }
#pragma unroll
        for (int j = 0; j < 2; ++j)
#pragma unroll
            for (int q = 0; q < 4; ++q)
#pragma unroll
                for (int i = 0; i < 4; ++i) acc[j][4 * q + i] *= cur.ae[q][i];
#pragma unroll
        for (int kk = 0; kk < 4; ++kk) { acc[0] = __builtin_amdgcn_mfma_f32_32x32x16_bf16(cur.a[kk], cur.bv[0][kk], acc[0], 0, 0, 0); acc[1] = __builtin_amdgcn_mfma_f32_32x32x16_bf16(cur.a[kk], cur.bv[1][kk], acc[1], 0, 0, 0); }
        cur = nxt;
    }
}

template <int DK> struct P2Stg { static constexpr int NC = DK == 128 ? 1 : 2, NKT = NC * DK * 128 / 8192, NVT = NC * 16384 / 8192; v4u kt[NKT]; v4u vt[NVT]; v4u ae; };
template <int DK> __device__ __forceinline__ void p2b_load(P2Stg<DK>& R, const ScanBufs<DK>& S, int blk, int s, int tid) {
    constexpr int NC = P2Stg<DK>::NC, KTB = DK * 128, VTB = 16384, AEB = DK * 4;
#pragma unroll
    for (int i = 0; i < P2Stg<DK>::NKT; ++i) { const int k = NC == 2 ? i : 0; const int c = blk * NC + k, dir = c & 1, h = (c >> 1) & 7, b = c >> 4; const int g = scan_chunk(b, dir, s);
        const char* base = (const char*)S.KT + (size_t)((dir * NCH + g) * 8 + h) * KTB + (NC == 2 ? 0 : i * 8192); R.kt[i] = *(const GAS v4u*)(base + tid * 16); }
#pragma unroll
    for (int i = 0; i < P2Stg<DK>::NVT; ++i) { const int k = NC == 2 ? (i >> 1) : 0; const int c = blk * NC + k, dir = c & 1, h = (c >> 1) & 7, b = c >> 4; const int g = scan_chunk(b, dir, s);
        const char* base = (const char*)S.VT + (size_t)(g * 8 + h) * VTB + (i & 1) * 8192; R.vt[i] = *(const GAS v4u*)(base + tid * 16); }
    { const int t5 = tid & 31; const int k = NC == 2 ? (t5 >> 4) : 0; const int c = blk * NC + k, dir = c & 1, h = (c >> 1) & 7, b = c >> 4; const int g = scan_chunk(b, dir, s);
        const char* base = (const char*)S.AE + (size_t)((dir * NCH + g) * 8 + h) * AEB; R.ae = *(const GAS v4u*)(base + (NC == 2 ? (t5 & 15) : t5) * 16); }
}
template <int DK> __device__ __forceinline__ void p2b_write(const P2Stg<DK>& R, LAS unsigned char* Lb, int tid) {
    constexpr int NC = P2Stg<DK>::NC, OFF_VT = NC * DK * 128, OFF_AE = OFF_VT + NC * 16384;
#pragma unroll
    for (int i = 0; i < P2Stg<DK>::NKT; ++i) *(LAS v4u*)(Lb + (tid + 512 * i) * 16) = R.kt[i];
#pragma unroll
    for (int i = 0; i < P2Stg<DK>::NVT; ++i) *(LAS v4u*)(Lb + OFF_VT + (tid + 512 * i) * 16) = R.vt[i];
    if (tid < 32) *(LAS v4u*)(Lb + OFF_AE + tid * 16) = R.ae;
}
template <int DK> __device__ __forceinline__ void scan_state_block(const ScanBufs<DK>& S, int blk, int wave, int lane, int tid, LAS unsigned char* L, bool skip_ctx_store) {
    constexpr int NC = P2Stg<DK>::NC, KTB = DK * 128, VTB = 16384, AEB = DK * 4, OFF_VT = NC * KTB, OFF_AE = OFF_VT + NC * VTB, STAGE = OFF_AE + NC * AEB;
    const int ci = NC == 2 ? (wave >> 2) : 0, wl = NC == 2 ? (wave & 3) : wave, dvb = wl & 1, dkb = wl >> 1;
    const int cc = blk * NC + ci, dir = cc & 1, h = (cc >> 1) & 7, b = cc >> 4;
    const int r = lane & 31, hi = lane >> 5;
    f32x16 acc[2]; acc[0] = f32x16{}; acc[1] = f32x16{};
    P2Stg<DK> R0, R1, R2;
#define P2B_ZSTORE() do { bf16* sp = S.SP + (((((size_t)dir * NCH + scan_chunk(b, dir, 0)) * 8 + h) * (DK / 8) + dkb * 4) * 128 + dvb * 64 + r) * 8 + 4 * hi; \
        _Pragma("unroll") for (int j = 0; j < 2; ++j) _Pragma("unroll") for (int q = 0; q < 4; ++q) *(GAS v2u*)(sp + ((size_t)q * 128 + j * 32) * 8) = (v2u){0u, 0u}; __builtin_amdgcn_sched_barrier(0); } while (0)
    p2b_load<DK>(R0, S, blk, 0, tid); __builtin_amdgcn_sched_barrier(0); P2B_ZSTORE(); p2b_load<DK>(R1, S, blk, 1, tid); __builtin_amdgcn_sched_barrier(0); P2B_ZSTORE(); p2b_load<DK>(R2, S, blk, 2, tid); __builtin_amdgcn_sched_barrier(0); P2B_ZSTORE();
#undef P2B_ZSTORE
#define P2B_STEP(R, s_) do { const int s = (s_); LAS unsigned char* Lb = L + (s & 1) * STAGE; p2b_write<DK>(R, Lb, tid); __builtin_amdgcn_sched_barrier(0); p2b_load<DK>(R, S, blk, min(s + 3, 35), tid); __builtin_amdgcn_sched_barrier(0);     \
        LDS_WAIT(); __builtin_amdgcn_s_barrier(); asm volatile("" ::: "memory"); \
        bf16x8 a_[4], bv_[2][4]; f32x4 ae_[4]; \
        { const LAS unsigned char* ka = Lb + ci * KTB + (hi * DK + dkb * 32 + r) * 16; const LAS unsigned char* va = Lb + OFF_VT + ci * VTB + (hi * 128 + dvb * 64 + r) * 16; const LAS unsigned char* ea = Lb + OFF_AE + ci * AEB + (dkb * 32 + 4 * hi) * 4; \
          _Pragma("unroll") for (int kk = 0; kk < 4; ++kk) { a_[kk] = *(const LAS bf16x8*)(ka + kk * 2 * DK * 16); bv_[0][kk] = *(const LAS bf16x8*)(va + kk * 2 * 128 * 16); bv_[1][kk] = *(const LAS bf16x8*)(va + kk * 2 * 128 * 16 + 32 * 16); ae_[kk] = *(const LAS f32x4*)(ea + 32 * kk); } } \
        const int g = scan_chunk(b, dir, s); \
        { bf16* sp = S.SP + (((((size_t)dir * NCH + g) * 8 + h) * (DK / 8) + dkb * 4) * 128 + dvb * 64 + r) * 8 + 4 * hi; \
            _Pragma("unroll") for (int j = 0; j < 2; ++j) _Pragma("unroll") for (int q = 0; q < 4; ++q) { v2u o; o.x = pk2(acc[j][4 * q], acc[j][4 * q + 1]); o.y = pk2(acc[j][4 * q + 2], acc[j][4 * q + 3]); *(GAS v2u*)(sp + ((size_t)q * 128 + j * 32) * 8) = o; } } \
        _Pragma("unroll") for (int j = 0; j < 2; ++j) _Pragma("unroll") for (int q = 0; q < 4; ++q) _Pragma("unroll") for (int i = 0; i < 4; ++i) acc[j][4 * q + i] *= ae_[q][i]; \
        _Pragma("unroll") for (int kk = 0; kk < 4; ++kk) { acc[0] = __builtin_amdgcn_mfma_f32_32x32x16_bf16(a_[kk], bv_[0][kk], acc[0], 0, 0, 0); acc[1] = __builtin_amdgcn_mfma_f32_32x32x16_bf16(a_[kk], bv_[1][kk], acc[1], 0, 0, 0); } } while (0)
#pragma nounroll
    for (int s3 = 0; s3 < 36; s3 += 3) { P2B_STEP(R0, s3); P2B_STEP(R1, s3 + 1); P2B_STEP(R2, s3 + 2); }
#undef P2B_STEP
}

constexpr int P3_ALP = 144, P3_WBYTES = 4 * 32 * P3_ALP, P3_STP = 272;
static_assert(32 * P3_STP <= 2 * 32 * P3_ALP, "output staging fits a t block's score rows");
template <int DK> __device__ __forceinline__ void scan_out_wave(const ScanBufs<DK>& S, int g, int h, const bf16* P, int gcol, const float* gain, bf16* Y, LAS unsigned char* W, int lane) {
    const int r = lane & 31, hi = lane >> 5;
    constexpr int NK = DK / 16, HD = 8 * DK;
    const size_t row0 = (size_t)g * 64;
    const unsigned oRow = (unsigned)((r * HD + 8 * hi) * 2);
    const unsigned oGrp = (unsigned)(((hi * 128 + r) * 8) * 2);
    const unsigned oHi4 = (unsigned)(8 * hi * 4), oHi2 = (unsigned)(8 * hi * 2);
#define UB(base) ([&]() -> const char* { const char* b_ = (const char*)(base); asm volatile("" : "+s"(b_)); return b_; }())
#define LDV(ub, off) (*(const GAS v4u*)((ub) + (off)))
#define LD16(base, off) ([&]() -> v4u { const char* b_ = (const char*)(base); asm volatile("" : "+s"(b_)); return *(const GAS v4u*)(b_ + (off)); }())
#define LD16F(base, off) ([&]() -> f32x4 { const char* b_ = (const char*)(base); asm volatile("" : "+s"(b_)); return *(const GAS f32x4*)(b_ + (off)); }())
#define P3_BLOCK(ti, si, DIAG, KA, QA) do { f32x16 acc_ = f32x16{}; _Pragma("unroll") for (int kk = 0; kk < NK; ++kk) acc_ = __builtin_amdgcn_mfma_f32_32x32x16_bf16(__builtin_bit_cast(bf16x8, KA[kk]), __builtin_bit_cast(bf16x8, QA[kk]), acc_, 0, 0, 0); \
            if (DIAG) { _Pragma("unroll") for (int e = 0; e < 16; ++e) { const int sl_ = (e & 3) + 8 * (e >> 2) + 4 * hi; const bool keep_ = dir == 0 ? (sl_ <= r) : (sl_ >= r); acc_[e] = keep_ ? acc_[e] : 0.f; } } \
            LAS unsigned char* ap_ = W + (((ti) * 2 + dir) * 32 + r) * P3_ALP + (32 * (si) + 4 * hi) * 2; \
            _Pragma("unroll") for (int q = 0; q < 4; ++q) { v2u o_; o_.x = pk2(acc_[4 * q], acc_[4 * q + 1]); o_.y = pk2(acc_[4 * q + 2], acc_[4 * q + 3]); *(LAS v2u*)(ap_ + 16 * q) = o_; } } while (0)
#define P3_ZERO(ti, si) do { LAS unsigned char* ap_ = W + (((ti) * 2 + dir) * 32 + r) * P3_ALP + (32 * (si) + 4 * hi) * 2; _Pragma("unroll") for (int q = 0; q < 4; ++q) *(LAS v2u*)(ap_ + 16 * q) = (v2u){0u, 0u}; } while (0)
#pragma unroll
    for (int dir = 0; dir < 2; ++dir) {
        const char* Qh = (const char*)(S.E + ((size_t)dir * MT + row0) * HD + h * DK); const char* Ku = (const char*)(S.K + ((size_t)dir * MT + row0) * HD + h * DK);
        v4u ka0[NK], ka1[NK], qa0[NK], qa1[NK];
        { const char* k0_ = UB(Ku); const char* k1_ = UB(Ku + (size_t)32 * HD * 2); const char* q0_ = UB(Qh); const char* q1_ = UB(Qh + (size_t)32 * HD * 2);
#pragma unroll
          for (int kk = 0; kk < NK; ++kk) { ka0[kk] = LDV(k0_ + 32 * kk, oRow); qa0[kk] = LDV(q0_ + 32 * kk, oRow); }
#pragma unroll
          for (int kk = 0; kk < NK; ++kk) { ka1[kk] = LDV(k1_ + 32 * kk, oRow); qa1[kk] = LDV(q1_ + 32 * kk, oRow); } }
        P3_BLOCK(0, 0, true, ka0, qa0);
        if (dir == 0) { P3_BLOCK(1, 0, false, ka0, qa1); P3_ZERO(0, 1); } else { P3_BLOCK(0, 1, false, ka1, qa0); P3_ZERO(1, 0); }
        P3_BLOCK(1, 1, true, ka1, qa1);
    }
#undef P3_BLOCK
#undef P3_ZERO
    LDS_WAIT();
    const char* VTu = (const char*)(S.VT + (((size_t)g * 8 + h) * 8) * 128 * 8);
    for (int tt = 0; tt < 2; ++tt) {
        f32x16 acc[4];
#pragma unroll
        for (int dvt = 0; dvt < 4; ++dvt) acc[dvt] = f32x16{};
        const LAS unsigned char* Wt = W + (size_t)tt * 2 * 32 * P3_ALP;
        const int tl = lane >> 3, seg = lane & 7; const size_t rowt = row0 + 32 * tt;
        const char* Gu = (const char*)(P + rowt * NINP + gcol + h * 128); const unsigned og = (unsigned)((tl * NINP + seg * 8) * 2);
        struct Raw8 { v4u x[8]; }; Raw8 A0, A1;
        constexpr int NST = 2 * (2 + NK);
#define P3_SLOAD(R, st) do { constexpr int dir_ = (st) / (2 + NK), j_ = (st) % (2 + NK); \
            if ((st) >= NST) { _Pragma("unroll") for (int j = 0; j < 8; ++j) { const char* gb_ = UB(Gu + ((size_t)(8 * (j >> 1)) * NINP + (j & 1) * 64) * 2); R.x[j] = LDV(gb_, og); } } \
            else if (j_ < 2) { _Pragma("unroll") for (int k2 = 0; k2 < 2; ++k2) { const char* vb_ = UB(VTu + (size_t)(2 * j_ + k2) * 2 * 128 * 16); _Pragma("unroll") for (int dvt = 0; dvt < 4; ++dvt) R.x[k2 * 4 + dvt] = LDV(vb_ + 32 * dvt * 16, oGrp); } } \
            else { constexpr int kk_ = j_ - 2; const char* sb_ = UB((const char*)(S.SP + ((((size_t)dir_ * NCH + g) * 8 + h) * (DK / 8)) * 128 * 8) + (size_t)kk_ * 2 * 128 * 16); \
                const char* qb_ = UB((const char*)(S.E + ((size_t)dir_ * MT + rowt) * HD + h * DK) + 32 * kk_); const char* bb_ = UB((const char*)(S.AE + (((size_t)dir_ * NCH + g) * 8 + h) * DK) + 64 * kk_); \
                _Pragma("unroll") for (int dvt = 0; dvt < 4; ++dvt) R.x[dvt] = LDV(sb_ + 32 * dvt * 16, oGrp); \
                R.x[4] = LDV(qb_, oRow); R.x[5] = R.x[4]; R.x[6] = LDV(bb_, oHi4); R.x[7] = LDV(bb_ + 16, oHi4); } \
            __builtin_amdgcn_sched_barrier(0); } while (0)
#define P3_SCOMP(R, st) do { constexpr int dir_ = (st) / (2 + NK), j_ = (st) % (2 + NK); \
            if (j_ < 2) { const LAS unsigned char* ap_ = Wt + (dir_ * 32 + r) * P3_ALP + (8 * hi) * 2; \
                _Pragma("unroll") for (int k2 = 0; k2 < 2; ++k2) { const bf16x8 af_ = *(const LAS bf16x8*)(ap_ + 32 * (2 * j_ + k2)); \
                    _Pragma("unroll") for (int dvt = 0; dvt < 4; ++dvt) acc[dvt] = __builtin_amdgcn_mfma_f32_32x32x16_bf16(__builtin_bit_cast(bf16x8, R.x[k2 * 4 + dvt]), af_, acc[dvt], 0, 0, 0); } } \
            else { const v4u qw_ = R.x[4]; const f32x4 b0_ = __builtin_bit_cast(f32x4, R.x[6]), b1_ = __builtin_bit_cast(f32x4, R.x[7]); v4u qa_;     \
                qa_.x = pk2(bflo(qw_.x) * b0_[0], bfhi(qw_.x) * b0_[1]); qa_.y = pk2(bflo(qw_.y) * b0_[2], bfhi(qw_.y) * b0_[3]); qa_.z = pk2(bflo(qw_.z) * b1_[0], bfhi(qw_.z) * b1_[1]); qa_.w = pk2(bflo(qw_.w) * b1_[2], bfhi(qw_.w) * b1_[3]); \
                _Pragma("unroll") for (int dvt = 0; dvt < 4; ++dvt) acc[dvt] = __builtin_amdgcn_mfma_f32_32x32x16_bf16(__builtin_bit_cast(bf16x8, R.x[dvt]), __builtin_bit_cast(bf16x8, qa_), acc[dvt], 0, 0, 0); } \
            __builtin_amdgcn_sched_barrier(0); } while (0)
#define P3_STEP2(st) do { P3_SLOAD(A1, (st) + 1); P3_SCOMP(A0, (st)); P3_SLOAD(A0, (st) + 2); P3_SCOMP(A1, (st) + 1); } while (0)
        P3_SLOAD(A0, 0);
        P3_STEP2(0); P3_STEP2(2); P3_STEP2(4); P3_STEP2(6); P3_STEP2(8); P3_STEP2(10);
        if (NK == 8) { P3_STEP2(12); P3_STEP2(14); P3_STEP2(16); P3_STEP2(18); }
#undef P3_SLOAD
#undef P3_SCOMP
#undef P3_STEP2
        float ss = 0.f;
#pragma unroll
        for (int dvt = 0; dvt < 4; ++dvt)
#pragma unroll
            for (int e = 0; e < 16; ++e) ss += acc[dvt][e] * acc[dvt][e];
        ss += __shfl_xor(ss, 32);
        const float rstd = 1.0f / sqrtf(ss * (1.f / 128.f) + RMS_EPS);
        LAS unsigned char* st = W + (size_t)tt * 2 * 32 * P3_ALP;
#pragma unroll
        for (int dvt = 0; dvt < 4; ++dvt)
#pragma unroll
            for (int q = 0; q < 4; ++q) { v2u o; o.x = pk2(acc[dvt][4 * q] * rstd, acc[dvt][4 * q + 1] * rstd); o.y = pk2(acc[dvt][4 * q + 2] * rstd, acc[dvt][4 * q + 3] * rstd); *(LAS v2u*)(st + r * P3_STP + (32 * dvt + 8 * q + 4 * hi) * 2) = o; }
        LDS_WAIT();
        { char* Yu = (char*)(Y + rowt * 1024 + h * 128); const unsigned oy = (unsigned)((tl * 1024 + seg * 8) * 2);
#pragma unroll
          for (int j = 0; j < 8; ++j) { const int rr = 8 * (j >> 1), hf = j & 1; const v4u ow = *(const LAS v4u*)(st + (tl + rr) * P3_STP + hf * 128 + seg * 16); const v4u gw = A0.x[j];
              const float* gn = gain + hf * 64 + seg * 8; const f32x4 n0 = *(const GAS f32x4*)gn, n1 = *(const GAS f32x4*)(gn + 4); v4u y;
#pragma unroll
              for (int c = 0; c < 4; ++c) { const float z0 = bflo(gw[c]), z1 = bfhi(gw[c]); const float na = c < 2 ? n0[2 * c] : n1[2 * c - 4], nb = c < 2 ? n0[2 * c + 1] : n1[2 * c - 3];
                  y[c] = pk2(bflo(ow[c]) * na * z0 * sigmoidf_(z0), bfhi(ow[c]) * nb * z1 * sigmoidf_(z1)); }
              *(GAS v4u*)(Yu + oy + ((size_t)rr * 1024 + hf * 64) * 2) = y; } }
        LDS_WAIT();
    }
#undef LD16
#undef LD16F
#undef UB
#undef LDV
}
__device__ __forceinline__ void mixer_phase3(Frame& FF, int l) {
    Frame F = FF; F.lane = xb_lane(); F.tid = F.wave * 64 + F.lane; const int lane = F.lane;
    const bf16* P = (const bf16*)(F.ws + WS_P); bf16* Y = (bf16*)(F.ws + WS_Y);
    const ScanBufs<128> A = bufsA(F.ws); const ScanBufs<64> B = bufsB(F.ws);
    { unsigned* sd = (unsigned*)(F.ctl + CW_QUEUE + 64 * (8 + l));
      if (F.wave == 0 && lane == 0) { XB_SPIN(xb_ld(sd) < 96u, (unsigned*)(F.ctl + CW_BAR)); __builtin_amdgcn_fence(__ATOMIC_ACQUIRE, "agent"); VM_WAIT(); }
      __syncthreads(); }
    const int nch = (l == DEPTH - 1) ? 128 : NCH;
    const int nu = nch * 8;
    LAS unsigned char* W = F.lds + F.wave * P3_WBYTES;
    const int NGW = F.G * NWAVES; const int gw0 = F.wave * F.G + F.vcu; const int gw1 = (F.G == 256) ? ((F.wave == 5) ? NGW + F.vcu : 2 * nu) : gw0 + NGW;
    for (int ui = 0; ui < 16; ++ui) { const int u = ui == 0 ? gw0 : (F.G == 256 ? (ui == 1 ? gw1 : 2 * nu) : gw0 + ui * NGW); if (u >= 2 * nu) break;
        const int ln = xb_lane();
        if (u < nu) scan_out_wave<128>(A, u >> 3, u & 7, P, PC_AG, FIN(8) + l * 128, Y, W, ln);
        else { const int v = u - nu; scan_out_wave<64>(B, v >> 3, v & 7, P, PC_BG, FIN(11) + l * 128, Y + (size_t)MT * 1024, W, ln); }
    }
}
namespace nat {
using s16x4 = __attribute__((ext_vector_type(4))) short; using u32x4 = __attribute__((ext_vector_type(4))) unsigned;
#define KSWZ(row, colB) ((row) * 256 + ((colB) ^ (((row) & 7) << 4)))
#define SBAR() __builtin_amdgcn_sched_barrier(0)
__device__ __forceinline__ int crow(int r, int hi) { return (r & 3) + 8 * (r >> 2) + 4 * hi; }
__device__ __forceinline__ unsigned cvtpk(float lo, float hi) {
  unsigned r; asm volatile("v_cvt_pk_bf16_f32 %0, %1, %2" : "=v"(r) : "v"(lo), "v"(hi)); return r;
}
__device__ __forceinline__ void finishSM(f32x16& p0, f32x16& p1, float alpha, float& l_reg, bf16x8& pa0, bf16x8& pa1, bf16x8& pa2, bf16x8& pa3) {
  for (int r = 0; r < 16; ++r) p1[r] = __builtin_amdgcn_exp2f(p1[r]);
  float ps = 0; for (int r = 0; r < 16; ++r) ps += p0[r]; for (int r = 0; r < 16; ++r) ps += p1[r];
  { auto rr = __builtin_amdgcn_permlane32_swap(__float_as_uint(ps), __float_as_uint(ps), false, false);
    ps = __uint_as_float(rr[0]) + __uint_as_float(rr[1]); }
  l_reg = l_reg * alpha + ps;
#define PK4(P, BASE, OUT) do { unsigned a0 = cvtpk(P[BASE + 0], P[BASE + 1]), a1 = cvtpk(P[BASE + 2], P[BASE + 3]);   \
    unsigned b0 = cvtpk(P[BASE + 4], P[BASE + 5]), b1 = cvtpk(P[BASE + 6], P[BASE + 7]);                              \
    auto r0 = __builtin_amdgcn_permlane32_swap(a0, b0, false, false); auto r1 = __builtin_amdgcn_permlane32_swap(a1, b1, false, false); \
    u32x4 w = {r0[0], r1[0], r0[1], r1[1]}; OUT = *reinterpret_cast<bf16x8*>(&w); } while (0)
  PK4(p0, 0, pa0); PK4(p0, 8, pa1); PK4(p1, 0, pa2); PK4(p1, 8, pa3);
#undef PK4
}
__device__ __forceinline__ void qkt(f32x16& p0, f32x16& p1, const bf16* Ks, const bf16x8* qr, int r32, int hi) {
  p0 = f32x16{}; p1 = f32x16{};
  for (int d0 = 0; d0 < 8; ++d0) { int cb = (d0 * 16 + hi * 8) * 2;
    bf16x8 b0 = *reinterpret_cast<const bf16x8*>((const char*)Ks + KSWZ(r32, cb));
    bf16x8 b1 = *reinterpret_cast<const bf16x8*>((const char*)Ks + KSWZ(32 + r32, cb));
    p0 = __builtin_amdgcn_mfma_f32_32x32x16_bf16(b0, qr[d0], p0, 0, 0, 0);
    p1 = __builtin_amdgcn_mfma_f32_32x32x16_bf16(b1, qr[d0], p1, 0, 0, 0); }
}
__device__ __forceinline__ int v_st(int k, int c) { const int kk = (k & ~0xC) | ((k & 4) << 1) | ((k & 8) >> 1); return ((kk >> 3) * 4 + (c >> 5)) * 512 + ((kk & 7) * 32 + (c & 31)) * 2; }
__device__ __forceinline__ int v_rd_base(int lane) { return ((lane & 3) << 3) | (((lane >> 2) & 3) << 6) | (((lane >> 4) & 1) << 5) | (((lane >> 5) & 1) << 8); }
constexpr int v_rd_off(int d0, int ks, int half) { return d0 * 512 + ks * 4096 + half * 2048; }
template <int OFF> __device__ __forceinline__ s16x4 tr_read(int vb) {
  s16x4 r; asm volatile("ds_read_b64_tr_b16 %0, %1 offset:%2" : "=&v"(r) : "v"(vb), "i"(OFF) : "memory"); return r;
}
template <int D0> __device__ __forceinline__ void pv_one(f32x16& od, int vb, bf16x8 pa0, bf16x8 pa1, bf16x8 pa2, bf16x8 pa3) {
  const s16x4 l0 = tr_read<v_rd_off(D0, 0, 0)>(vb), h0 = tr_read<v_rd_off(D0, 0, 1)>(vb), l1 = tr_read<v_rd_off(D0, 1, 0)>(vb), h1 = tr_read<v_rd_off(D0, 1, 1)>(vb);
  const s16x4 l2 = tr_read<v_rd_off(D0, 2, 0)>(vb), h2 = tr_read<v_rd_off(D0, 2, 1)>(vb), l3 = tr_read<v_rd_off(D0, 3, 0)>(vb), h3 = tr_read<v_rd_off(D0, 3, 1)>(vb);
  asm volatile("s_waitcnt lgkmcnt(0)" ::: "memory"); SBAR();
#define PK(L, H) (bf16x8){L[0], L[1], L[2], L[3], H[0], H[1], H[2], H[3]}
  od = __builtin_amdgcn_mfma_f32_32x32x16_bf16(pa0, PK(l0, h0), od, 0, 0, 0);
  od = __builtin_amdgcn_mfma_f32_32x32x16_bf16(pa1, PK(l1, h1), od, 0, 0, 0);
  od = __builtin_amdgcn_mfma_f32_32x32x16_bf16(pa2, PK(l2, h2), od, 0, 0, 0);
  od = __builtin_amdgcn_mfma_f32_32x32x16_bf16(pa3, PK(l3, h3), od, 0, 0, 0);
#undef PK
}
__device__ __forceinline__ void pv_d0(f32x16* o, int vb, bf16x8 pa0, bf16x8 pa1, bf16x8 pa2, bf16x8 pa3) {
  pv_one<0>(o[0], vb, pa0, pa1, pa2, pa3); pv_one<1>(o[1], vb, pa0, pa1, pa2, pa3); pv_one<2>(o[2], vb, pa0, pa1, pa2, pa3); pv_one<3>(o[3], vb, pa0, pa1, pa2, pa3);
}

constexpr int SHM_V = 64 * 128 * 2, SHM_K = 64 * 128 * 2, SHM_ATTN = 2 * SHM_V + 2 * SHM_K + 8 * 64 * 4;
constexpr int NAT_TAB = SHM_ATTN, NAT_TABW = 128, NAT_MISC = NAT_TAB + 15 * NAT_TABW * 4, NAT_LDS = NAT_MISC + 16;
constexpr float C2 = 0.088388347648318440f * 1.4426950408889634f;
constexpr float THR2 = 8.f * 1.4426950408889634f;
constexpr float NEGB = -1e30f;
template <bool WIN> __device__ __forceinline__ void partialSM(f32x16& p0, f32x16& p1, float& m_reg, float& mn, float& alpha, bool rowok, const float* tb, int t0) {
  if (WIN) {
    if (rowok) {
#pragma unroll
      for (int r = 0; r < 16; ++r) { const int cr = (r & 3) + 8 * (r >> 2);
        const float b0 = tb[cr], b1 = tb[cr + 32];
        p0[r] = ((unsigned)(cr + t0) < 16u) ? fmaf(p0[r], C2, b0) : NEGB;
        p1[r] = ((unsigned)(cr + 32 + t0) < 16u) ? fmaf(p1[r], C2, b1) : NEGB; }
    } else {
#pragma unroll
      for (int r = 0; r < 16; ++r) { p0[r] = NEGB; p1[r] = NEGB; }
    }
  } else {
#pragma unroll
    for (int r = 0; r < 16; ++r) { p0[r] *= C2; p1[r] *= C2; }
  }
  float pmax = p0[0];
#pragma unroll
  for (int r = 1; r < 16; ++r) pmax = fmaxf(pmax, p0[r]);
#pragma unroll
  for (int r = 0; r < 16; ++r) pmax = fmaxf(pmax, p1[r]);
  { auto rr = __builtin_amdgcn_permlane32_swap(__float_as_uint(pmax), __float_as_uint(pmax), false, false);
    pmax = fmaxf(__uint_as_float(rr[0]), __uint_as_float(rr[1])); }
  if (__builtin_expect(__all(pmax - m_reg <= THR2), 1)) { mn = m_reg; alpha = 1.f; }
  else { mn = fmaxf(m_reg, pmax); alpha = __builtin_amdgcn_exp2f(m_reg - mn); m_reg = mn; }
#pragma unroll
  for (int r = 0; r < 16; ++r) { p0[r] -= mn; p1[r] -= mn; }
#pragma unroll
  for (int r = 0; r < 16; ++r) p0[r] = __builtin_amdgcn_exp2f(p0[r]);
}
__device__ __forceinline__ void natten_unit(const bf16* __restrict__ P, bf16* __restrict__ Y, const float* __restrict__ rpbh, long qrow0, long crow0, long wrow0, int h, int NT, bool win, int r0, int ws0, char* lds, int tid) {
  const int wid = __builtin_amdgcn_readfirstlane(tid >> 6), lane = tid & 63, r32 = lane & 31, hi = lane >> 5;
  bf16* V_lds = (bf16*)lds; bf16* K_lds = (bf16*)(lds + 2 * SHM_V);
  float* ws = (float*)(lds + 2 * SHM_V + 2 * SHM_K) + wid * 64; float* li_l = ws; float* al_l = ws + 32;
  float* tab = (float*)(lds + NAT_TAB);
  __syncthreads();
  if (win) { for (int i = tid; i < 15 * NAT_TABW; i += 512) { const int dr = i >> 7, dc = (i & 127) - 48; tab[i] = (dc >= 0 && dc <= 30) ? rpbh[dr * 31 + dc] * 1.4426950408889634f : 0.f; } }
  float m_reg = -1e30f, l_reg = 0; f32x16 o[4] = {}; bf16x8 qr[8];
  { const char* Qb = (const char*)(P + (size_t)(qrow0 + wid * 32) * NINP + PC_CQ + h * 128); const unsigned qoff = (unsigned)((r32 * NINP + hi * 8) * 2);
#pragma unroll
    for (int d0 = 0; d0 < 8; ++d0) qr[d0] = *(const GAS bf16x8*)(Qb + qoff + d0 * 32); }
  const int sr = tid >> 4, sc = (tid & 15) * 8, vst0 = v_st(sr, sc), vst1 = v_st(32 + sr, sc);
  const int vb0 = (int)(uintptr_t)V_lds + v_rd_base(lane);
  const unsigned kvoff = (unsigned)((sr * NINP + h * 128 + sc) * 2);
  const char* Pk = (const char*)(P + PC_CK); const char* Pv = (const char*)(P + PC_CV);
  const int qgr = r0 + (wid >> 1), qc = 32 * (wid & 1) + r32;
  const int rs = min(max(qgr - 4, 0), 24), cs = min(max(qc - 8, 0), 48);
  const int t0 = 4 * hi - cs; const float* tbl = tab + 63 - qc + 4 * hi;
  bf16x8 vs0, vs1, ks0, ks1;
#define TROW(t) ((t) < 4 ? crow0 + 64 * (t) : wrow0 + 64 * ((t) - 4))
#define SLOAD(t) do { const size_t rb_ = (size_t)(TROW(t)) * (NINP * 2); const char* kb_ = Pk + rb_; const char* vb_ = Pv + rb_; \
    vs0 = *(const GAS bf16x8*)(vb_ + kvoff); vs1 = *(const GAS bf16x8*)(vb_ + (size_t)32 * NINP * 2 + kvoff); \
    ks0 = *(const GAS bf16x8*)(kb_ + kvoff); ks1 = *(const GAS bf16x8*)(kb_ + (size_t)32 * NINP * 2 + kvoff); } while (0)
#define SWRITE(b) do { *(bf16x8*)((char*)V_lds + (b) * SHM_V + vst0) = vs0; *(bf16x8*)((char*)V_lds + (b) * SHM_V + vst1) = vs1; const int kc = sc * 2; \
    *(bf16x8*)((char*)K_lds + (b) * SHM_K + KSWZ(sr, kc)) = ks0; *(bf16x8*)((char*)K_lds + (b) * SHM_K + KSWZ(32 + sr, kc)) = ks1; } while (0)
#define RESC(a) do { if (__any((a) < 1.f)) { if (hi == 0) al_l[r32] = (a); asm volatile("s_waitcnt lgkmcnt(0)" ::: "memory"); \
    for (int d = 0; d < 4; ++d) for (int r = 0; r < 16; ++r) o[d][r] *= al_l[crow(r, hi)]; } } while (0)
  f32x16 p0, p1; float mn, al; bf16x8 pa0, pa1, pa2, pa3;
  SLOAD(0); asm volatile("s_waitcnt vmcnt(0)" ::: "memory"); SWRITE(0); SLOAD(1);
  for (int t = 0; t < NT; ++t) {
    const int buf = t & 1;
    asm volatile("s_waitcnt lgkmcnt(0)" ::: "memory"); __syncthreads();
    if (t + 1 < NT) { asm volatile("s_waitcnt vmcnt(0)" ::: "memory"); SWRITE(buf ^ 1); if (t + 2 < NT) SLOAD(t + 2); }
    const int kr_ = ws0 + t - 4; const bool wtile = win && t >= 4; const bool ok_ = (unsigned)(kr_ - rs) < 8u;
    if (!wtile || ok_) {
        SBAR(); qkt(p0, p1, (bf16*)((char*)K_lds + buf * SHM_K), qr, r32, hi);
        if (!wtile) partialSM<false>(p0, p1, m_reg, mn, al, true, tbl, t0);
        else { const int dr_ = min(max(kr_ - qgr + 7, 0), 14); partialSM<true>(p0, p1, m_reg, mn, al, true, tbl + dr_ * NAT_TABW, t0); }
        finishSM(p0, p1, al, l_reg, pa0, pa1, pa2, pa3); SBAR();
        RESC(al);
        pv_d0(o, vb0 + buf * (int)SHM_V, pa0, pa1, pa2, pa3);
    }
  }
  if (hi == 0) li_l[r32] = l_reg; asm volatile("s_waitcnt lgkmcnt(0)" ::: "memory");
  float rli[16];
#pragma unroll
  for (int r = 0; r < 16; ++r) rli[r] = __builtin_amdgcn_rcpf(li_l[crow(r, hi)]);
  char* Ob = (char*)(Y + (size_t)(qrow0 + wid * 32) * 1024 + h * 128); const unsigned ooff = (unsigned)((4 * hi * 1024 + r32) * 2);
#pragma unroll
  for (int r = 0; r < 16; ++r) { const int orow = (r & 3) + 8 * (r >> 2);
#pragma unroll
    for (int d0 = 0; d0 < 4; ++d0) *(GAS bf16*)(Ob + ooff + (orow * 1024 + d0 * 32) * 2) = (bf16)f2bf(o[d0][r] * rli[r]); }
  asm volatile("s_waitcnt vmcnt(0)" ::: "memory");
#undef TROW
#undef SLOAD
#undef SWRITE
#undef RESC
}
}

__device__ __forceinline__ void mixer_phase2(Frame& FF, int l, int rep) {
    Frame F = FF; F.lane = xb_lane(); F.tid = F.wave * 64 + F.lane; const int lane = F.lane, tid = F.tid;
    { const ScanBufs<128> A = bufsA(F.ws); const ScanBufs<64> B = bufsB(F.ws);
      const int gw = F.vcu * NWAVES + F.wave; const bool lastl = (l == DEPTH - 1);
      if (F.vcu < 64) scan_state_block<128>(A, F.vcu, F.wave, lane, tid, F.lds, lastl);
      else if (F.vcu < 96) scan_state_block<64>(B, F.vcu - 64, F.wave, lane, tid, F.lds, lastl); }
    if (F.vcu < 96) {
        VM_WAIT(); __syncthreads();
        if (tid == 0) { __builtin_amdgcn_fence(__ATOMIC_RELEASE, "agent"); VM_WAIT(); __hip_atomic_fetch_add(F.ctl + CW_QUEUE + 64 * (8 + l), 1u, RLX_AGENT); } }
    const bf16* P = (const bf16*)(F.ws + WS_P); bf16* Y = (bf16*)(F.ws + WS_Y) + (size_t)2 * MT * 1024;
    const float* rpb = FIN(12) + (size_t)l * 8 * 15 * 31;
    const int total = (l == DEPTH - 1) ? 256 : 288;
    volatile LAS unsigned* slot = (volatile LAS unsigned*)(F.lds + nat::NAT_MISC);
    gu32* qhead = F.ctl + CW_QUEUE + 64 * (l + 4 * rep);
    for (;;) {
        __syncthreads();
        if (tid == 0) *slot = __hip_atomic_fetch_add(qhead, 1u, RLX_AGENT);
        __syncthreads();
        const int idx = (int)__builtin_amdgcn_readfirstlane(*slot);
        if (idx >= total) break;
        if (idx < 256) { int bh, r0;
            if (idx < 192) { bh = idx / 6; r0 = 4 + 4 * (idx % 6); } else { const int i = idx - 192; bh = i >> 1; r0 = (i & 1) ? 28 : 0; }
            const int b = bh >> 3, h = bh & 7; const int ws0 = (r0 == 0) ? 0 : (r0 == 28 ? 24 : min(r0 - 4, 20)); const int nwin = (r0 == 0 || r0 == 28) ? 8 : 12;
            nat::natten_unit(P, Y, rpb + h * 15 * 31, (long)b * 2048 + 64 * r0, (long)ML + b * 256, (long)b * 2048 + 64 * ws0, h, 4 + nwin, true, r0, ws0, (char*)F.lds, tid);
        } else { const int bh = idx - 256, b = bh >> 3, h = bh & 7;
            nat::natten_unit(P, Y, rpb, (long)ML + b * 256, (long)ML + b * 256, 0, h, 4, false, 0, 0, (char*)F.lds, tid); }
    }
}


#ifndef WGM_IN
#define WGM_IN 4
#endif
#ifndef WGM_BR
#define WGM_BR 4
#endif
#ifndef WGM_OUT
#define WGM_OUT 4
#endif
#ifndef WGM_M1
#define WGM_M1 4
#endif
#ifndef WGM_M2
#define WGM_M2 2
#endif
constexpr int NPH_PRE = 3, NPH_LAYER = 10, NPH = NPH_PRE + DEPTH * NPH_LAYER;
struct Args { const float* in[21]; float* out; unsigned char* ws; int ph_lo, ph_hi, use_bar, pad; };
__global__ void __launch_bounds__(NWAVES * 64, 2) fwd_kernel(Args args) {
    extern __shared__ __attribute__((aligned(16))) unsigned char lds[];
    Frame F;
    F.lds = (LAS unsigned char*)lds;
    F.MISC = (volatile LAS unsigned*)(F.lds + MISC_OFF);
    F.wave = __builtin_amdgcn_readfirstlane((int)threadIdx.x >> 6); F.lane = xb_lane(); F.tid = F.wave * 64 + F.lane;
    F.G = gridDim.x; { const int bx = blockIdx.x; F.vcu = (F.G % 8 == 0) ? (bx % 8) * (F.G / 8) + bx / 8 : bx; }
    F.ws = args.ws; F.ctl = (gu32*)(args.ws + WS_CTL); F.out = args.out;
    F.kin = (kin_t)__builtin_amdgcn_kernarg_segment_ptr();
    for (int u = F.tid; u < (LDS_BYTES - LDSCTL_OFF) / 4; u += NWAVES * 64) ((LAS unsigned*)(F.lds + LDSCTL_OFF))[u] = 0u;
    __syncthreads();
    const bool use_bar = args.use_bar != 0;
    XcdBarrier bar; bar.bar = (unsigned*)(F.ctl + CW_BAR); bar.x = 0; bar.st = nullptr; bar.wave = F.wave;
    if (use_bar) bar = xcd_barrier_post((unsigned*)(F.ctl + CW_BAR), F.MISC + 8);
    const int lo = args.ph_lo, hi = args.ph_hi;
#define IN(k) (lo <= (k) && (k) < hi)
#ifndef REP_KIND
#define REP_KIND -1
#endif
#define RUN(kind, ...) do { _Pragma("nounroll") for (int rep_ = 0; rep_ < ((REP_KIND == (kind)) ? 2 : 1); ++rep_) { __VA_ARGS__; } } while (0)
#define SEAM(k) do { if (IN((k) + 1)) { if (use_bar) { xcd_barrier(bar); if (REP_KIND == 9) xcd_barrier(bar); } else if (F.tid == 0) __hip_atomic_store(F.ctl + CW_TMO, 0xBADBA0u, RLX_AGENT); } } while (0)
    unsigned char* ws = args.ws;
    if (IN(0)) { RUN(0, p0_prologue(F)); SEAM(0); }
    if (IN(1)) { p0b_modreduce(F); SEAM(1); }
    if (IN(2)) { p0c_modulate(F); SEAM(2); }
    for (int l = 0; l < DEPTH; ++l) {
        const int pb = NPH_PRE + l * NPH_LAYER;
        const bool lastl = (l == DEPTH - 1);
        const int Mg = lastl ? ML : MT;
        if (IN(pb + 0)) {
            RUN(1, { pg8::Gemm g{(const bf16*)(ws + WS_H), (const bf16*)(ws + WS_WIN) + (size_t)l * NINP * 2048, MT, NINP, 2048, 0, 0, 2048, 2048}; pg8::StaticOrder S; S.init(MT, NINP, F.G, (int)blockIdx.x, WGM_IN);
            pg8::EpiBf16<0> E{(bf16*)(ws + WS_P), NINP, 0};
            pg8::gemm_phase<pg8::EpiBf16<0>, pg8::StaticOrder, true, true>(F.lds + RING_OFF, g, S, E, F.wave); });
            if (F.G == 256) convert_pocket(F, l + 1, CV_P0, CV_P1, (MT / 256) * (NINP / 256) - 9 * 256);
            SEAM(pb + 0);
        }
        if (IN(pb + 1)) { RUN(2, mixer_phase1(F, l)); SEAM(pb + 1); }
        if (IN(pb + 2)) { mixer_phase2(F, l, 0); if (REP_KIND == 3) mixer_phase2(F, l, 1); if (!use_bar) SEAM(pb + 2); }
        if (IN(pb + 3)) { RUN(4, mixer_phase3(F, l)); SEAM(pb + 3); }
        if (IN(pb + 4)) {
            RUN(5, { pg8::Gemm g{(const bf16*)(ws + WS_Y), (const bf16*)(ws + WS_WBR) + (size_t)l * 3 * 2048 * 1024, ML, 2048, 1024, (size_t)MT * 1024 * 2, (size_t)2048 * 1024 * 2, 1024, 1024}; pg8::SlabOrder<3> S; S.init(ML, 2048, F.G, (int)blockIdx.x, WGM_BR);
            pg8::EpiGate<true> E{(bf16*)(ws + WS_U), 2048, (const bf16*)(ws + WS_P) + PC_GT, NINP, 0};
            pg8::gemm_phase<pg8::EpiGate<true>, pg8::SlabOrder<3>, true, true>(F.lds + RING_OFF, g, S, E, F.wave);
            if (!lastl) { pg8::Gemm g2 = g; g2.M = MC; pg8::SplitKOrder<1, 3> S2; S2.init(MC, 2048, F.G, (int)blockIdx.x, ML / 256, 1024);
                pg8::EpiGate<false> E2{(bf16*)(ws + WS_UC) - (size_t)ML * 2048, 2048, (const bf16*)(ws + WS_P) + PC_GT, NINP, (size_t)MC * 2048};
                pg8::gemm_phase<pg8::EpiGate<false>, pg8::SplitKOrder<1, 3>, true, true>(F.lds + RING_OFF, g2, S2, E2, F.wave); } });
            if (F.G == 256 && !lastl) convert_pocket(F, l + 1, CV_P1, CV_P2, 96);
            SEAM(pb + 4);
        }
        if (IN(pb + 5)) {
            RUN(6, { pg8::Gemm g{(const bf16*)(ws + WS_U), (const bf16*)(ws + WS_WOUT) + (size_t)l * 2048 * 2048, ML, 2048, 2048, 0, 0, 2048, 2048}; pg8::StaticOrder S; S.init(ML, 2048, F.G, (int)blockIdx.x, WGM_OUT);
            pg8::EpiBf16<0> E{(bf16*)(ws + WS_MIX), 2048, 0};
            pg8::gemm_phase<pg8::EpiBf16<0>, pg8::StaticOrder, true, true>(F.lds + RING_OFF, g, S, E, F.wave);
            if (!lastl) { pg8::Gemm g2{(const bf16*)(ws + WS_UC) - (size_t)ML * 2048, (const bf16*)(ws + WS_WOUT) + (size_t)l * 2048 * 2048, MC, 2048, 1024, (size_t)MC * 2048 * 2, 0, 2048, 2048}; pg8::SplitKOrder<2, 3> S2; S2.init(MC, 2048, F.G, (int)blockIdx.x, ML / 256, 1024);
                pg8::EpiBf16<0> E2{(bf16*)(ws + WS_PART) - (size_t)ML * 2048, 2048, (size_t)MC * 2048};
                pg8::gemm_phase<pg8::EpiBf16<0>, pg8::SplitKOrder<2, 3>, true, true>(F.lds + RING_OFF, g2, S2, E2, F.wave); } });
            SEAM(pb + 5);
        }
        if (IN(pb + 6)) { if (REP_KIND == 10) ln_phase(F, l, 2, FIN(15) + l * DM, FIN(16) + l * DM, l, 3, l == 0, false, Mg, true, 6); ln_phase(F, l, 2, FIN(15) + l * DM, FIN(16) + l * DM, l, 3, l == 0, false, Mg, false, 6); SEAM(pb + 6); }
        if (IN(pb + 7)) {
            RUN(7, { pg8::Gemm g{(const bf16*)(ws + WS_H), (const bf16*)(ws + WS_WM1) + (size_t)l * 8192 * 2048, Mg, DFF, 2048, 0, 0, 2048, 2048}; pg8::StaticOrder S; S.init(Mg, DFF, F.G, (int)blockIdx.x, WGM_M1);
            pg8::EpiBf16<2> E{(bf16*)(ws + WS_HM), DFF, 0};
            pg8::gemm_phase<pg8::EpiBf16<2>, pg8::StaticOrder, true, true>(F.lds + RING_OFF, g, S, E, F.wave); });
            if (F.G == 256 && !lastl) convert_pocket(F, l + 1, CV_P2, CV_IL, 128);
            SEAM(pb + 7);
        }
        if (IN(pb + 8)) {
            RUN(8, { pg8::Gemm g{(const bf16*)(ws + WS_HM), (const bf16*)(ws + WS_WM2) + (size_t)l * 2048 * 8192, ML, 2048, DFF, 0, 0, DFF, DFF}; pg8::StaticOrder S; S.init(ML, 2048, F.G, (int)blockIdx.x, WGM_M2);
            pg8::EpiBf16<0> E{(bf16*)(ws + WS_MIX), 2048, 0};
            pg8::gemm_phase<pg8::EpiBf16<0>, pg8::StaticOrder, true, true>(F.lds + RING_OFF, g, S, E, F.wave);
            if (!lastl) { pg8::Gemm g2{(const bf16*)(ws + WS_HM), (const bf16*)(ws + WS_WM2) + (size_t)l * 2048 * 8192, MC, 2048, 1024, 0, 0, DFF, DFF}; pg8::SplitKOrder<8> S2; S2.init(MC, 2048, F.G, (int)blockIdx.x, ML / 256, 1024);
                pg8::EpiBf16<0> E2{(bf16*)(ws + WS_PART) - (size_t)ML * 2048, 2048, (size_t)MC * 2048};
                pg8::gemm_phase<pg8::EpiBf16<0>, pg8::SplitKOrder<8>, true, true>(F.lds + RING_OFF, g2, S2, E2, F.wave); } });
            SEAM(pb + 8);
        }
        if (IN(pb + 9)) { if (REP_KIND == 10) ln_phase(F, l, 5, FIN(17) + l * DM, FIN(18) + l * DM, l + 1, lastl ? -1 : 0, false, lastl, Mg, true, 8); ln_phase(F, l, 5, FIN(17) + l * DM, FIN(18) + l * DM, l + 1, lastl ? -1 : 0, false, lastl, Mg, false, 8); SEAM(pb + 9); }
    }
#undef IN
#undef SEAM
}

#ifndef MK_LAUNCHES
#define MK_LAUNCHES 1
#endif
extern "C" void kernel_launch(void* const* d_in, const int* in_sizes, int n_in, void* d_out, int out_size, void* d_ws, size_t ws_size, hipStream_t stream) {
    static int grid = 0;
    if (grid == 0) {
        if (n_in != 21 || out_size != ML * DM || ws_size < WS_END) { fprintf(stderr, "kernel_launch: unexpected shapes: n_in %d out %d ws %zu (need %zu)\n", n_in, out_size, ws_size, (size_t)WS_END); grid = -1; return; }
        int dev = 0, cus = 0, per_cu = 0;
        if (hipGetDevice(&dev) != hipSuccess || hipDeviceGetAttribute(&cus, hipDeviceAttributeMultiprocessorCount, dev) != hipSuccess) { grid = -1; return; }
        if (hipFuncSetAttribute((const void*)fwd_kernel, hipFuncAttributeMaxDynamicSharedMemorySize, LDS_BYTES) != hipSuccess) { fprintf(stderr, "kernel_launch: hipFuncSetAttribute failed\n"); grid = -1; return; }
        if (hipOccupancyMaxActiveBlocksPerMultiprocessor(&per_cu, (const void*)fwd_kernel, NWAVES * 64, LDS_BYTES) != hipSuccess || per_cu < 1) { fprintf(stderr, "kernel_launch: occupancy query reports %d\n", per_cu); }
        (void)hipGetLastError();
        grid = cus;
    }
    if (grid < 0) return;
    if (hipMemsetAsync((char*)d_ws + WS_CTL, 0, CTL_ZERO_BYTES, stream) != hipSuccess) return;
    Args a{};
    for (int i = 0; i < 21; ++i) a.in[i] = (const float*)d_in[i];
    a.out = (float*)d_out; a.ws = (unsigned char*)d_ws; a.pad = 0;
#if MK_LAUNCHES == 1
    a.ph_lo = 0; a.ph_hi = NPH; a.use_bar = 1;
    hipLaunchKernelGGL(fwd_kernel, dim3(grid), dim3(NWAVES * 64), LDS_BYTES, stream, a);
#else
    for (int p = 0; p < NPH; ++p) { a.ph_lo = p; a.ph_hi = p + 1; a.use_bar = 0; hipLaunchKernelGGL(fwd_kernel, dim3(grid), dim3(NWAVES * 64), LDS_BYTES, stream, a); }
#endif
    const hipError_t le = hipPeekAtLastError();
    if (le != hipSuccess) fprintf(stderr, "kernel_launch: launch failed: %s\n", hipGetErrorName(le));
}
```

```cpp
#define MK_LAUNCHES 1
#include <hip/hip_runtime.h>
#include <hip/hip_bf16.h>
#include <cstdio>
#include <cstdint>

namespace pg8 {
#define PG8_LAS __attribute__((address_space(3)))
typedef unsigned short bf16_t;
typedef short bf16x8 __attribute__((ext_vector_type(8)));
typedef float f32x4 __attribute__((ext_vector_type(4)));
typedef unsigned u32x4 __attribute__((ext_vector_type(4)));
constexpr int BM = 256, BK = 64, HALF = 128, HTB = HALF * BK * 2  , STAGE_BYTES = 8 * HTB, NXCD = 8, WGM = 4;

__host__ __device__ __forceinline__ int lds_byte(int r, int c) { const int st = (r >> 4) * 2 + (c >> 5), rr = r & 15, cc = c & 31, ob = rr * 64 + cc * 2; return st * 1024 + (ob ^ (((ob >> 9) & 1) << 5)); }
__host__ __device__ __forceinline__ void stage_rc(int b, int& R, int& C) { const int st = b / 1024, sb = b % 1024, swz = sb ^ (((sb >> 9) & 1) << 5); R = (st >> 1) * 16 + swz / 64; C = (st & 1) * 32 + (swz % 64) / 2; }
__host__ __device__ __forceinline__ int perm32(int rho) { const int n = rho >> 4, i = rho & 15; return 8 * (i >> 2) + 4 * n + (i & 3); }

__device__ __forceinline__ int xb_lane_pg8() { int z = 0; asm volatile("" : "+v"(z)); return (int)__builtin_amdgcn_mbcnt_hi(~0u, __builtin_amdgcn_mbcnt_lo(~0u, (unsigned)z)); }
struct Unit { int pm, pn, z, k0, zo; };
struct Gemm { const bf16_t* A; const bf16_t* Bt; int M, N, K; size_t zsA, zsB; int lda, ldb; };

struct StaticOrder {
    int nM, nN, nwg, G, c, wgm;
    __host__ __device__ void init(int M, int N, int G_, int c_, int wgm_ = WGM) { nM = M / BM; nN = N / BM; nwg = nM * nN; G = G_; c = c_; wgm = wgm_; }
    __host__ __device__ bool tile(long L, Unit& u) const {
        if (L >= nwg) return false;
        int wgid = (int)L; { const int q = nwg / NXCD, r = nwg % NXCD, xcd = wgid % NXCD, off = wgid / NXCD; wgid = (xcd < r ? xcd * (q + 1) : r * (q + 1) + (xcd - r) * q) + off; }
        const int nig = wgm * nN, gid = wgid / nig, fm = gid * wgm, gsz = (nM - fm) < wgm ? (nM - fm) : wgm;
        u.pm = fm + ((wgid % nig) % gsz); u.pn = (wgid % nig) / gsz; u.z = 0; u.k0 = 0; u.zo = 0; return true;
    }
    __host__ __device__ bool next(int i, Unit& u) const { return tile((long)i * G + c, u); }
    __device__ __forceinline__ void a_ready(const Unit&) const {}
    __device__ __forceinline__ void done(const Unit&) const {}
};
template <int NZ> struct SlabOrder : StaticOrder {
    __host__ __device__ bool next(int i, Unit& u) const { if (!tile((long)(i / NZ) * G + c, u)) return false; u.z = i % NZ; return true; }
};

template <int NS, int NZ = 1> struct SplitKOrder {
    int nM, nN, nwg, G, c, pm0, Kc;
    __host__ __device__ void init(int M, int N, int G_, int c_, int pm0_, int Kc_) { nM = M / BM; nN = N / BM; nwg = nM * nN * NS * NZ; G = G_; c = c_; pm0 = pm0_; Kc = Kc_; }
    __host__ __device__ bool next(int i, Unit& u) const { const long L = (long)i * G + c; if (L >= nwg) return false; const int t = (int)L / (NS * NZ), rem = (int)L % (NS * NZ), z = rem / NS, ks = rem % NS;
        u.pm = pm0 + t / nN; u.pn = t % nN; u.z = z; u.k0 = ks * Kc; u.zo = z * NS + ks; return true; }
    __device__ __forceinline__ void a_ready(const Unit&) const {}
    __device__ __forceinline__ void done(const Unit&) const {}
};
typedef float f32x2_t __attribute__((ext_vector_type(2))); typedef __bf16 bf16x2_t __attribute__((ext_vector_type(2)));
__device__ __forceinline__ unsigned cvt_pk_bf16(float lo, float hi) { const f32x2_t v = {lo, hi}; const bf16x2_t b = __builtin_convertvector(v, bf16x2_t); return __builtin_bit_cast(unsigned, b); }
__device__ __forceinline__ float bf_lo(unsigned w) { return __uint_as_float(w << 16); }
__device__ __forceinline__ float bf_hi(unsigned w) { return __uint_as_float(w & 0xffff0000u); }

template <int ACT  > struct EpiBf16 {
    static constexpr bool PERM = true, AFTER_DRAIN = false;
    bf16_t* O; int ldc; size_t zsO;
    __device__ __forceinline__ void operator()(const f32x4 (&acc)[2][2][4][2], const Unit& u, int wr, int wc, int fr, int fq) const {
        const int row0 = u.pm * BM + wr * 64 + fr; const int col0 = u.pn * BM + wc * 32 + 8 * fq;
#pragma unroll
        for (int ai = 0; ai < 2; ++ai)
#pragma unroll
            for (int m = 0; m < 4; ++m) { bf16_t* rowp = O + (size_t)u.zo * zsO + (size_t)(row0 + ai * HALF + m * 16) * ldc + col0;
#pragma unroll
                for (int bj = 0; bj < 2; ++bj) { f32x4 v0 = acc[ai][bj][m][0], v1 = acc[ai][bj][m][1];
                    if (ACT == 2) {
#pragma unroll
                        for (int j = 0; j < 4; ++j) { const float a = fmaxf(v0[j], 0.f), b = fmaxf(v1[j], 0.f); v0[j] = a * a; v1[j] = b * b; } }
                    u32x4 w; w.x = cvt_pk_bf16(v0[0], v0[1]); w.y = cvt_pk_bf16(v0[2], v0[3]); w.z = cvt_pk_bf16(v1[0], v1[1]); w.w = cvt_pk_bf16(v1[2], v1[3]);
                    *(u32x4*)(rowp + bj * HALF) = w; } }
    }
};
struct EpiF32 {
    static constexpr bool PERM = false, AFTER_DRAIN = false;
    float* C; int ldc; size_t zsC;
    __device__ __forceinline__ void operator()(const f32x4 (&acc)[2][2][4][2], const Unit& u, int wr, int wc, int fr, int fq) const {
        const int row0 = u.pm * BM + wr * 64 + fr, col0 = u.pn * BM + wc * 32 + 4 * fq;
#pragma unroll
        for (int ai = 0; ai < 2; ++ai)
#pragma unroll
            for (int m = 0; m < 4; ++m) { float* rowp = C + (size_t)u.zo * zsC + (size_t)(row0 + ai * HALF + m * 16) * ldc + col0;
#pragma unroll
                for (int bj = 0; bj < 2; ++bj)
#pragma unroll
                    for (int n = 0; n < 2; ++n) *(f32x4*)(rowp + bj * HALF + n * 16) = acc[ai][bj][m][n]; }
    }
};
template <bool ACCUM> struct EpiGate {
    static constexpr bool PERM = true, AFTER_DRAIN = false;
    bf16_t* U; int ldc; const bf16_t* GT; int ldg; size_t zsU;
    __device__ __forceinline__ void operator()(const f32x4 (&acc)[2][2][4][2], const Unit& u, int wr, int wc, int fr, int fq) const {
        const int row0 = u.pm * BM + wr * 64 + fr; const int col0 = u.pn * BM + wc * 32 + 8 * fq;
#pragma unroll
        for (int ai = 0; ai < 2; ++ai)
#pragma unroll
            for (int m = 0; m < 4; ++m) { const size_t row = (size_t)(row0 + ai * HALF + m * 16); bf16_t* rowp = U + (ACCUM ? (size_t)0 : (size_t)u.z * zsU) + row * ldc + col0; const bf16_t* gp = GT + row * ldg + (size_t)u.z * 2048 + col0;
#pragma unroll
                for (int bj = 0; bj < 2; ++bj) { const u32x4 gw = *(const u32x4*)(gp + bj * HALF); u32x4 pw = (u32x4){0u, 0u, 0u, 0u}; if (ACCUM && u.z > 0) pw = *(const u32x4*)(rowp + bj * HALF);
                    const f32x4 v0 = acc[ai][bj][m][0], v1 = acc[ai][bj][m][1]; const float a[8] = {v0[0], v0[1], v0[2], v0[3], v1[0], v1[1], v1[2], v1[3]};
                    float o[8];
#pragma unroll
                    for (int j = 0; j < 4; ++j) { const unsigned g2 = gw[j], p2 = pw[j];
                        const float s0 = __builtin_amdgcn_rcpf(1.f + __expf(-bf_lo(g2))), s1 = __builtin_amdgcn_rcpf(1.f + __expf(-bf_hi(g2)));
                        o[2 * j] = bf_lo(p2) + s0 * a[2 * j]; o[2 * j + 1] = bf_hi(p2) + s1 * a[2 * j + 1]; }
                    u32x4 w; w.x = cvt_pk_bf16(o[0], o[1]); w.y = cvt_pk_bf16(o[2], o[3]); w.z = cvt_pk_bf16(o[4], o[5]); w.w = cvt_pk_bf16(o[6], o[7]);
                    *(u32x4*)(rowp + bj * HALF) = w; } }
    }
};

template <class Epi, class Sched, bool ALIGN_EPI = false, bool SP2 = false>
__device__ __forceinline__ void gemm_phase(PG8_LAS unsigned char* lds, const Gemm g, const Sched& S, const Epi& E, const int wave0) {
    int tid_ = wave0 * 64 + xb_lane_pg8();
    const int tid = tid_, wid = __builtin_amdgcn_readfirstlane(tid >> 6), lane = tid & 63, wr = wid >> 2, wc = wid & 3, fr = lane & 15, fq = lane >> 4;
    const int K = g.K, nt = K / BK;
    unsigned voffA[2], voffB[2];
#pragma unroll
    for (int i = 0; i < 2; ++i) { int R, C; stage_rc(tid * 16 + i * 8192, R, C); const int Rb = Epi::PERM ? ((R & ~31) + perm32(R & 31)) : R;
        voffA[i] = (unsigned)(R * g.lda + C) * 2u; voffB[i] = (unsigned)(Rb * g.ldb + C) * 2u; }
    const size_t kstep = (size_t)(BK * 2);
    const size_t hstepA = (size_t)HALF * g.lda * 2, hstepB = (size_t)HALF * g.ldb * 2;
    const size_t tstepA = 2 * hstepA, tstepB = 2 * hstepB;
    const unsigned ldsw = (unsigned)wid * 1024u;
    const int aoff = lds_byte(wr * 64 + fr, fq * 8), boff = lds_byte(wc * 32 + fr, fq * 8);
#define PG8_SA(b, h) (((b) * 2 + (h)) * HTB)
#define PG8_SB(b, h) ((4 + (b) * 2 + (h)) * HTB)
#define PG8_STAGE(bufoff, gbase, voff) do { _Pragma("unroll") for (int _i = 0; _i < 2; ++_i) \
        __builtin_amdgcn_global_load_lds((const unsigned*)((const char*)(gbase) + (voff)[_i]), (PG8_LAS unsigned*)(lds + (bufoff) + ldsw + _i * 8192), 16, 0, 0); } while (0)
#define PG8_LDA(dst, b, h) do { _Pragma("unroll") for (int m = 0; m < 4; ++m) _Pragma("unroll") for (int k = 0; k < 2; ++k) dst[m][k] = *(const PG8_LAS bf16x8*)(lds + PG8_SA(b, h) + aoff + m * 2048 + k * 1024); } while (0)
#define PG8_LDB(dst, b, h) do { _Pragma("unroll") for (int n = 0; n < 2; ++n) _Pragma("unroll") for (int k = 0; k < 2; ++k) dst[n][k] = *(const PG8_LAS bf16x8*)(lds + PG8_SB(b, h) + boff + n * 2048 + k * 1024); } while (0)
#define PG8_MMA(ai, bj, At, Bt) do { __builtin_amdgcn_s_setprio(1); _Pragma("unroll") for (int m = 0; m < 4; ++m) _Pragma("unroll") for (int n = 0; n < 2; ++n) _Pragma("unroll") for (int k = 0; k < 2; ++k) \
        acc[ai][bj][m][n] = __builtin_amdgcn_mfma_f32_16x16x32_bf16(Bt[n][k], At[m][k], acc[ai][bj][m][n], 0, 0, 0); __builtin_amdgcn_s_setprio(0); } while (0)
#define PG8_WAIT_V(n) asm volatile("s_waitcnt vmcnt(" #n ")" ::: "memory")
#define PG8_WAIT_L(n) asm volatile("s_waitcnt lgkmcnt(" #n ")" ::: "memory")
#define PG8_BAR __builtin_amdgcn_s_barrier()
#define PG8_SCHED __builtin_amdgcn_sched_barrier(0)
    Unit cur, nxt; int ui = 0;
    if (!S.next(0, cur)) return;
    f32x4 acc[2][2][4][2];
#pragma unroll
    for (int a = 0; a < 2; ++a)
#pragma unroll
        for (int b = 0; b < 2; ++b)
#pragma unroll
            for (int m = 0; m < 4; ++m)
#pragma unroll
                for (int n = 0; n < 2; ++n) acc[a][b][m][n] = (f32x4){0.f, 0.f, 0.f, 0.f};
    bf16x8 At[4][2], B0[2][2], B1[2][2];
    const char* cA = (const char*)g.A + (size_t)cur.z * g.zsA + (size_t)cur.pm * tstepA + (size_t)cur.k0 * 2; const char* cB = (const char*)g.Bt + (size_t)cur.z * g.zsB + (size_t)cur.pn * tstepB + (size_t)cur.k0 * 2;
    S.a_ready(cur);
    if constexpr (SP2) {
        PG8_STAGE(PG8_SB(0, 0), cB, voffB); PG8_STAGE(PG8_SB(0, 1), cB + hstepB, voffB); PG8_STAGE(PG8_SA(0, 0), cA, voffA); PG8_STAGE(PG8_SA(0, 1), cA + hstepA, voffA);
        if (wr == 1) PG8_BAR;
        PG8_WAIT_V(2); PG8_BAR;
        PG8_STAGE(PG8_SB(1, 0), cB + kstep, voffB); PG8_STAGE(PG8_SA(1, 0), cA + kstep, voffA); PG8_STAGE(PG8_SB(1, 1), cB + hstepB + kstep, voffB);
        PG8_WAIT_V(6); PG8_BAR;
    } else {
        PG8_STAGE(PG8_SB(0, 0), cB, voffB); PG8_STAGE(PG8_SA(0, 0), cA, voffA); PG8_STAGE(PG8_SB(0, 1), cB + hstepB, voffB); PG8_STAGE(PG8_SA(0, 1), cA + hstepA, voffA);
        if (wr == 1) PG8_BAR;
        PG8_WAIT_V(4); PG8_BAR;
        PG8_STAGE(PG8_SB(1, 0), cB + kstep, voffB); PG8_STAGE(PG8_SA(1, 0), cA + kstep, voffA); PG8_STAGE(PG8_SB(1, 1), cB + hstepB + kstep, voffB);
        PG8_WAIT_V(6); PG8_BAR;
    }
    for (;;) {
        const bool has_next = S.next(ui + 1, nxt);
        const char* nA = has_next ? (const char*)g.A + (size_t)nxt.z * g.zsA + (size_t)nxt.pm * tstepA + (size_t)nxt.k0 * 2 : cA; const char* nB = has_next ? (const char*)g.Bt + (size_t)nxt.z * g.zsB + (size_t)nxt.pn * tstepB + (size_t)nxt.k0 * 2 : cB;
        for (int t = 0; t < nt; t += 2) {
            const bool last = (t == nt - 2);
            const char* a1 = cA + (size_t)(t + 1) * kstep;
            const char* a2 = last ? nA : cA + (size_t)(t + 2) * kstep; const char* b2 = last ? nB : cB + (size_t)(t + 2) * kstep;
            const char* a3 = a2 + kstep; const char* b3 = b2 + kstep;
            if (last && has_next) S.a_ready(nxt);
            if constexpr (SP2) {
            PG8_LDB(B0, 0, 0); PG8_LDB(B1, 0, 1); PG8_SCHED; PG8_LDA(At, 0, 0); PG8_STAGE(PG8_SA(1, 1), a1 + hstepA, voffA);
            PG8_WAIT_V(8); PG8_WAIT_L(0); PG8_BAR; PG8_MMA(0, 0, At, B0); PG8_MMA(0, 1, At, B1); PG8_BAR; PG8_SCHED;
            PG8_LDA(At, 0, 1); PG8_STAGE(PG8_SB(0, 0), b2, voffB); PG8_STAGE(PG8_SB(0, 1), b2 + hstepB, voffB); PG8_STAGE(PG8_SA(0, 0), a2, voffA);
            PG8_WAIT_V(8); PG8_WAIT_L(0); PG8_BAR; PG8_MMA(1, 0, At, B0); PG8_MMA(1, 1, At, B1); PG8_BAR; PG8_SCHED;
            PG8_LDB(B0, 1, 0); PG8_LDB(B1, 1, 1); PG8_SCHED; PG8_LDA(At, 1, 0); PG8_STAGE(PG8_SA(0, 1), a2 + hstepA, voffA);
            PG8_WAIT_V(8); PG8_WAIT_L(0); PG8_BAR; PG8_MMA(0, 0, At, B0); PG8_MMA(0, 1, At, B1); PG8_BAR; PG8_SCHED;
            PG8_LDA(At, 1, 1); PG8_STAGE(PG8_SB(1, 0), b3, voffB); PG8_STAGE(PG8_SB(1, 1), b3 + hstepB, voffB); PG8_STAGE(PG8_SA(1, 0), a3, voffA);
            PG8_WAIT_V(8); PG8_WAIT_L(0); PG8_BAR; PG8_MMA(1, 0, At, B0); PG8_MMA(1, 1, At, B1); PG8_BAR; PG8_SCHED;
            } else {
            PG8_LDB(B0, 0, 0); PG8_SCHED; PG8_LDA(At, 0, 0); PG8_STAGE(PG8_SA(1, 1), a1 + hstepA, voffA);
            PG8_WAIT_L(8); PG8_BAR; PG8_WAIT_L(0); PG8_MMA(0, 0, At, B0); PG8_BAR; PG8_SCHED;
            PG8_LDB(B1, 0, 1); PG8_STAGE(PG8_SB(0, 0), b2, voffB);
            PG8_BAR; PG8_WAIT_L(0); PG8_MMA(0, 1, At, B1); PG8_BAR;
            PG8_LDA(At, 0, 1); PG8_STAGE(PG8_SA(0, 0), a2, voffA);
            PG8_BAR; PG8_WAIT_L(0); PG8_MMA(1, 0, At, B0); PG8_BAR; PG8_SCHED;
            PG8_STAGE(PG8_SB(0, 1), b2 + hstepB, voffB);
            PG8_WAIT_V(6); PG8_BAR; PG8_MMA(1, 1, At, B1); PG8_BAR;
            PG8_LDB(B0, 1, 0); PG8_SCHED; PG8_LDA(At, 1, 0); PG8_STAGE(PG8_SA(0, 1), a2 + hstepA, voffA);
            PG8_WAIT_L(8); PG8_BAR; PG8_WAIT_L(0); PG8_MMA(0, 0, At, B0); PG8_BAR; PG8_SCHED;
            PG8_LDB(B1, 1, 1); PG8_STAGE(PG8_SB(1, 0), b3, voffB);
            PG8_BAR; PG8_WAIT_L(0); PG8_MMA(0, 1, At, B1); PG8_BAR;
            PG8_LDA(At, 1, 1); PG8_STAGE(PG8_SA(1, 0), a3, voffA);
            PG8_BAR; PG8_WAIT_L(0); PG8_MMA(1, 0, At, B0); PG8_BAR; PG8_SCHED;
            PG8_STAGE(PG8_SB(1, 1), b3 + hstepB, voffB);
            PG8_WAIT_V(6); PG8_BAR; PG8_MMA(1, 1, At, B1); PG8_BAR;
            }
        }
        if constexpr (ALIGN_EPI) { if (wr == 0) PG8_BAR; }
        if constexpr (!Epi::AFTER_DRAIN) { E(acc, cur, wr, wc, fr, fq); S.done(cur); }
        if (!has_next) break;
#pragma unroll
        for (int a = 0; a < 2; ++a)
#pragma unroll
            for (int b = 0; b < 2; ++b)
#pragma unroll
                for (int m = 0; m < 4; ++m)
#pragma unroll
                    for (int n = 0; n < 2; ++n) acc[a][b][m][n] = (f32x4){0.f, 0.f, 0.f, 0.f};
        cur = nxt; cA = nA; cB = nB; ++ui;
        if constexpr (ALIGN_EPI) { if (wr == 1) PG8_BAR; }
    }
    PG8_WAIT_V(0);
    if constexpr (!ALIGN_EPI) { if (wr == 0) PG8_BAR; }
    PG8_BAR;
    if constexpr (Epi::AFTER_DRAIN) { E.fused(acc, cur, wr, wc, fr, fq, lds, wid, lane); S.done(cur); }
#undef PG8_SA
#undef PG8_SB
#undef PG8_STAGE
#undef PG8_LDA
#undef PG8_LDB
#undef PG8_MMA
#undef PG8_WAIT_V
#undef PG8_WAIT_L
#undef PG8_BAR
#undef PG8_SCHED
}
}

constexpr int DM = 2048, NB = 4, SEQ = 2048, DEPTH = 4, GW = 64, CTXL = 256, DFF = 8192;
constexpr int ML = NB * SEQ, MC = NB * CTXL, MT = ML + MC;
constexpr int NIN = 17440, NINP = 17664;
constexpr int NHEAD = 8;
constexpr float LN_EPS = 1e-5f, RMS_EPS = 1e-6f;
constexpr float DN_ALPHA = 1.6817928305074290f;
constexpr int PC_AQ = 0, PC_AI = 1024, PC_AG = 2048, PC_AFF = 3072, PC_AFB = 4096, PC_BQ = 5120, PC_BK = 5632, PC_BV = 6144, PC_BG = 7168,
              PC_CQ = 8192, PC_CK = 9216, PC_CV = 10240, PC_GT = 11264, PC_GK = 17408;
__host__ __device__ __forceinline__ int in_src_col(int n) { return n < 8192 ? n : (n < 17408 ? n + 32 : (n < 17440 ? 8192 + (n - 17408) : -1)); }

constexpr size_t MiB = 1u << 20;
constexpr size_t WS_CTL = 0, CTL_ZERO_BYTES = 1 * MiB;
constexpr size_t WS_MODP = 1 * MiB;
constexpr size_t WS_MOD = WS_MODP + 16 * MiB;
constexpr size_t WS_TAB = WS_MOD + 1 * MiB;
constexpr size_t TAB_LB = 0, TAB_RR = 32768, TAB_RC = 32768 + 4096;
constexpr size_t WS_WIN = WS_TAB + 1 * MiB;
constexpr size_t WS_WBR = WS_WIN + 277 * MiB;
constexpr size_t WS_WOUT = WS_WBR + 48 * MiB;
constexpr size_t WS_WM1 = WS_WOUT + 32 * MiB;
constexpr size_t WS_WM2 = WS_WM1 + 128 * MiB;
constexpr size_t WS_XS = WS_WM2 + 128 * MiB;
constexpr size_t WS_H = WS_XS + 72 * MiB;
constexpr size_t WS_P = WS_H + 36 * MiB;
constexpr size_t WS_Y = WS_P + 311 * MiB;
constexpr size_t WS_U = WS_Y + 54 * MiB;
constexpr size_t WS_MIX = WS_U + 36 * MiB;
constexpr size_t WS_HM = WS_MIX + 72 * MiB;
constexpr size_t WS_SCAN = WS_HM + 144 * MiB;
constexpr size_t WS_PART = WS_SCAN + 400 * MiB;
constexpr size_t WS_UC = WS_PART + 96 * MiB;
constexpr size_t WS_END = WS_UC + 12 * MiB;
static_assert((size_t)4 * NINP * 2048 * 2 <= 277 * MiB && (size_t)MT * NINP * 2 <= 311 * MiB, "ws map");

constexpr int RING_OFF = 0, RING_BYTES = 131072;
constexpr int LDS_BYTES = 163840;
constexpr int LDSCTL_OFF = LDS_BYTES - 1024, MISC_OFF = LDSCTL_OFF + 320;
constexpr int NWAVES = 8;

#define GAS __attribute__((address_space(1)))
#define LAS __attribute__((address_space(3)))
typedef unsigned short bf16;
typedef unsigned v4u __attribute__((ext_vector_type(4)));
typedef unsigned v2u __attribute__((ext_vector_type(2)));
typedef float f32x4 __attribute__((ext_vector_type(4)));
typedef float f32x2 __attribute__((ext_vector_type(2)));
typedef short bf16x8 __attribute__((ext_vector_type(8)));
typedef GAS unsigned gu32;
#define RLX_AGENT __ATOMIC_RELAXED, __HIP_MEMORY_SCOPE_AGENT
#define LDS_WAIT() asm volatile("s_waitcnt lgkmcnt(0)" ::: "memory")
#define VM_WAIT() asm volatile("s_waitcnt vmcnt(0)" ::: "memory")
typedef float f32x2_t __attribute__((ext_vector_type(2))); typedef __bf16 bf16x2_t __attribute__((ext_vector_type(2)));
__device__ __forceinline__ unsigned pk2(float lo, float hi) { const f32x2_t v = {lo, hi}; const bf16x2_t b = __builtin_convertvector(v, bf16x2_t); return __builtin_bit_cast(unsigned, b); }
__device__ __forceinline__ unsigned f2bf(float f) { return pk2(f, 0.f) & 0xffffu; }
__device__ __forceinline__ float bflo(unsigned w) { return __uint_as_float(w << 16); }
__device__ __forceinline__ float bfhi(unsigned w) { return __uint_as_float(w & 0xffff0000u); }
__device__ __forceinline__ float bf2f(bf16 h) { return __uint_as_float(((unsigned)h) << 16); }
__device__ __forceinline__ float sigmoidf_(float x) { return __builtin_amdgcn_rcpf(1.f + __expf(-x)); }
__device__ __forceinline__ float wave_sum(float v) {
#pragma unroll
    for (int o = 1; o < 64; o <<= 1) v += __shfl_xor(v, o);
    return v;
}
constexpr int CW_TMO = 0, CW_CODE = 1, CW_BAR = 4096, CW_QUEUE = 16384;

#define XB_TMO      128
#define XB_XCNT(j)  (256  + 64 * (j))
#define XB_XSUB(j)  (1280 + 64 * (j))
#define XB_XGEN(j)  (2304 + 64 * (j))
#define XB_TOP      3328
#define XB_TOPGEN   3392
#define XCD_BAR_WORDS 3456
#define XB_SPIN_CAP (1u << 18)

__device__ __forceinline__ unsigned xb_ld(unsigned* p)              { return __hip_atomic_load(p, __ATOMIC_RELAXED, __HIP_MEMORY_SCOPE_AGENT); }
__device__ __forceinline__ unsigned xb_add(unsigned* p, unsigned v) { return __hip_atomic_fetch_add(p, v, __ATOMIC_RELAXED, __HIP_MEMORY_SCOPE_AGENT); }
__device__ __forceinline__ unsigned xb_xcc_id() { return (unsigned)__builtin_amdgcn_s_getreg((3 << 11) | 20) & 0xFu; }
#define XB_SPIN(cond, bar) do { unsigned _sp = 0; while (cond) { __builtin_amdgcn_s_sleep(1); \
    if ((++_sp & 255u) == 0u) { if (xb_ld(&(bar)[XB_TMO])) break; if (_sp > XB_SPIN_CAP) { atomicAdd(&(bar)[XB_TMO], 1u); break; } } } } while (0)

__device__ __forceinline__ int xb_lane() { int z = 0; asm volatile("" : "+v"(z)); return (int)__builtin_amdgcn_mbcnt_hi(~0u, __builtin_amdgcn_mbcnt_lo(~0u, (unsigned)z)); }
struct XcdBarrier {
    unsigned* bar; unsigned x;
    int wave;
    volatile LAS unsigned* st;
};

__device__ __forceinline__ XcdBarrier xcd_barrier_post(unsigned* bar, volatile LAS unsigned* st) {
    XcdBarrier b; b.bar = bar; b.x = xb_xcc_id(); b.st = st; b.wave = __builtin_amdgcn_readfirstlane((int)threadIdx.x >> 6);
    if (threadIdx.x == 0) (void)xb_add(&bar[XB_XCNT(b.x)], 1u);
    return b;
}
__device__ __forceinline__ void xcd_barrier_complete(unsigned* bar, unsigned x, unsigned& nloc, unsigned& nx) {
    const unsigned G = gridDim.x * gridDim.y * gridDim.z;
    unsigned sum, cnt, mine, sp = 0u;
    for (;;) {
        sum = 0u; cnt = 0u; mine = 0u;
#pragma unroll
        for (unsigned j = 0; j < 16; ++j) { const unsigned c = xb_ld(&bar[XB_XCNT(j)]); sum += c; cnt += (c > 0u) ? 1u : 0u; mine = (j == x) ? c : mine; }
        if (sum == G) break;
        __builtin_amdgcn_s_sleep(1);
        if ((++sp & 255u) == 0u) { if (xb_ld(&bar[XB_TMO])) break; if (sp > XB_SPIN_CAP) { atomicAdd(&bar[XB_TMO], 1u); break; } }
    }
    nloc = mine > 0u ? mine : 1u; nx = cnt > 0u ? cnt : 1u;
}

__device__ __forceinline__ void xcd_barrier(const XcdBarrier& b) {
    asm volatile("s_waitcnt vmcnt(0)" ::: "memory");
    __syncthreads();
    if (b.wave == 0 && xb_lane() == 0) {
        unsigned* bar = b.bar;
        __builtin_amdgcn_s_waitcnt(0);
        unsigned nloc = b.st[0], nx = b.st[1];
        if (nloc == 0u) { xcd_barrier_complete(bar, b.x, nloc, nx); b.st[0] = nloc; b.st[1] = nx; }
        const unsigned old = xb_add(&bar[XB_XSUB(b.x)], 1u);
        const unsigned gen = old / nloc;
        if (old + 1u == (gen + 1u) * nloc) {
            __builtin_amdgcn_fence(__ATOMIC_RELEASE, "agent");
            asm volatile("s_waitcnt vmcnt(0)" ::: "memory");
            const unsigned og = xb_add(&bar[XB_TOP], 1u);
            const unsigned tg = og / nx;
            if (og + 1u == (tg + 1u) * nx) xb_add(&bar[XB_TOPGEN], 1u);
            else XB_SPIN(xb_ld(&bar[XB_TOPGEN]) == tg, bar);
            __builtin_amdgcn_fence(__ATOMIC_ACQUIRE, "agent");
            xb_add(&bar[XB_XGEN(b.x)], 1u);
            asm volatile("s_waitcnt vmcnt(0)" ::: "memory");
        } else {
            XB_SPIN(xb_ld(&bar[XB_XGEN(b.x)]) == gen, bar);
            __builtin_amdgcn_fence(__ATOMIC_ACQUIRE, "agent");
            asm volatile("s_waitcnt vmcnt(0)" ::: "memory");
        }
    }
    __syncthreads();
}


typedef const float* cfp_t; typedef __attribute__((address_space(4))) const cfp_t* kin_t;
__device__ __forceinline__ kin_t kin_launder(kin_t p) { asm volatile("" : "+s"(p)); return p; }
#define FIN(k) (kin_launder(F.kin)[k])
struct Frame {
    LAS unsigned char* lds;
    volatile LAS unsigned* MISC;
    gu32* ctl;
    int tid, lane, wave;
    int vcu, G;
    unsigned char* ws;
    kin_t kin;
    float* out;
};

__device__ __forceinline__ void p0_transpose_item(const float* W, int ldw, int src_col0, int k0, bf16* WT, int K, int dst_row0, LAS float* scr, int lane) {
    const int kr = lane >> 3, nc = lane & 7;
    f32x4 v[8];
    if (src_col0 >= 0) { const float* wp = W + (size_t)(k0 + kr) * ldw + src_col0 + 4 * nc;
#pragma unroll
        for (int i = 0; i < 8; ++i) v[i] = *(const GAS f32x4*)(wp + (size_t)(8 * i) * ldw);
    } else {
#pragma unroll
        for (int i = 0; i < 8; ++i) v[i] = (f32x4){0.f, 0.f, 0.f, 0.f};
    }
#pragma unroll
    for (int i = 0; i < 8; ++i) { LAS float* d = scr + (8 * i + kr) * 33 + 4 * nc; d[0] = v[i][0]; d[1] = v[i][1]; d[2] = v[i][2]; d[3] = v[i][3]; }
    LDS_WAIT(); asm volatile("" ::: "memory");
    const int c = lane & 7;
#pragma unroll
    for (int j = 0; j < 4; ++j) { const int n = (lane >> 3) + 8 * j; const LAS float* s = scr + (8 * c) * 33 + n;
        v4u o; o.x = pk2(s[0 * 33], s[1 * 33]); o.y = pk2(s[2 * 33], s[3 * 33]); o.z = pk2(s[4 * 33], s[5 * 33]); o.w = pk2(s[6 * 33], s[7 * 33]);
        *(GAS v4u*)(WT + (size_t)(dst_row0 + n) * K + k0 + 8 * c) = o; }
    LDS_WAIT(); asm volatile("" ::: "memory");
}
constexpr int CV_IIN = 32 * (NINP / 32), CV_IBR = 3 * 16 * 64, CV_IOUT = 32 * 64, CV_IM1 = 32 * 256, CV_IM2 = 128 * 64, CV_IL = CV_IIN + CV_IBR + CV_IOUT + CV_IM1 + CV_IM2;
constexpr int CV_P0 = 11168, CV_P1 = 18168, CV_P2 = 27168;
__device__ __forceinline__ void convert_items(Frame& F, int l, int r_lo, int r_hi, int widx, int nw) {
    LAS float* scr = (LAS float*)(F.lds + RING_OFF + F.wave * 8448); const int lane = xb_lane();
    for (int it = r_lo + widx; it < r_hi; it += nw) { int r = it;
        if (r < CV_IIN) { const int nbk = NINP / 32, kb = r / nbk, nb = r % nbk; p0_transpose_item(FIN(6) + (size_t)l * 2048 * NIN, NIN, in_src_col(32 * nb), 64 * kb, (bf16*)(F.ws + WS_WIN) + (size_t)l * NINP * 2048, 2048, 32 * nb, scr, lane); continue; } r -= CV_IIN;
        if (r < CV_IBR) { const int n = r / 1024, rr = r % 1024, kb = rr / 64, nb = rr % 64; p0_transpose_item(FIN(13) + (size_t)(l * 3 + n) * 1024 * 2048, 2048, 32 * nb, 64 * kb, (bf16*)(F.ws + WS_WBR) + (size_t)(l * 3 + n) * 2048 * 1024, 1024, 32 * nb, scr, lane); continue; } r -= CV_IBR;
        if (r < CV_IOUT) { const int kb = r / 64, nb = r % 64; p0_transpose_item(FIN(14) + (size_t)l * 2048 * 2048, 2048, 32 * nb, 64 * kb, (bf16*)(F.ws + WS_WOUT) + (size_t)l * 2048 * 2048, 2048, 32 * nb, scr, lane); continue; } r -= CV_IOUT;
        if (r < CV_IM1) { const int kb = r / 256, nb = r % 256; p0_transpose_item(FIN(19) + (size_t)l * 2048 * 8192, 8192, 32 * nb, 64 * kb, (bf16*)(F.ws + WS_WM1) + (size_t)l * 8192 * 2048, 2048, 32 * nb, scr, lane); continue; } r -= CV_IM1;
        { const int kb = r / 64, nb = r % 64; p0_transpose_item(FIN(20) + (size_t)l * 8192 * 2048, 2048, 32 * nb, 64 * kb, (bf16*)(F.ws + WS_WM2) + (size_t)l * 2048 * 8192, 8192, 32 * nb, scr, lane); }
    }
}
__device__ __forceinline__ void convert_pocket(Frame& F, int lnext, int r_lo, int r_hi, int first_idle) {
    const int c = (int)blockIdx.x; if (lnext >= DEPTH || c < first_idle) return;
    convert_items(F, lnext, r_lo, r_hi, (c - first_idle) * NWAVES + F.wave, ((int)gridDim.x - first_idle) * NWAVES);
}
__device__ __forceinline__ void p0_prologue(Frame& FF) {
    Frame F = FF; F.lane = xb_lane(); F.tid = F.wave * 64 + F.lane;
    LAS float* scr = (LAS float*)(F.lds + RING_OFF + F.wave * 8448);
    LAS float* sil = (LAS float*)(F.lds + RING_OFF + 69632);
    const int gw = F.vcu * NWAVES + F.wave, NGW = F.G * NWAVES;
    for (int i = F.tid; i < 5 * 2048; i += NWAVES * 64) { const int b = i >> 11, k = i & 2047; const float v = (b < 4) ? FIN(1)[b * 2048 + k] : FIN(3)[k]; sil[i] = v * sigmoidf_(v); }
    { float* LB = (float*)(F.ws + WS_TAB + TAB_LB);
      for (int i = gw * 64 + F.lane; i < 2048; i += NGW * 64) { float e[4], mx = -1e30f;
#pragma unroll
          for (int l = 0; l < 4; ++l) { e[l] = FIN(7)[l * 2048 + i]; mx = fmaxf(mx, e[l]); }
          float s = 0.f;
#pragma unroll
          for (int l = 0; l < 4; ++l) { e[l] = expf(e[l] - mx); s += e[l]; }
          const float inv = 1.f / s; float cum = 0.f;
#pragma unroll
          for (int l = 0; l < 4; ++l) { LB[l * 2048 + i] = cum; cum += e[l] * inv; } }
      f32x2* RR = (f32x2*)(F.ws + WS_TAB + TAB_RR); f32x2* RC = (f32x2*)(F.ws + WS_TAB + TAB_RC);
      for (int i = gw * 64 + F.lane; i < 96 * 16; i += NGW * 64) { const int p = i >> 4, j = i & 15; const int pos = p < 32 ? p : p - 32;
          const float fr = expf(-(float)j * (9.210340371976184f / 16.f)); const float ang = (float)pos * fr; const f32x2 cs = {cosf(ang), sinf(ang)};
          if (p < 32) RR[p * 16 + j] = cs; else RC[(p - 32) * 16 + j] = cs; } }
    __syncthreads();
    for (int u = gw; u < 3072; u += NGW) { const int l = u / 768, r = u % 768, cb = r >> 4, ks = r & 15; const int c0 = cb * 256 + 4 * F.lane;
        f32x4 acc[5];
#pragma unroll
        for (int b = 0; b < 5; ++b) acc[b] = (f32x4){0.f, 0.f, 0.f, 0.f};
        const float* wp = FIN(4) + ((size_t)l * 2048 + ks * 128) * 12288 + c0;
#pragma unroll 8
        for (int k = 0; k < 128; ++k) { const f32x4 w = *(const GAS f32x4*)(wp + (size_t)k * 12288);
#pragma unroll
            for (int b = 0; b < 5; ++b) acc[b] += w * sil[b * 2048 + ks * 128 + k]; }
        float* mp = (float*)(F.ws + WS_MODP) + ((size_t)(ks * 4 + l) * 5) * 12288 + c0;
#pragma unroll
        for (int b = 0; b < 5; ++b) *(GAS f32x4*)(mp + (size_t)b * 12288) = acc[b]; }
    convert_items(F, 0, 0, CV_IL, gw, NGW);
    for (int l = 1; l < DEPTH; ++l) convert_items(F, l, 0, F.G == 256 ? CV_P0 : CV_IL, gw, NGW);
}
__device__ __forceinline__ void p0b_modreduce(Frame& FF) {
    Frame F = FF; F.lane = xb_lane(); F.tid = F.wave * 64 + F.lane;
    const float* mp = (const float*)(F.ws + WS_MODP); float* mo = (float*)(F.ws + WS_MOD);
    for (int i = (F.vcu * NWAVES + F.wave) * 64 + F.lane; i < 4 * 5 * 12288; i += F.G * NWAVES * 64) { const int l = i / (5 * 12288), c = i % 12288;
        float s = FIN(5)[l * 12288 + c];
#pragma unroll
        for (int ks = 0; ks < 16; ++ks) s += mp[(size_t)ks * (4 * 5 * 12288) + i];
        mo[i] = s; }
}
__device__ __forceinline__ int row_modb(int row) { return row < ML ? (row >> 11) : 4; }
__device__ __forceinline__ const float* row_input(const Frame& F, int row) { return row < ML ? FIN(0) + (size_t)row * DM : FIN(2) + (size_t)(row - ML) * DM; }
__device__ __forceinline__ void store_modulated(const f32x4 (&v)[8], const float* sc, const float* sh, bf16* hrow, int lane) {
#pragma unroll
    for (int j = 0; j < 8; ++j) { const int c = 4 * lane + 256 * j; const f32x4 s = *(const GAS f32x4*)(sc + c), t = *(const GAS f32x4*)(sh + c);
        const f32x4 o = v[j] * (s + 1.0f) + t; v2u w; w.x = pk2(o[0], o[1]); w.y = pk2(o[2], o[3]); *(GAS v2u*)(hrow + c) = w; }
}
__device__ __forceinline__ void p0c_modulate(Frame& FF) {
    Frame F = FF; F.lane = xb_lane(); F.tid = F.wave * 64 + F.lane;
    const float* mo = (const float*)(F.ws + WS_MOD); bf16* H = (bf16*)(F.ws + WS_H);
    for (int row = F.vcu * NWAVES + F.wave; row < MT; row += F.G * NWAVES) { const float* xr = row_input(F, row); const float* mb = mo + (size_t)row_modb(row) * 12288;
        f32x4 v[8];
#pragma unroll
        for (int j = 0; j < 8; ++j) v[j] = *(const GAS f32x4*)(xr + 4 * F.lane + 256 * j);
        store_modulated(v, mb + 1 * 2048, mb + 0 * 2048, H + (size_t)row * DM, F.lane); }
}
__device__ __forceinline__ void ln_rows(Frame& F, const float* xbase, const float* mixbase, int nslab, float* obase, bf16* hbase, int row0, int nr, bool hm, LAS float* V, int lane, int wave) {
    f32x4 xn[8], mn[8];
    const bool part = nslab > 0;
    const unsigned ol = (unsigned)(16 * lane);
#define LN_UB(p) ([&]() -> const char* { const char* b_ = (const char*)(p); asm volatile("" : "+s"(b_)); return b_; }())
#define LN_LOAD(row) do { const char* xr_ = LN_UB(xbase + (size_t)(row) * DM); _Pragma("unroll") for (int j = 0; j < 8; ++j) xn[j] = *(const GAS f32x4*)(xr_ + ol + 1024 * j); \
        if (!part) { const char* mr_ = LN_UB((const bf16*)mixbase + (size_t)(row) * DM); _Pragma("unroll") for (int j = 0; j < 8; ++j) { const v2u w_ = *(const GAS v2u*)(mr_ + (ol >> 1) + 512 * j); mn[j] = (f32x4){bflo(w_.x), bfhi(w_.x), bflo(w_.y), bfhi(w_.y)}; } } \
        else { const bf16* pr0_ = (const bf16*)mixbase + (size_t)((row) - ML) * DM; _Pragma("unroll") for (int j = 0; j < 8; ++j) mn[j] = (f32x4){0.f, 0.f, 0.f, 0.f}; \
            _Pragma("nounroll") for (int ks = 0; ks < nslab; ++ks) { const char* ps_ = LN_UB(pr0_ + (size_t)ks * MC * DM); _Pragma("unroll") for (int j = 0; j < 8; ++j) { const v2u w_ = *(const GAS v2u*)(ps_ + (ol >> 1) + 512 * j); mn[j] += (f32x4){bflo(w_.x), bfhi(w_.x), bflo(w_.y), bfhi(w_.y)}; } } } } while (0)
    if (nr > 0) LN_LOAD(row0 + wave);
    for (int i = 0; i < nr; ++i) { const int row = row0 + wave + 8 * i;
        f32x4 v[8]; float s = 0.f;
#pragma unroll
        for (int j = 0; j < 8; ++j) { const f32x4 g = *(const LAS f32x4*)(V + 0 * 2048 + 4 * lane + 256 * j); v[j] = xn[j] * DN_ALPHA + g * mn[j]; s += (v[j][0] + v[j][1]) + (v[j][2] + v[j][3]); }
        __builtin_amdgcn_sched_barrier(0);
        if (i + 1 < nr) LN_LOAD(row + 8);
        __builtin_amdgcn_sched_barrier(0);
        const float mean = wave_sum(s) * (1.f / DM); float q = 0.f;
#pragma unroll
        for (int j = 0; j < 8; ++j) { v[j] = v[j] - mean; q += (v[j][0] * v[j][0] + v[j][1] * v[j][1]) + (v[j][2] * v[j][2] + v[j][3] * v[j][3]); }
        const float rstd = 1.0f / sqrtf(wave_sum(q) * (1.f / DM) + LN_EPS);
        char* orow = (char*)(obase + (size_t)row * DM) + ol; char* hrow = (char*)(hbase + (size_t)row * DM) + (ol >> 1);
#pragma unroll
        for (int j = 0; j < 8; ++j) { const f32x4 g = *(const LAS f32x4*)(V + 1 * 2048 + 4 * lane + 256 * j), b = *(const LAS f32x4*)(V + 2 * 2048 + 4 * lane + 256 * j);
            v[j] = v[j] * rstd * g + b; *(GAS f32x4*)(orow + 1024 * j) = v[j];
            if (hm) { const f32x4 sc = *(const LAS f32x4*)(V + 3 * 2048 + 4 * lane + 256 * j), sh = *(const LAS f32x4*)(V + 4 * 2048 + 4 * lane + 256 * j); const f32x4 o = v[j] * sc + sh;
                v2u w; w.x = pk2(o[0], o[1]); w.y = pk2(o[2], o[3]); *(GAS v2u*)(hrow + 512 * j) = w; }
            if (j & 1) __builtin_amdgcn_sched_barrier(0); }
    }
#undef LN_LOAD
#undef LN_UB
}
__device__ __forceinline__ void ln_phase(Frame& FF, int l, int gi, const float* lng, const float* lnb, int lh, int hmod, bool first, bool to_out, int nrows, bool dry, int nslab) {
    Frame F = FF; F.lane = xb_lane(); F.tid = F.wave * 64 + F.lane;
    const float* mo = (const float*)(F.ws + WS_MOD); float* XS = (float*)(F.ws + WS_XS); const float* MIX = (const float*)(F.ws + WS_MIX); bf16* H = dry ? (bf16*)(F.ws + WS_HM + 72 * MiB) : (bf16*)(F.ws + WS_H);
    LAS float* V = (LAS float*)(F.lds + RING_OFF);
    if (F.G != 256) {
        for (int row = F.vcu * NWAVES + F.wave; row < nrows; row += F.G * NWAVES) { const int mb = row_modb(row);
            const float* xr = first ? row_input(F, row) : XS + (size_t)row * DM; const float* gv = mo + ((size_t)l * 5 + mb) * 12288 + gi * 2048;
            f32x4 v[8]; float s = 0.f;
#pragma unroll
            for (int j = 0; j < 8; ++j) { const int c = 4 * F.lane + 256 * j; const f32x4 xv = *(const GAS f32x4*)(xr + c), g = *(const GAS f32x4*)(gv + c); f32x4 mv;
                if (row < ML) { const v2u w_ = *(const GAS v2u*)((const bf16*)MIX + (size_t)row * DM + c); mv = (f32x4){bflo(w_.x), bfhi(w_.x), bflo(w_.y), bfhi(w_.y)}; }
                else { const bf16* pr = (const bf16*)(F.ws + WS_PART) + (size_t)(row - ML) * DM + c; mv = (f32x4){0.f, 0.f, 0.f, 0.f}; for (int ks = 0; ks < nslab; ++ks) { const v2u w_ = *(const GAS v2u*)(pr + (size_t)ks * MC * DM); mv += (f32x4){bflo(w_.x), bfhi(w_.x), bflo(w_.y), bfhi(w_.y)}; } }
                v[j] = xv * DN_ALPHA + g * mv; s += (v[j][0] + v[j][1]) + (v[j][2] + v[j][3]); }
            const float mean = wave_sum(s) * (1.f / DM); float q = 0.f;
#pragma unroll
            for (int j = 0; j < 8; ++j) { v[j] = v[j] - mean; q += (v[j][0] * v[j][0] + v[j][1] * v[j][1]) + (v[j][2] * v[j][2] + v[j][3] * v[j][3]); }
            const float rstd = 1.0f / sqrtf(wave_sum(q) * (1.f / DM) + LN_EPS);
            float* orow = dry ? (float*)(F.ws + WS_HM) + (size_t)row * DM : (to_out ? F.out + (size_t)row * DM : XS + (size_t)row * DM);
#pragma unroll
            for (int j = 0; j < 8; ++j) { const int c = 4 * F.lane + 256 * j; const f32x4 g = *(const GAS f32x4*)(lng + c), b = *(const GAS f32x4*)(lnb + c); v[j] = v[j] * rstd * g + b; *(GAS f32x4*)(orow + c) = v[j]; }
            if (hmod >= 0) { const float* mh = mo + ((size_t)lh * 5 + mb) * 12288; store_modulated(v, mh + (hmod + 1) * 2048, mh + hmod * 2048, H + (size_t)row * DM, F.lane); } }
        return;
    }
    float* obase = dry ? (float*)(F.ws + WS_HM) : (to_out ? F.out : XS);
#pragma unroll 1
    for (int seg = 0; seg < 2; ++seg) {
        if (seg == 1 && nrows <= ML) break;
        const int mb = seg == 0 ? (F.vcu >> 6) : 4;
        __syncthreads();
        { const float* gv = mo + ((size_t)l * 5 + mb) * 12288 + gi * 2048; const float* mh = mo + ((size_t)(hmod >= 0 ? lh : l) * 5 + mb) * 12288; const int c = 4 * F.tid;
          *(LAS f32x4*)(V + 0 * 2048 + c) = *(const GAS f32x4*)(gv + c); *(LAS f32x4*)(V + 1 * 2048 + c) = *(const GAS f32x4*)(lng + c); *(LAS f32x4*)(V + 2 * 2048 + c) = *(const GAS f32x4*)(lnb + c);
          if (hmod >= 0) { *(LAS f32x4*)(V + 3 * 2048 + c) = *(const GAS f32x4*)(mh + (hmod + 1) * 2048 + c) + 1.0f; *(LAS f32x4*)(V + 4 * 2048 + c) = *(const GAS f32x4*)(mh + hmod * 2048 + c); } }
        LDS_WAIT(); __syncthreads();
        if (seg == 0) ln_rows(F, first ? FIN(0) : XS, MIX, 0, obase, H, 32 * F.vcu, 4, hmod >= 0, V, F.lane, F.wave);
        else ln_rows(F, first ? FIN(2) - (size_t)ML * DM : XS, (const float*)(F.ws + WS_PART), nslab, obase, H, ML + 4 * F.vcu, F.wave < 4 ? 1 : 0, hmod >= 0, V, F.lane, F.wave);
    }
}

typedef float f32x16 __attribute__((ext_vector_type(16)));
constexpr int NCH = 144;
constexpr size_t SC_QA = 0, SC_KA = SC_QA + 18 * MiB, SC_EA = SC_KA + 36 * MiB, SC_KTA = SC_EA + 72 * MiB, SC_AEA = SC_KTA + 36 * MiB, SC_BEA = SC_AEA + 2 * MiB, SC_VTA = SC_BEA + 2 * MiB, SC_SPA = SC_VTA + 18 * MiB,
                 SC_QB = SC_SPA + 72 * MiB, SC_KB = SC_QB + 9 * MiB, SC_EB = SC_KB + 9 * MiB, SC_KTB = SC_EB + 36 * MiB, SC_AEB = SC_KTB + 18 * MiB, SC_BEB = SC_AEB + 1 * MiB, SC_VTB = SC_BEB + 1 * MiB, SC_SPB = SC_VTB + 18 * MiB, SC_END = SC_SPB + 36 * MiB;
static_assert(SC_END <= 400 * MiB, "scan scratch");
template <int DK> struct ScanBufs {
    bf16* Q;
    bf16* K;
    unsigned short* E;
    bf16* KT;
    float* AE;
    float* BE;
    bf16* VT;
    bf16* SP;
};
__device__ __forceinline__ ScanBufs<128> bufsA(unsigned char* ws) { unsigned char* s = ws + WS_SCAN; return ScanBufs<128>{(bf16*)(s + SC_QA), (bf16*)(s + SC_KA), (unsigned short*)(s + SC_EA), (bf16*)(s + SC_KTA), (float*)(s + SC_AEA), (float*)(s + SC_BEA), (bf16*)(s + SC_VTA), (bf16*)(s + SC_SPA)}; }
__device__ __forceinline__ ScanBufs<64> bufsB(unsigned char* ws) { unsigned char* s = ws + WS_SCAN; return ScanBufs<64>{(bf16*)(s + SC_QB), (bf16*)(s + SC_QB)  , (unsigned short*)(s + SC_EB), (bf16*)(s + SC_KTB), (float*)(s + SC_AEB), (float*)(s + SC_BEB), (bf16*)(s + SC_VTB), (bf16*)(s + SC_SPB)}; }
typedef _Float16 h2_t __attribute__((ext_vector_type(2)));
__device__ __forceinline__ unsigned pkh2(float a, float b) { const h2_t v = {(_Float16)a, (_Float16)b}; return __builtin_bit_cast(unsigned, v); }
__device__ __forceinline__ float hlo(unsigned w) { return (float)__builtin_bit_cast(h2_t, w)[0]; }
__device__ __forceinline__ float hhi(unsigned w) { return (float)__builtin_bit_cast(h2_t, w)[1]; }
__device__ __forceinline__ float ex2(float x) { return __builtin_amdgcn_exp2f(x); }
__device__ __forceinline__ float clampe(float x) { return __builtin_amdgcn_fmed3f(x, -115.f, 115.f); }
__device__ __forceinline__ float bfe(const v4u& w, int c) { return (c & 1) ? bfhi(w[c >> 1]) : bflo(w[c >> 1]); }
__device__ __forceinline__ float bfe2(const v2u& w, int c) { return (c & 1) ? bfhi(w[c >> 1]) : bflo(w[c >> 1]); }

template <int NC, int CPH> __device__ __forceinline__ void store_groups(LAS v4u* Wl, const v4u (&o)[NC], bf16* hb, size_t HS, int lane) {
#pragma unroll
    for (int c = 0; c < NC; ++c) Wl[lane * NC + c] = o[c];
    LDS_WAIT();
#pragma unroll
    for (int i = 0; i < NC; ++i) { const int sidx = i * 64 + lane; const v4u v = Wl[sidx]; *(GAS v4u*)(hb + (size_t)(sidx / CPH) * HS + (size_t)(sidx % CPH) * 8) = v; }
    LDS_WAIT();
}
template <int DIR> __device__ __forceinline__ void prep_hgrn_f(const ScanBufs<128>& A, const bf16* P, const float* LB, int g, int half, int lane, LAS v4u* Wl) {
    const int ch = half * 512 + 8 * lane, h = ch >> 7, d = ch & 127; const size_t row0 = (size_t)g * 64;
    const bf16* fp = P + row0 * NINP + (DIR ? PC_AFB : PC_AFF) + ch; const bf16* qp = P + row0 * NINP + PC_AQ + ch;
    float lb[8], cum[8];
    { const f32x4 a = *(const GAS f32x4*)(LB + DIR * 1024 + ch), b = *(const GAS f32x4*)(LB + DIR * 1024 + ch + 4);
#pragma unroll
      for (int c = 0; c < 4; ++c) { lb[c] = a[c]; lb[4 + c] = b[c]; } }
#pragma unroll
    for (int c = 0; c < 8; ++c) cum[c] = 0.f;
    unsigned short* Ep = A.E + ((size_t)DIR * MT + row0) * 1024 + ch; bf16* Kp = A.K + ((size_t)DIR * MT + row0) * 1024 + ch;
    bf16* kt = A.KT + (((((size_t)DIR * NCH + g) * 8 + half * 4) * 8) * 128) * 8;
    v4u fn[4], qn[4];
#pragma unroll
    for (int j = 0; j < 4; ++j) { fn[j] = *(const GAS v4u*)(fp + (size_t)((DIR ? 0 : 60) + j) * NINP); qn[j] = *(const GAS v4u*)(qp + (size_t)((DIR ? 0 : 60) + j) * NINP); }
    for (int i8 = 0; i8 < 8; ++i8) { const int t8 = DIR ? i8 : 7 - i8;
        float kp[8][8];
#pragma unroll
        for (int hh = 0; hh < 2; ++hh) { const int hf = DIR ? hh : 1 - hh;
            v4u f[4], qf[4];
#pragma unroll
            for (int j = 0; j < 4; ++j) { f[j] = fn[j]; qf[j] = qn[j]; }
            { const int hgn = 2 * i8 + hh + 1; if (hgn < 16) { const int tb = DIR ? 4 * hgn : 60 - 4 * hgn;
#pragma unroll
                for (int j = 0; j < 4; ++j) { fn[j] = *(const GAS v4u*)(fp + (size_t)(tb + j) * NINP); qn[j] = *(const GAS v4u*)(qp + (size_t)(tb + j) * NINP); } } }
#pragma unroll
            for (int jj = 0; jj < 4; ++jj) { const int j = DIR ? jj : 3 - jj; const int t = t8 * 8 + hf * 4 + j; float ev[8], kv[8];
#pragma unroll
                for (int c = 0; c < 8; ++c) { const float x = bfe(f[j], c); const float sg = sigmoidf_(x); const float la = __log2f(lb[c] + (1.f - lb[c]) * sg); const float k = (1.f - lb[c]) * (1.f - sg);
                    const float xq = bfe(qf[j], c); const float qv = xq * sigmoidf_(xq) * 0.08838834764831845f;
                    const float e = cum[c]; cum[c] += la; kv[c] = k * ex2(e); kp[hf * 4 + j][c] = kv[c]; ev[c] = qv * ex2(fminf(-e, 126.f)); }
                { v4u ew; ew.x = pk2(ev[0], ev[1]); ew.y = pk2(ev[2], ev[3]); ew.z = pk2(ev[4], ev[5]); ew.w = pk2(ev[6], ev[7]); *(GAS v4u*)(Ep + (size_t)t * 1024) = ew; }
                v4u kw; kw.x = pk2(kv[0], kv[1]); kw.y = pk2(kv[2], kv[3]); kw.z = pk2(kv[4], kv[5]); kw.w = pk2(kv[6], kv[7]); *(GAS v4u*)(Kp + (size_t)t * 1024) = kw; } }
        { v4u og[8];
#pragma unroll
          for (int c = 0; c < 8; ++c) { og[c].x = pk2(kp[0][c], kp[1][c]); og[c].y = pk2(kp[2][c], kp[3][c]); og[c].z = pk2(kp[4][c], kp[5][c]); og[c].w = pk2(kp[6][c], kp[7][c]); }
          store_groups<8, 128>(Wl, og, kt + (size_t)t8 * 128 * 8, (size_t)8 * 128 * 8, lane); }
    }
    float* be = A.BE + (((size_t)DIR * NCH + g) * 8 + h) * 128 + d; float* ae = A.AE + (((size_t)DIR * NCH + g) * 8 + h) * 128 + d;
    *(GAS f32x4*)be = (f32x4){cum[0], cum[1], cum[2], cum[3]}; *(GAS f32x4*)(be + 4) = (f32x4){cum[4], cum[5], cum[6], cum[7]};
    *(GAS f32x4*)ae = (f32x4){ex2(cum[0]), ex2(cum[1]), ex2(cum[2]), ex2(cum[3])}; *(GAS f32x4*)(ae + 4) = (f32x4){ex2(cum[4]), ex2(cum[5]), ex2(cum[6]), ex2(cum[7])};
}
template <int DIR> __device__ __forceinline__ void prep_gla_k(const ScanBufs<64>& B, const bf16* P, const float* w2g, const float* b2g, const f32x2* RR, const LAS f32x2* RC  , int g, int half, int lane, LAS v4u* Wl) {
    const int ch = half * 256 + 4 * lane, h = ch >> 6, d = ch & 63; const size_t row0 = (size_t)g * 64;
    float w2[16][4];
#pragma unroll
    for (int r = 0; r < 16; ++r) { const f32x4 w = *(const GAS f32x4*)(w2g + ((size_t)DIR * 16 + r) * 512 + ch); w2[r][0] = w[0]; w2[r][1] = w[1]; w2[r][2] = w[2]; w2[r][3] = w[3]; }
    const f32x4 b2 = *(const GAS f32x4*)(b2g + (size_t)DIR * 512 + ch);
    const bool lat = g < 128; const int grow = g & 31; const int j0 = d & 15; const bool isrow = d < 32; const bool second = (d & 16) != 0;
    f32x2 csr[4];
#pragma unroll
    for (int c = 0; c < 4; ++c) csr[c] = RR[grow * 16 + j0 + c];
    float cum[4] = {0.f, 0.f, 0.f, 0.f};
    const bf16* kp0 = P + row0 * NINP + PC_BK + ch; const bf16* lp0 = P + row0 * NINP + PC_GK + 16 * DIR; const bf16* qp0 = P + row0 * NINP + PC_BQ + ch;
    unsigned short* Ep = B.E + ((size_t)DIR * MT + row0) * 512 + ch; bf16* Kp = B.K + ((size_t)DIR * MT + row0) * 512 + ch;
    bf16* kt = B.KT + (((((size_t)DIR * NCH + g) * 8 + half * 4) * 8) * 64) * 8;
    for (int i8 = 0; i8 < 8; ++i8) { const int t8 = DIR ? i8 : 7 - i8;
        float kp[8][4];
#pragma unroll
        for (int hh = 0; hh < 2; ++hh) { const int hf = DIR ? hh : 1 - hh;
            v2u kr[4], qr2[4]; v4u l0[4], l1[4];
#pragma unroll
            for (int j = 0; j < 4; ++j) { const size_t ro = (size_t)(t8 * 8 + hf * 4 + j) * NINP; kr[j] = *(const GAS v2u*)(kp0 + ro); qr2[j] = *(const GAS v2u*)(qp0 + ro); l0[j] = *(const GAS v4u*)(lp0 + ro); l1[j] = *(const GAS v4u*)(lp0 + ro + 8); }
#pragma unroll
            for (int jj = 0; jj < 4; ++jj) { const int j = DIR ? jj : 3 - jj; const int t = t8 * 8 + hf * 4 + j; float ev[4], kv[4];
                f32x2 csc[4];
                { const LAS f32x4* rc4 = (const LAS f32x4*)(RC + t * 16 + j0); const f32x4 ra = rc4[0], rb = rc4[1];
                  csc[0] = isrow ? csr[0] : (f32x2){ra[0], ra[1]}; csc[1] = isrow ? csr[1] : (f32x2){ra[2], ra[3]}; csc[2] = isrow ? csr[2] : (f32x2){rb[0], rb[1]}; csc[3] = isrow ? csr[3] : (f32x2){rb[2], rb[3]}; }
#pragma unroll
                for (int c = 0; c < 4; ++c) { float x = b2[c];
#pragma unroll
                    for (int r = 0; r < 8; ++r) { x += bfe(l0[j], r) * w2[r][c]; x += bfe(l1[j], r) * w2[8 + r][c]; }
                    const float la = (fminf(x, 0.f) * 1.4426950408889634f - __log2f(1.f + __expf(-fabsf(x)))) * 0.0625f;
                    float k = bfe2(kr[j], c), q = bfe2(qr2[j], c);
                    if (lat) { const f32x2 cs = csc[c]; const float pt = __shfl_xor(k, 4), pq = __shfl_xor(q, 4); k = k * cs.x + (second ? pt : -pt) * cs.y; q = q * cs.x + (second ? pq : -pq) * cs.y; }
                    const float e = cum[c]; cum[c] += la; kv[c] = k * ex2(e); kp[hf * 4 + j][c] = kv[c]; ev[c] = q * 0.125f * ex2(fminf(-e, 126.f)); }
                { v2u ew; ew.x = pk2(ev[0], ev[1]); ew.y = pk2(ev[2], ev[3]); *(GAS v2u*)(Ep + (size_t)t * 512) = ew; }
                { v2u kw; kw.x = pk2(kv[0], kv[1]); kw.y = pk2(kv[2], kv[3]); *(GAS v2u*)(Kp + (size_t)t * 512) = kw; } } }
        { v4u og[4];
#pragma unroll
          for (int c = 0; c < 4; ++c) { og[c].x = pk2(kp[0][c], kp[1][c]); og[c].y = pk2(kp[2][c], kp[3][c]); og[c].z = pk2(kp[4][c], kp[5][c]); og[c].w = pk2(kp[6][c], kp[7][c]); }
          store_groups<4, 64>(Wl, og, kt + (size_t)t8 * 64 * 8, (size_t)8 * 64 * 8, lane); }
    }
    float* be = B.BE + (((size_t)DIR * NCH + g) * 8 + h) * 64 + d; float* ae = B.AE + (((size_t)DIR * NCH + g) * 8 + h) * 64 + d;
    *(GAS f32x4*)be = (f32x4){cum[0], cum[1], cum[2], cum[3]}; *(GAS f32x4*)ae = (f32x4){ex2(cum[0]), ex2(cum[1]), ex2(cum[2]), ex2(cum[3])};
}
__device__ __forceinline__ void prep_vt(const bf16* P, int vcol, bf16* VT, int g, int half, int lane, LAS v4u* Wl) {
    const int ch = half * 512 + 8 * lane, h = ch >> 7, d = ch & 127; const size_t row0 = (size_t)g * 64; const bf16* vp = P + row0 * NINP + vcol + ch; bf16* vt = VT + ((((size_t)g * 8 + half * 4) * 8) * 128) * 8;
    for (int t8 = 0; t8 < 8; ++t8) { v4u f[8];
#pragma unroll
        for (int j = 0; j < 8; ++j) f[j] = *(const GAS v4u*)(vp + (size_t)(t8 * 8 + j) * NINP);
        v4u og[8];
#pragma unroll
        for (int c = 0; c < 8; ++c) {
#pragma unroll
            for (int q = 0; q < 4; ++q) { const unsigned a = f[2 * q][c >> 1], b = f[2 * q + 1][c >> 1]; og[c][q] = (c & 1) ? ((a >> 16) | (b & 0xffff0000u)) : ((a & 0xffffu) | (b << 16)); } }
        store_groups<8, 128>(Wl, og, vt + (size_t)t8 * 128 * 8, (size_t)8 * 128 * 8, lane); }
}
__device__ __forceinline__ void mixer_phase1(Frame& FF, int l) {
    Frame F = FF; F.lane = xb_lane(); F.tid = F.wave * 64 + F.lane;
    const bf16* P = (const bf16*)(F.ws + WS_P);
    const ScanBufs<128> A = bufsA(F.ws); const ScanBufs<64> B = bufsB(F.ws);
    const float* LB = (const float*)(F.ws + WS_TAB + TAB_LB) + (size_t)l * 2048;
    const f32x2* RR = (const f32x2*)(F.ws + WS_TAB + TAB_RR); const f32x2* RC = (const f32x2*)(F.ws + WS_TAB + TAB_RC);
    const int gw = F.vcu * NWAVES + F.wave, NGW = F.G * NWAVES;
    LAS v4u* Wl = (LAS v4u*)(F.lds + F.wave * 8192);
    LAS f32x2* RCl = (LAS f32x2*)(F.lds + 65536);
    { const v4u v = *(const GAS v4u*)((const char*)RC + F.tid * 16); *(LAS v4u*)((LAS unsigned char*)RCl + F.tid * 16) = v; }
    LDS_WAIT(); __syncthreads();
    constexpr int U_F = NCH * 4, U_K = NCH * 4, U_V = NCH * 4, U_QA = 0, U_QB = 0, U_ALL = U_F + U_K + U_V + U_QA + U_QB;
    int u0 = -1;
    const bool deal = (F.G == 256); if (deal) { const int w = F.wave, cu = F.vcu;
        if (w < 4) u0 = w * 256 + cu;
        else if (w == 4 && cu < 128) u0 = 1024 + cu;
        else { const int li = cu < 128 ? cu * 3 + (w - 5) : 384 + (cu - 128) * 4 + (w - 4); if (U_F + U_K + li < U_ALL) u0 = U_F + U_K + li; }
    }
    const int ustep = deal ? 1 : NGW; const int uend = deal ? 1 : U_ALL;
    for (int ui = deal ? 0 : gw; ui < uend; ui += ustep) { const int u = deal ? u0 : ui; if (u < 0) continue;
        int r = u; const int lane = xb_lane();
        if (r < U_F) { const int half = r & 1, dir = (r >> 1) & 1, g = r >> 2; if (dir == 0) prep_hgrn_f<0>(A, P, LB, g, half, lane, Wl); else prep_hgrn_f<1>(A, P, LB, g, half, lane, Wl); continue; } r -= U_F;
        if (r < U_K) { const int half = r & 1, dir = (r >> 1) & 1, g = r >> 2; const float* w2g = FIN(9) + (size_t)l * 2 * 16 * 512; const float* b2g = FIN(10) + (size_t)l * 2 * 512;
            if (dir == 0) prep_gla_k<0>(B, P, w2g, b2g, RR, RCl, g, half, lane, Wl); else prep_gla_k<1>(B, P, w2g, b2g, RR, RCl, g, half, lane, Wl); continue; } r -= U_K;
        if (r < U_V) { const int half = r & 1, mix = (r >> 1) & 1, g = r >> 2; if (mix == 0) prep_vt(P, PC_AI, A.VT, g, half, lane, Wl); else prep_vt(P, PC_BV, B.VT, g, half, lane, Wl); continue; } r -= U_V;
        if (r < U_QA) { const int half = r & 1, g = r >> 1; const int ch = half * 512 + 8 * lane; const size_t row0 = (size_t)g * 64;
            for (int t8 = 0; t8 < 8; ++t8) { v4u f[8];
#pragma unroll
                for (int j = 0; j < 8; ++j) f[j] = *(const GAS v4u*)(P + (row0 + t8 * 8 + j) * NINP + PC_AQ + ch);
#pragma unroll
                for (int j = 0; j < 8; ++j) { float q[8];
#pragma unroll
                    for (int c = 0; c < 8; ++c) { const float x = bfe(f[j], c); q[c] = x * sigmoidf_(x) * 0.08838834764831845f; }
                    v4u o; o.x = pk2(q[0], q[1]); o.y = pk2(q[2], q[3]); o.z = pk2(q[4], q[5]); o.w = pk2(q[6], q[7]); *(GAS v4u*)(A.Q + (row0 + t8 * 8 + j) * 1024 + ch) = o; } }
            continue; } r -= U_QA;
        { const int g = r; const int ch = 8 * lane, d = ch & 63; const size_t row0 = (size_t)g * 64;
          const bool lat = g < 128; const int grow = g & 31; const int j0 = d & 15; const bool isrow = d < 32; const bool second = (d & 16) != 0;
          f32x2 csr[8];
#pragma unroll
          for (int c = 0; c < 8; ++c) csr[c] = RR[grow * 16 + j0 + c];
          for (int t8 = 0; t8 < 8; ++t8) { v4u f[8];
#pragma unroll
              for (int j = 0; j < 8; ++j) f[j] = *(const GAS v4u*)(P + (row0 + t8 * 8 + j) * NINP + PC_BQ + ch);
#pragma unroll
              for (int j = 0; j < 8; ++j) { float q[8]; const int t = t8 * 8 + j;
#pragma unroll
                  for (int c = 0; c < 8; ++c) { float x = bfe(f[j], c);
                      if (lat) { const f32x2 cs = isrow ? csr[c] : RC[t * 16 + j0 + c]; const float pt = __shfl_xor(x, 2); x = x * cs.x + (second ? pt : -pt) * cs.y; }
                      q[c] = x * 0.125f; }
                  v4u o; o.x = pk2(q[0], q[1]); o.y = pk2(q[2], q[3]); o.z = pk2(q[4], q[5]); o.w = pk2(q[6], q[7]); *(GAS v4u*)(B.Q + (row0 + t) * 512 + ch) = o; } } }
    }
}

__device__ __forceinline__ int scan_chunk(int b, int dir, int s) { return s < 4 ? 128 + 4 * b + (dir ? 3 - s : s) : 32 * b + (dir ? 31 - (s - 4) : (s - 4)); }
template <int DK> struct P2Frag { bf16x8 a[4]; bf16x8 bv[2][4]; f32x4 ae[4]; };
template <int DK> __device__ __forceinline__ void p2_load(P2Frag<DK>& f, const ScanBufs<DK>& S, int dir, int g, int h, int dkb, int dvb, int r, int hi) {
    const bf16* kt = S.KT + (((((size_t)dir * NCH + g) * 8 + h) * 8 + hi) * DK + dkb * 32 + r) * 8;
    const bf16* vt = S.VT + ((((size_t)g * 8 + h) * 8 + hi) * 128 + dvb * 64 + r) * 8;
    const float* ae = S.AE + (((size_t)dir * NCH + g) * 8 + h) * DK + dkb * 32 + 4 * hi;
#pragma unroll
    for (int kk = 0; kk < 4; ++kk) { f.a[kk] = *(const GAS bf16x8*)(kt + (size_t)kk * 2 * DK * 8); f.bv[0][kk] = *(const GAS bf16x8*)(vt + (size_t)kk * 2 * 128 * 8); f.bv[1][kk] = *(const GAS bf16x8*)(vt + (size_t)kk * 2 * 128 * 8 + 32 * 8); f.ae[kk] = *(const GAS f32x4*)(ae + 8 * kk); }
}
template <int DK> __device__ __forceinline__ void scan_state_unit(const ScanBufs<DK>& S, int unit, int lane, bool skip_ctx_store) {
    constexpr int NKB = DK / 32;
    const int dvb = unit & 1, dkb = (unit >> 1) % NKB, rest = (unit >> 1) / NKB; const int dir = rest & 1, h = (rest >> 1) & 7, b = rest >> 4;
    const int r = lane & 31, hi = lane >> 5;
    f32x16 acc[2]; acc[0] = f32x16{}; acc[1] = f32x16{};
    P2Frag<DK> cur, nxt; p2_load<DK>(cur, S, dir, scan_chunk(b, dir, 0), h, dkb, dvb, r, hi);
    for (int s = 0; s < 36; ++s) {
        const int g = scan_chunk(b, dir, s);
        if (s + 1 < 36) p2_load<DK>(nxt, S, dir, scan_chunk(b, dir, s + 1), h, dkb, dvb, r, hi);
        if (!(skip_ctx_store && s < 4)) {
            bf16* sp = S.SP + (((((size_t)dir * NCH + g) * 8 + h) * (DK / 8) + dkb * 4) * 128 + dvb * 64 + r) * 8 + 4 * hi;
#pragma unroll
            for (int j = 0; j < 2; ++j)
#pragma unroll
                for (int q = 0; q < 4; ++q) { v2u o; o.x = pk2(acc[j][4 * q], acc[j][4 * q + 1]); o.y = pk2(acc[j][4 * q + 2], acc[j][4 * q + 3]); *(GAS v2u*)(sp + ((size_t)q * 128 + j * 32) * 8) = o; }
        }
#pragma unroll
        for (int j = 0; j < 2; ++j)
#pragma unroll
            for (int q = 0; q < 4; ++q)
#pragma unroll
                for (int i = 0; i < 4; ++i) acc[j][4 * q + i] *= cur.ae[q][i];
#pragma unroll
        for (int kk = 0; kk < 4; ++kk) { acc[0] = __builtin_amdgcn_mfma_f32_32x32x16_bf16(cur.a[kk], cur.bv[0][kk], acc[0], 0, 0, 0); acc[1] = __builtin_amdgcn_mfma_f32_32x32x16_bf16(cur.a[kk], cur.bv[1][kk], acc[1], 0, 0, 0); }
        cur = nxt;
    }
}

constexpr int P3_ALP = 144, P3_WBYTES = 4 * 32 * P3_ALP, P3_STP = 272;
static_assert(32 * P3_STP <= 2 * 32 * P3_ALP, "output staging fits a t block's score rows");
template <int DK> __device__ __forceinline__ void scan_out_wave(const ScanBufs<DK>& S, int g, int h, const bf16* P, int gcol, const float* gain, bf16* Y, LAS unsigned char* W, int lane) {
    const int r = lane & 31, hi = lane >> 5;
    constexpr int NK = DK / 16, HD = 8 * DK;
    const size_t row0 = (size_t)g * 64;
    const unsigned oRow = (unsigned)((r * HD + 8 * hi) * 2);
    const unsigned oGrp = (unsigned)(((hi * 128 + r) * 8) * 2);
    const unsigned oHi4 = (unsigned)(8 * hi * 4), oHi2 = (unsigned)(8 * hi * 2);
#define UB(base) ([&]() -> const char* { const char* b_ = (const char*)(base); asm volatile("" : "+s"(b_)); return b_; }())
#define LDV(ub, off) (*(const GAS v4u*)((ub) + (off)))
#define LD16(base, off) ([&]() -> v4u { const char* b_ = (const char*)(base); asm volatile("" : "+s"(b_)); return *(const GAS v4u*)(b_ + (off)); }())
#define LD16F(base, off) ([&]() -> f32x4 { const char* b_ = (const char*)(base); asm volatile("" : "+s"(b_)); return *(const GAS f32x4*)(b_ + (off)); }())
#define P3_BLOCK(ti, si, DIAG, KA, QA) do { f32x16 acc_ = f32x16{}; _Pragma("unroll") for (int kk = 0; kk < NK; ++kk) acc_ = __builtin_amdgcn_mfma_f32_32x32x16_bf16(__builtin_bit_cast(bf16x8, KA[kk]), __builtin_bit_cast(bf16x8, QA[kk]), acc_, 0, 0, 0); \
            if (DIAG) { _Pragma("unroll") for (int e = 0; e < 16; ++e) { const int sl_ = (e & 3) + 8 * (e >> 2) + 4 * hi; const bool keep_ = dir == 0 ? (sl_ <= r) : (sl_ >= r); acc_[e] = keep_ ? acc_[e] : 0.f; } } \
            LAS unsigned char* ap_ = W + (((ti) * 2 + dir) * 32 + r) * P3_ALP + (32 * (si) + 4 * hi) * 2; \
            _Pragma("unroll") for (int q = 0; q < 4; ++q) { v2u o_; o_.x = pk2(acc_[4 * q], acc_[4 * q + 1]); o_.y = pk2(acc_[4 * q + 2], acc_[4 * q + 3]); *(LAS v2u*)(ap_ + 16 * q) = o_; } } while (0)
#define P3_ZERO(ti, si) do { LAS unsigned char* ap_ = W + (((ti) * 2 + dir) * 32 + r) * P3_ALP + (32 * (si) + 4 * hi) * 2; _Pragma("unroll") for (int q = 0; q < 4; ++q) *(LAS v2u*)(ap_ + 16 * q) = (v2u){0u, 0u}; } while (0)
#pragma unroll
    for (int dir = 0; dir < 2; ++dir) {
        const char* Qh = (const char*)(S.E + ((size_t)dir * MT + row0) * HD + h * DK); const char* Ku = (const char*)(S.K + ((size_t)dir * MT + row0) * HD + h * DK);
        v4u ka0[NK], ka1[NK], qa0[NK], qa1[NK];
        { const char* k0_ = UB(Ku); const char* k1_ = UB(Ku + (size_t)32 * HD * 2); const char* q0_ = UB(Qh); const char* q1_ = UB(Qh + (size_t)32 * HD * 2);
#pragma unroll
          for (int kk = 0; kk < NK; ++kk) { ka0[kk] = LDV(k0_ + 32 * kk, oRow); qa0[kk] = LDV(q0_ + 32 * kk, oRow); }
#pragma unroll
          for (int kk = 0; kk < NK; ++kk) { ka1[kk] = LDV(k1_ + 32 * kk, oRow); qa1[kk] = LDV(q1_ + 32 * kk, oRow); } }
        P3_BLOCK(0, 0, true, ka0, qa0);
        if (dir == 0) { P3_BLOCK(1, 0, false, ka0, qa1); P3_ZERO(0, 1); } else { P3_BLOCK(0, 1, false, ka1, qa0); P3_ZERO(1, 0); }
        P3_BLOCK(1, 1, true, ka1, qa1);
    }
#undef P3_BLOCK
#undef P3_ZERO
    LDS_WAIT();
    const char* VTu = (const char*)(S.VT + (((size_t)g * 8 + h) * 8) * 128 * 8);
    for (int tt = 0; tt < 2; ++tt) {
        f32x16 acc[4];
#pragma unroll
        for (int dvt = 0; dvt < 4; ++dvt) acc[dvt] = f32x16{};
        const LAS unsigned char* Wt = W + (size_t)tt * 2 * 32 * P3_ALP;
        const int tl = lane >> 3, seg = lane & 7; const size_t rowt = row0 + 32 * tt;
        const char* Gu = (const char*)(P + rowt * NINP + gcol + h * 128); const unsigned og = (unsigned)((tl * NINP + seg * 8) * 2);
        struct Raw8 { v4u x[8]; }; Raw8 A0, A1;
        constexpr int NST = 2 * (2 + NK);
#define P3_SLOAD(R, st) do { constexpr int dir_ = (st) / (2 + NK), j_ = (st) % (2 + NK); \
            if ((st) >= NST) { _Pragma("unroll") for (int j = 0; j < 8; ++j) { const char* gb_ = UB(Gu + ((size_t)(8 * (j >> 1)) * NINP + (j & 1) * 64) * 2); R.x[j] = LDV(gb_, og); } } \
            else if (j_ < 2) { _Pragma("unroll") for (int k2 = 0; k2 < 2; ++k2) { const char* vb_ = UB(VTu + (size_t)(2 * j_ + k2) * 2 * 128 * 16); _Pragma("unroll") for (int dvt = 0; dvt < 4; ++dvt) R.x[k2 * 4 + dvt] = LDV(vb_ + 32 * dvt * 16, oGrp); } } \
            else { constexpr int kk_ = j_ - 2; const char* sb_ = UB((const char*)(S.SP + ((((size_t)dir_ * NCH + g) * 8 + h) * (DK / 8)) * 128 * 8) + (size_t)kk_ * 2 * 128 * 16); \
                const char* qb_ = UB((const char*)(S.E + ((size_t)dir_ * MT + rowt) * HD + h * DK) + 32 * kk_); const char* bb_ = UB((const char*)(S.AE + (((size_t)dir_ * NCH + g) * 8 + h) * DK) + 64 * kk_); \
                _Pragma("unroll") for (int dvt = 0; dvt < 4; ++dvt) R.x[dvt] = LDV(sb_ + 32 * dvt * 16, oGrp); \
                R.x[4] = LDV(qb_, oRow); R.x[5] = R.x[4]; R.x[6] = LDV(bb_, oHi4); R.x[7] = LDV(bb_ + 16, oHi4); } \
            __builtin_amdgcn_sched_barrier(0); } while (0)
#define P3_SCOMP(R, st) do { constexpr int dir_ = (st) / (2 + NK), j_ = (st) % (2 + NK); \
            if (j_ < 2) { const LAS unsigned char* ap_ = Wt + (dir_ * 32 + r) * P3_ALP + (8 * hi) * 2; \
                _Pragma("unroll") for (int k2 = 0; k2 < 2; ++k2) { const bf16x8 af_ = *(const LAS bf16x8*)(ap_ + 32 * (2 * j_ + k2)); \
                    _Pragma("unroll") for (int dvt = 0; dvt < 4; ++dvt) acc[dvt] = __builtin_amdgcn_mfma_f32_32x32x16_bf16(__builtin_bit_cast(bf16x8, R.x[k2 * 4 + dvt]), af_, acc[dvt], 0, 0, 0); } } \
            else { const v4u qw_ = R.x[4]; const f32x4 b0_ = __builtin_bit_cast(f32x4, R.x[6]), b1_ = __builtin_bit_cast(f32x4, R.x[7]); v4u qa_;     \
                qa_.x = pk2(bflo(qw_.x) * b0_[0], bfhi(qw_.x) * b0_[1]); qa_.y = pk2(bflo(qw_.y) * b0_[2], bfhi(qw_.y) * b0_[3]); qa_.z = pk2(bflo(qw_.z) * b1_[0], bfhi(qw_.z) * b1_[1]); qa_.w = pk2(bflo(qw_.w) * b1_[2], bfhi(qw_.w) * b1_[3]); \
                _Pragma("unroll") for (int dvt = 0; dvt < 4; ++dvt) acc[dvt] = __builtin_amdgcn_mfma_f32_32x32x16_bf16(__builtin_bit_cast(bf16x8, R.x[dvt]), __builtin_bit_cast(bf16x8, qa_), acc[dvt], 0, 0, 0); } \
            __builtin_amdgcn_sched_barrier(0); } while (0)
#define P3_STEP2(st) do { P3_SLOAD(A1, (st) + 1); P3_SCOMP(A0, (st)); P3_SLOAD(A0, (st) + 2); P3_SCOMP(A1, (st) + 1); } while (0)
        P3_SLOAD(A0, 0);
        P3_STEP2(0); P3_STEP2(2); P3_STEP2(4); P3_STEP2(6); P3_STEP2(8); P3_STEP2(10);
        if (NK == 8) { P3_STEP2(12); P3_STEP2(14); P3_STEP2(16); P3_STEP2(18); }
#undef P3_SLOAD
#undef P3_SCOMP
#undef P3_STEP2
        float ss = 0.f;
#pragma unroll
        for (int dvt = 0; dvt < 4; ++dvt)
#pragma unroll
            for (int e = 0; e < 16; ++e) ss += acc[dvt][e] * acc[dvt][e];
        ss += __shfl_xor(ss, 32);
        const float rstd = 1.0f / sqrtf(ss * (1.f / 128.f) + RMS_EPS);
        LAS unsigned char* st = W + (size_t)tt * 2 * 32 * P3_ALP;
#pragma unroll
        for (int dvt = 0; dvt < 4; ++dvt)
#pragma unroll
            for (int q = 0; q < 4; ++q) { v2u o; o.x = pk2(acc[dvt][4 * q] * rstd, acc[dvt][4 * q + 1] * rstd); o.y = pk2(acc[dvt][4 * q + 2] * rstd, acc[dvt][4 * q + 3] * rstd); *(LAS v2u*)(st + r * P3_STP + (32 * dvt + 8 * q + 4 * hi) * 2) = o; }
        LDS_WAIT();
        { char* Yu = (char*)(Y + rowt * 1024 + h * 128); const unsigned oy = (unsigned)((tl * 1024 + seg * 8) * 2);
#pragma unroll
          for (int j = 0; j < 8; ++j) { const int rr = 8 * (j >> 1), hf = j & 1; const v4u ow = *(const LAS v4u*)(st + (tl + rr) * P3_STP + hf * 128 + seg * 16); const v4u gw = A0.x[j];
              const float* gn = gain + hf * 64 + seg * 8; const f32x4 n0 = *(const GAS f32x4*)gn, n1 = *(const GAS f32x4*)(gn + 4); v4u y;
#pragma unroll
              for (int c = 0; c < 4; ++c) { const float z0 = bflo(gw[c]), z1 = bfhi(gw[c]); const float na = c < 2 ? n0[2 * c] : n1[2 * c - 4], nb = c < 2 ? n0[2 * c + 1] : n1[2 * c - 3];
                  y[c] = pk2(bflo(ow[c]) * na * z0 * sigmoidf_(z0), bfhi(ow[c]) * nb * z1 * sigmoidf_(z1)); }
              *(GAS v4u*)(Yu + oy + ((size_t)rr * 1024 + hf * 64) * 2) = y; } }
        LDS_WAIT();
    }
#undef LD16
#undef LD16F
#undef UB
#undef LDV
}
__device__ __forceinline__ void mixer_phase3(Frame& FF, int l) {
    Frame F = FF; F.lane = xb_lane(); F.tid = F.wave * 64 + F.lane; const int lane = F.lane;
    const bf16* P = (const bf16*)(F.ws + WS_P); bf16* Y = (bf16*)(F.ws + WS_Y);
    const ScanBufs<128> A = bufsA(F.ws); const ScanBufs<64> B = bufsB(F.ws);
    const int nch = (l == DEPTH - 1) ? 128 : NCH;
    const int nu = nch * 8;
    LAS unsigned char* W = F.lds + F.wave * P3_WBYTES;
    const int NGW = F.G * NWAVES; const int gw0 = F.wave * F.G + F.vcu; const int gw1 = (F.G == 256) ? ((F.wave == 5) ? NGW + F.vcu : 2 * nu) : gw0 + NGW;
    for (int ui = 0; ui < 16; ++ui) { const int u = ui == 0 ? gw0 : (F.G == 256 ? (ui == 1 ? gw1 : 2 * nu) : gw0 + ui * NGW); if (u >= 2 * nu) break;
        const int ln = xb_lane();
        if (u < nu) scan_out_wave<128>(A, u >> 3, u & 7, P, PC_AG, FIN(8) + l * 128, Y, W, ln);
        else { const int v = u - nu; scan_out_wave<64>(B, v >> 3, v & 7, P, PC_BG, FIN(11) + l * 128, Y + (size_t)MT * 1024, W, ln); }
    }
}
namespace nat {
using s16x4 = __attribute__((ext_vector_type(4))) short; using u32x4 = __attribute__((ext_vector_type(4))) unsigned;
#define KSWZ(row, colB) ((row) * 256 + ((colB) ^ (((row) & 7) << 4)))
#define SBAR() __builtin_amdgcn_sched_barrier(0)
__device__ __forceinline__ int crow(int r, int hi) { return (r & 3) + 8 * (r >> 2) + 4 * hi; }
__device__ __forceinline__ unsigned cvtpk(float lo, float hi) {
  unsigned r; asm volatile("v_cvt_pk_bf16_f32 %0, %1, %2" : "=v"(r) : "v"(lo), "v"(hi)); return r;
}
__device__ __forceinline__ void finishSM(f32x16& p0, f32x16& p1, float alpha, float& l_reg, bf16x8& pa0, bf16x8& pa1, bf16x8& pa2, bf16x8& pa3) {
  for (int r = 0; r < 16; ++r) p1[r] = __builtin_amdgcn_exp2f(p1[r]);
  float ps = 0; for (int r = 0; r < 16; ++r) ps += p0[r]; for (int r = 0; r < 16; ++r) ps += p1[r];
  { auto rr = __builtin_amdgcn_permlane32_swap(__float_as_uint(ps), __float_as_uint(ps), false, false);
    ps = __uint_as_float(rr[0]) + __uint_as_float(rr[1]); }
  l_reg = l_reg * alpha + ps;
#define PK4(P, BASE, OUT) do { unsigned a0 = cvtpk(P[BASE + 0], P[BASE + 1]), a1 = cvtpk(P[BASE + 2], P[BASE + 3]);   \
    unsigned b0 = cvtpk(P[BASE + 4], P[BASE + 5]), b1 = cvtpk(P[BASE + 6], P[BASE + 7]);                              \
    auto r0 = __builtin_amdgcn_permlane32_swap(a0, b0, false, false); auto r1 = __builtin_amdgcn_permlane32_swap(a1, b1, false, false); \
    u32x4 w = {r0[0], r1[0], r0[1], r1[1]}; OUT = *reinterpret_cast<bf16x8*>(&w); } while (0)
  PK4(p0, 0, pa0); PK4(p0, 8, pa1); PK4(p1, 0, pa2); PK4(p1, 8, pa3);
#undef PK4
}
__device__ __forceinline__ void qkt(f32x16& p0, f32x16& p1, const bf16* Ks, const bf16x8* qr, int r32, int hi) {
  p0 = f32x16{}; p1 = f32x16{};
  for (int d0 = 0; d0 < 8; ++d0) { int cb = (d0 * 16 + hi * 8) * 2;
    bf16x8 b0 = *reinterpret_cast<const bf16x8*>((const char*)Ks + KSWZ(r32, cb));
    bf16x8 b1 = *reinterpret_cast<const bf16x8*>((const char*)Ks + KSWZ(32 + r32, cb));
    p0 = __builtin_amdgcn_mfma_f32_32x32x16_bf16(b0, qr[d0], p0, 0, 0, 0);
    p1 = __builtin_amdgcn_mfma_f32_32x32x16_bf16(b1, qr[d0], p1, 0, 0, 0); }
}
__device__ __forceinline__ int v_st(int k, int c) { const int kk = (k & ~0xC) | ((k & 4) << 1) | ((k & 8) >> 1); return ((kk >> 3) * 4 + (c >> 5)) * 512 + ((kk & 7) * 32 + (c & 31)) * 2; }
__device__ __forceinline__ int v_rd_base(int lane) { return ((lane & 3) << 3) | (((lane >> 2) & 3) << 6) | (((lane >> 4) & 1) << 5) | (((lane >> 5) & 1) << 8); }
constexpr int v_rd_off(int d0, int ks, int half) { return d0 * 512 + ks * 4096 + half * 2048; }
template <int OFF> __device__ __forceinline__ s16x4 tr_read(int vb) {
  s16x4 r; asm volatile("ds_read_b64_tr_b16 %0, %1 offset:%2" : "=&v"(r) : "v"(vb), "i"(OFF) : "memory"); return r;
}
template <int D0> __device__ __forceinline__ void pv_one(f32x16& od, int vb, bf16x8 pa0, bf16x8 pa1, bf16x8 pa2, bf16x8 pa3) {
  const s16x4 l0 = tr_read<v_rd_off(D0, 0, 0)>(vb), h0 = tr_read<v_rd_off(D0, 0, 1)>(vb), l1 = tr_read<v_rd_off(D0, 1, 0)>(vb), h1 = tr_read<v_rd_off(D0, 1, 1)>(vb);
  const s16x4 l2 = tr_read<v_rd_off(D0, 2, 0)>(vb), h2 = tr_read<v_rd_off(D0, 2, 1)>(vb), l3 = tr_read<v_rd_off(D0, 3, 0)>(vb), h3 = tr_read<v_rd_off(D0, 3, 1)>(vb);
  asm volatile("s_waitcnt lgkmcnt(0)" ::: "memory"); SBAR();
#define PK(L, H) (bf16x8){L[0], L[1], L[2], L[3], H[0], H[1], H[2], H[3]}
  od = __builtin_amdgcn_mfma_f32_32x32x16_bf16(pa0, PK(l0, h0), od, 0, 0, 0);
  od = __builtin_amdgcn_mfma_f32_32x32x16_bf16(pa1, PK(l1, h1), od, 0, 0, 0);
  od = __builtin_amdgcn_mfma_f32_32x32x16_bf16(pa2, PK(l2, h2), od, 0, 0, 0);
  od = __builtin_amdgcn_mfma_f32_32x32x16_bf16(pa3, PK(l3, h3), od, 0, 0, 0);
#undef PK
}
__device__ __forceinline__ void pv_d0(f32x16* o, int vb, bf16x8 pa0, bf16x8 pa1, bf16x8 pa2, bf16x8 pa3) {
  pv_one<0>(o[0], vb, pa0, pa1, pa2, pa3); pv_one<1>(o[1], vb, pa0, pa1, pa2, pa3); pv_one<2>(o[2], vb, pa0, pa1, pa2, pa3); pv_one<3>(o[3], vb, pa0, pa1, pa2, pa3);
}

constexpr int SHM_V = 64 * 128 * 2, SHM_K = 64 * 128 * 2, SHM_ATTN = 2 * SHM_V + 2 * SHM_K + 8 * 64 * 4;
constexpr int NAT_TAB = SHM_ATTN, NAT_TABW = 128, NAT_MISC = NAT_TAB + 15 * NAT_TABW * 4, NAT_LDS = NAT_MISC + 16;
constexpr float C2 = 0.088388347648318440f * 1.4426950408889634f;
constexpr float THR2 = 8.f * 1.4426950408889634f;
constexpr float NEGB = -1e30f;
template <bool WIN> __device__ __forceinline__ void partialSM(f32x16& p0, f32x16& p1, float& m_reg, float& mn, float& alpha, bool rowok, const float* tb, int t0) {
  if (WIN) {
    if (rowok) {
#pragma unroll
      for (int r = 0; r < 16; ++r) { const int cr = (r & 3) + 8 * (r >> 2);
        const float b0 = tb[cr], b1 = tb[cr + 32];
        p0[r] = ((unsigned)(cr + t0) < 16u) ? fmaf(p0[r], C2, b0) : NEGB;
        p1[r] = ((unsigned)(cr + 32 + t0) < 16u) ? fmaf(p1[r], C2, b1) : NEGB; }
    } else {
#pragma unroll
      for (int r = 0; r < 16; ++r) { p0[r] = NEGB; p1[r] = NEGB; }
    }
  } else {
#pragma unroll
    for (int r = 0; r < 16; ++r) { p0[r] *= C2; p1[r] *= C2; }
  }
  float pmax = p0[0];
#pragma unroll
  for (int r = 1; r < 16; ++r) pmax = fmaxf(pmax, p0[r]);
#pragma unroll
  for (int r = 0; r < 16; ++r) pmax = fmaxf(pmax, p1[r]);
  { auto rr = __builtin_amdgcn_permlane32_swap(__float_as_uint(pmax), __float_as_uint(pmax), false, false);
    pmax = fmaxf(__uint_as_float(rr[0]), __uint_as_float(rr[1])); }
  if (__builtin_expect(__all(pmax - m_reg <= THR2), 1)) { mn = m_reg; alpha = 1.f; }
  else { mn = fmaxf(m_reg, pmax); alpha = __builtin_amdgcn_exp2f(m_reg - mn); m_reg = mn; }
#pragma unroll
  for (int r = 0; r < 16; ++r) { p0[r] -= mn; p1[r] -= mn; }
#pragma unroll
  for (int r = 0; r < 16; ++r) p0[r] = __builtin_amdgcn_exp2f(p0[r]);
}
__device__ __forceinline__ void natten_unit(const bf16* __restrict__ P, bf16* __restrict__ Y, const float* __restrict__ rpbh, long qrow0, long crow0, long wrow0, int h, int NT, bool win, int r0, int ws0, char* lds, int tid) {
  const int wid = __builtin_amdgcn_readfirstlane(tid >> 6), lane = tid & 63, r32 = lane & 31, hi = lane >> 5;
  bf16* V_lds = (bf16*)lds; bf16* K_lds = (bf16*)(lds + 2 * SHM_V);
  float* ws = (float*)(lds + 2 * SHM_V + 2 * SHM_K) + wid * 64; float* li_l = ws; float* al_l = ws + 32;
  float* tab = (float*)(lds + NAT_TAB);
  __syncthreads();
  if (win) { for (int i = tid; i < 15 * NAT_TABW; i += 512) { const int dr = i >> 7, dc = (i & 127) - 48; tab[i] = (dc >= 0 && dc <= 30) ? rpbh[dr * 31 + dc] * 1.4426950408889634f : 0.f; } }
  float m_reg = -1e30f, l_reg = 0; f32x16 o[4] = {}; bf16x8 qr[8];
  { const char* Qb = (const char*)(P + (size_t)(qrow0 + wid * 32) * NINP + PC_CQ + h * 128); const unsigned qoff = (unsigned)((r32 * NINP + hi * 8) * 2);
#pragma unroll
    for (int d0 = 0; d0 < 8; ++d0) qr[d0] = *(const GAS bf16x8*)(Qb + qoff + d0 * 32); }
  const int sr = tid >> 4, sc = (tid & 15) * 8, vst0 = v_st(sr, sc), vst1 = v_st(32 + sr, sc);
  const int vb0 = (int)(uintptr_t)V_lds + v_rd_base(lane);
  const unsigned kvoff = (unsigned)((sr * NINP + h * 128 + sc) * 2);
  const char* Pk = (const char*)(P + PC_CK); const char* Pv = (const char*)(P + PC_CV);
  const int qgr = r0 + (wid >> 1), qc = 32 * (wid & 1) + r32;
  const int rs = min(max(qgr - 4, 0), 24), cs = min(max(qc - 8, 0), 48);
  const int t0 = 4 * hi - cs; const float* tbl = tab + 63 - qc + 4 * hi;
  bf16x8 vs0, vs1, ks0, ks1;
#define TROW(t) ((t) < 4 ? crow0 + 64 * (t) : wrow0 + 64 * ((t) - 4))
#define SLOAD(t) do { const size_t rb_ = (size_t)(TROW(t)) * (NINP * 2); const char* kb_ = Pk + rb_; const char* vb_ = Pv + rb_; \
    vs0 = *(const GAS bf16x8*)(vb_ + kvoff); vs1 = *(const GAS bf16x8*)(vb_ + (size_t)32 * NINP * 2 + kvoff); \
    ks0 = *(const GAS bf16x8*)(kb_ + kvoff); ks1 = *(const GAS bf16x8*)(kb_ + (size_t)32 * NINP * 2 + kvoff); } while (0)
#define SWRITE(b) do { *(bf16x8*)((char*)V_lds + (b) * SHM_V + vst0) = vs0; *(bf16x8*)((char*)V_lds + (b) * SHM_V + vst1) = vs1; const int kc = sc * 2; \
    *(bf16x8*)((char*)K_lds + (b) * SHM_K + KSWZ(sr, kc)) = ks0; *(bf16x8*)((char*)K_lds + (b) * SHM_K + KSWZ(32 + sr, kc)) = ks1; } while (0)
#define RESC(a) do { if (__any((a) < 1.f)) { if (hi == 0) al_l[r32] = (a); asm volatile("s_waitcnt lgkmcnt(0)" ::: "memory"); \
    for (int d = 0; d < 4; ++d) for (int r = 0; r < 16; ++r) o[d][r] *= al_l[crow(r, hi)]; } } while (0)
  f32x16 p0, p1; float mn, al; bf16x8 pa0, pa1, pa2, pa3;
  SLOAD(0); asm volatile("s_waitcnt vmcnt(0)" ::: "memory"); SWRITE(0); SLOAD(1);
  for (int t = 0; t < NT; ++t) {
    const int buf = t & 1;
    asm volatile("s_waitcnt lgkmcnt(0)" ::: "memory"); __syncthreads();
    if (t + 1 < NT) { asm volatile("s_waitcnt vmcnt(0)" ::: "memory"); SWRITE(buf ^ 1); if (t + 2 < NT) SLOAD(t + 2); }
    const int kr_ = ws0 + t - 4; const bool wtile = win && t >= 4; const bool ok_ = (unsigned)(kr_ - rs) < 8u;
    if (!wtile || ok_) {
        SBAR(); qkt(p0, p1, (bf16*)((char*)K_lds + buf * SHM_K), qr, r32, hi);
        if (!wtile) partialSM<false>(p0, p1, m_reg, mn, al, true, tbl, t0);
        else { const int dr_ = min(max(kr_ - qgr + 7, 0), 14); partialSM<true>(p0, p1, m_reg, mn, al, true, tbl + dr_ * NAT_TABW, t0); }
        finishSM(p0, p1, al, l_reg, pa0, pa1, pa2, pa3); SBAR();
        RESC(al);
        pv_d0(o, vb0 + buf * (int)SHM_V, pa0, pa1, pa2, pa3);
    }
  }
  if (hi == 0) li_l[r32] = l_reg; asm volatile("s_waitcnt lgkmcnt(0)" ::: "memory");
  float rli[16];
#pragma unroll
  for (int r = 0; r < 16; ++r) rli[r] = __builtin_amdgcn_rcpf(li_l[crow(r, hi)]);
  char* Ob = (char*)(Y + (size_t)(qrow0 + wid * 32) * 1024 + h * 128); const unsigned ooff = (unsigned)((4 * hi * 1024 + r32) * 2);
#pragma unroll
  for (int r = 0; r < 16; ++r) { const int orow = (r & 3) + 8 * (r >> 2);
#pragma unroll
    for (int d0 = 0; d0 < 4; ++d0) *(GAS bf16*)(Ob + ooff + (orow * 1024 + d0 * 32) * 2) = (bf16)f2bf(o[d0][r] * rli[r]); }
  asm volatile("s_waitcnt vmcnt(0)" ::: "memory");
#undef TROW
#undef SLOAD
#undef SWRITE
#undef RESC
}
}

__device__ __forceinline__ void mixer_phase2(Frame& FF, int l, int rep) {
    Frame F = FF; F.lane = xb_lane(); F.tid = F.wave * 64 + F.lane; const int lane = F.lane, tid = F.tid;
    { const ScanBufs<128> A = bufsA(F.ws); const ScanBufs<64> B = bufsB(F.ws);
      const int gw = F.vcu * NWAVES + F.wave; const bool lastl = (l == DEPTH - 1);
      if (gw < 512) scan_state_unit<128>(A, gw, lane, lastl);
      else if (gw < 768) scan_state_unit<64>(B, gw - 512, lane, lastl); }
    const bf16* P = (const bf16*)(F.ws + WS_P); bf16* Y = (bf16*)(F.ws + WS_Y) + (size_t)2 * MT * 1024;
    const float* rpb = FIN(12) + (size_t)l * 8 * 15 * 31;
    const int total = (l == DEPTH - 1) ? 256 : 288;
    volatile LAS unsigned* slot = (volatile LAS unsigned*)(F.lds + nat::NAT_MISC);
    gu32* qhead = F.ctl + CW_QUEUE + 64 * (l + 4 * rep);
    for (;;) {
        __syncthreads();
        if (tid == 0) *slot = __hip_atomic_fetch_add(qhead, 1u, RLX_AGENT);
        __syncthreads();
        const int idx = (int)__builtin_amdgcn_readfirstlane(*slot);
        if (idx >= total) break;
        if (idx < 256) { int bh, r0;
            if (idx < 192) { bh = idx / 6; r0 = 4 + 4 * (idx % 6); } else { const int i = idx - 192; bh = i >> 1; r0 = (i & 1) ? 28 : 0; }
            const int b = bh >> 3, h = bh & 7; const int ws0 = (r0 == 0) ? 0 : (r0 == 28 ? 24 : min(r0 - 4, 20)); const int nwin = (r0 == 0 || r0 == 28) ? 8 : 12;
            nat::natten_unit(P, Y, rpb + h * 15 * 31, (long)b * 2048 + 64 * r0, (long)ML + b * 256, (long)b * 2048 + 64 * ws0, h, 4 + nwin, true, r0, ws0, (char*)F.lds, tid);
        } else { const int bh = idx - 256, b = bh >> 3, h = bh & 7;
            nat::natten_unit(P, Y, rpb, (long)ML + b * 256, (long)ML + b * 256, 0, h, 4, false, 0, 0, (char*)F.lds, tid); }
    }
}


#ifndef WGM_IN
#define WGM_IN 4
#endif
#ifndef WGM_BR
#define WGM_BR 4
#endif
#ifndef WGM_OUT
#define WGM_OUT 4
#endif
#ifndef WGM_M1
#define WGM_M1 4
#endif
#ifndef WGM_M2
#define WGM_M2 2
#endif
constexpr int NPH_PRE = 3, NPH_LAYER = 10, NPH = NPH_PRE + DEPTH * NPH_LAYER;
struct Args { const float* in[21]; float* out; unsigned char* ws; int ph_lo, ph_hi, use_bar, pad; };
__global__ void __launch_bounds__(NWAVES * 64, 2) fwd_kernel(Args args) {
    extern __shared__ __attribute__((aligned(16))) unsigned char lds[];
    Frame F;
    F.lds = (LAS unsigned char*)lds;
    F.MISC = (volatile LAS unsigned*)(F.lds + MISC_OFF);
    F.wave = __builtin_amdgcn_readfirstlane((int)threadIdx.x >> 6); F.lane = xb_lane(); F.tid = F.wave * 64 + F.lane;
    F.G = gridDim.x; { const int bx = blockIdx.x; F.vcu = (F.G % 8 == 0) ? (bx % 8) * (F.G / 8) + bx / 8 : bx; }
    F.ws = args.ws; F.ctl = (gu32*)(args.ws + WS_CTL); F.out = args.out;
    F.kin = (kin_t)__builtin_amdgcn_kernarg_segment_ptr();
    for (int u = F.tid; u < (LDS_BYTES - LDSCTL_OFF) / 4; u += NWAVES * 64) ((LAS unsigned*)(F.lds + LDSCTL_OFF))[u] = 0u;
    __syncthreads();
    const bool use_bar = args.use_bar != 0;
    XcdBarrier bar; bar.bar = (unsigned*)(F.ctl + CW_BAR); bar.x = 0; bar.st = nullptr; bar.wave = F.wave;
    if (use_bar) bar = xcd_barrier_post((unsigned*)(F.ctl + CW_BAR), F.MISC + 8);
    const int lo = args.ph_lo, hi = args.ph_hi;
#define IN(k) (lo <= (k) && (k) < hi)
#ifndef REP_KIND
#define REP_KIND -1
#endif
#define RUN(kind, ...) do { _Pragma("nounroll") for (int rep_ = 0; rep_ < ((REP_KIND == (kind)) ? 2 : 1); ++rep_) { __VA_ARGS__; } } while (0)
#define SEAM(k) do { if (IN((k) + 1)) { if (use_bar) { xcd_barrier(bar); if (REP_KIND == 9) xcd_barrier(bar); } else if (F.tid == 0) __hip_atomic_store(F.ctl + CW_TMO, 0xBADBA0u, RLX_AGENT); } } while (0)
    unsigned char* ws = args.ws;
    if (IN(0)) { RUN(0, p0_prologue(F)); SEAM(0); }
    if (IN(1)) { p0b_modreduce(F); SEAM(1); }
    if (IN(2)) { p0c_modulate(F); SEAM(2); }
    for (int l = 0; l < DEPTH; ++l) {
        const int pb = NPH_PRE + l * NPH_LAYER;
        const bool lastl = (l == DEPTH - 1);
        const int Mg = lastl ? ML : MT;
        if (IN(pb + 0)) {
            RUN(1, { pg8::Gemm g{(const bf16*)(ws + WS_H), (const bf16*)(ws + WS_WIN) + (size_t)l * NINP * 2048, MT, NINP, 2048, 0, 0, 2048, 2048}; pg8::StaticOrder S; S.init(MT, NINP, F.G, (int)blockIdx.x, WGM_IN);
            pg8::EpiBf16<0> E{(bf16*)(ws + WS_P), NINP, 0};
            pg8::gemm_phase<pg8::EpiBf16<0>, pg8::StaticOrder, true, true>(F.lds + RING_OFF, g, S, E, F.wave); });
            if (F.G == 256) convert_pocket(F, l + 1, CV_P0, CV_P1, (MT / 256) * (NINP / 256) - 9 * 256);
            SEAM(pb + 0);
        }
        if (IN(pb + 1)) { RUN(2, mixer_phase1(F, l)); SEAM(pb + 1); }
        if (IN(pb + 2)) { mixer_phase2(F, l, 0); if (REP_KIND == 3) mixer_phase2(F, l, 1); SEAM(pb + 2); }
        if (IN(pb + 3)) { RUN(4, mixer_phase3(F, l)); SEAM(pb + 3); }
        if (IN(pb + 4)) {
            RUN(5, { pg8::Gemm g{(const bf16*)(ws + WS_Y), (const bf16*)(ws + WS_WBR) + (size_t)l * 3 * 2048 * 1024, ML, 2048, 1024, (size_t)MT * 1024 * 2, (size_t)2048 * 1024 * 2, 1024, 1024}; pg8::SlabOrder<3> S; S.init(ML, 2048, F.G, (int)blockIdx.x, WGM_BR);
            pg8::EpiGate<true> E{(bf16*)(ws + WS_U), 2048, (const bf16*)(ws + WS_P) + PC_GT, NINP, 0};
            pg8::gemm_phase<pg8::EpiGate<true>, pg8::SlabOrder<3>, true, true>(F.lds + RING_OFF, g, S, E, F.wave);
            if (!lastl) { pg8::Gemm g2 = g; g2.M = MC; pg8::SplitKOrder<1, 3> S2; S2.init(MC, 2048, F.G, (int)blockIdx.x, ML / 256, 1024);
                pg8::EpiGate<false> E2{(bf16*)(ws + WS_UC) - (size_t)ML * 2048, 2048, (const bf16*)(ws + WS_P) + PC_GT, NINP, (size_t)MC * 2048};
                pg8::gemm_phase<pg8::EpiGate<false>, pg8::SplitKOrder<1, 3>, true, true>(F.lds + RING_OFF, g2, S2, E2, F.wave); } });
            if (F.G == 256 && !lastl) convert_pocket(F, l + 1, CV_P1, CV_P2, 96);
            SEAM(pb + 4);
        }
        if (IN(pb + 5)) {
            RUN(6, { pg8::Gemm g{(const bf16*)(ws + WS_U), (const bf16*)(ws + WS_WOUT) + (size_t)l * 2048 * 2048, ML, 2048, 2048, 0, 0, 2048, 2048}; pg8::StaticOrder S; S.init(ML, 2048, F.G, (int)blockIdx.x, WGM_OUT);
            pg8::EpiBf16<0> E{(bf16*)(ws + WS_MIX), 2048, 0};
            pg8::gemm_phase<pg8::EpiBf16<0>, pg8::StaticOrder, true, true>(F.lds + RING_OFF, g, S, E, F.wave);
            if (!lastl) { pg8::Gemm g2{(const bf16*)(ws + WS_UC) - (size_t)ML * 2048, (const bf16*)(ws + WS_WOUT) + (size_t)l * 2048 * 2048, MC, 2048, 1024, (size_t)MC * 2048 * 2, 0, 2048, 2048}; pg8::SplitKOrder<2, 3> S2; S2.init(MC, 2048, F.G, (int)blockIdx.x, ML / 256, 1024);
                pg8::EpiBf16<0> E2{(bf16*)(ws + WS_PART) - (size_t)ML * 2048, 2048, (size_t)MC * 2048};
                pg8::gemm_phase<pg8::EpiBf16<0>, pg8::SplitKOrder<2, 3>, true, true>(F.lds + RING_OFF, g2, S2, E2, F.wave); } });
            SEAM(pb + 5);
        }
        if (IN(pb + 6)) { if (REP_KIND == 10) ln_phase(F, l, 2, FIN(15) + l * DM, FIN(16) + l * DM, l, 3, l == 0, false, Mg, true, 6); ln_phase(F, l, 2, FIN(15) + l * DM, FIN(16) + l * DM, l, 3, l == 0, false, Mg, false, 6); SEAM(pb + 6); }
        if (IN(pb + 7)) {
            RUN(7, { pg8::Gemm g{(const bf16*)(ws + WS_H), (const bf16*)(ws + WS_WM1) + (size_t)l * 8192 * 2048, Mg, DFF, 2048, 0, 0, 2048, 2048}; pg8::StaticOrder S; S.init(Mg, DFF, F.G, (int)blockIdx.x, WGM_M1);
            pg8::EpiBf16<2> E{(bf16*)(ws + WS_HM), DFF, 0};
            pg8::gemm_phase<pg8::EpiBf16<2>, pg8::StaticOrder, true, true>(F.lds + RING_OFF, g, S, E, F.wave); });
            if (F.G == 256 && !lastl) convert_pocket(F, l + 1, CV_P2, CV_IL, 128);
            SEAM(pb + 7);
        }
        if (IN(pb + 8)) {
            RUN(8, { pg8::Gemm g{(const bf16*)(ws + WS_HM), (const bf16*)(ws + WS_WM2) + (size_t)l * 2048 * 8192, ML, 2048, DFF, 0, 0, DFF, DFF}; pg8::StaticOrder S; S.init(ML, 2048, F.G, (int)blockIdx.x, WGM_M2);
            pg8::EpiBf16<0> E{(bf16*)(ws + WS_MIX), 2048, 0};
            pg8::gemm_phase<pg8::EpiBf16<0>, pg8::StaticOrder, true, true>(F.lds + RING_OFF, g, S, E, F.wave);
            if (!lastl) { pg8::Gemm g2{(const bf16*)(ws + WS_HM), (const bf16*)(ws + WS_WM2) + (size_t)l * 2048 * 8192, MC, 2048, 1024, 0, 0, DFF, DFF}; pg8::SplitKOrder<8> S2; S2.init(MC, 2048, F.G, (int)blockIdx.x, ML / 256, 1024);
                pg8::EpiBf16<0> E2{(bf16*)(ws + WS_PART) - (size_t)ML * 2048, 2048, (size_t)MC * 2048};
                pg8::gemm_phase<pg8::EpiBf16<0>, pg8::SplitKOrder<8>, true, true>(F.lds + RING_OFF, g2, S2, E2, F.wave); } });
            SEAM(pb + 8);
        }
        if (IN(pb + 9)) { if (REP_KIND == 10) ln_phase(F, l, 5, FIN(17) + l * DM, FIN(18) + l * DM, l + 1, lastl ? -1 : 0, false, lastl, Mg, true, 8); ln_phase(F, l, 5, FIN(17) + l * DM, FIN(18) + l * DM, l + 1, lastl ? -1 : 0, false, lastl, Mg, false, 8); SEAM(pb + 9); }
    }
#undef IN
#undef SEAM
}

#ifndef MK_LAUNCHES
#define MK_LAUNCHES 1
#endif
extern "C" void kernel_launch(void* const* d_in, const int* in_sizes, int n_in, void* d_out, int out_size, void* d_ws, size_t ws_size, hipStream_t stream) {
    static int grid = 0;
    if (grid == 0) {
        if (n_in != 21 || out_size != ML * DM || ws_size < WS_END) { fprintf(stderr, "kernel_launch: unexpected shapes: n_in %d out %d ws %zu (need %zu)\n", n_in, out_size, ws_size, (size_t)WS_END); grid = -1; return; }
        int dev = 0, cus = 0, per_cu = 0;
        if (hipGetDevice(&dev) != hipSuccess || hipDeviceGetAttribute(&cus, hipDeviceAttributeMultiprocessorCount, dev) != hipSuccess) { grid = -1; return; }
        if (hipFuncSetAttribute((const void*)fwd_kernel, hipFuncAttributeMaxDynamicSharedMemorySize, LDS_BYTES) != hipSuccess) { fprintf(stderr, "kernel_launch: hipFuncSetAttribute failed\n"); grid = -1; return; }
        if (hipOccupancyMaxActiveBlocksPerMultiprocessor(&per_cu, (const void*)fwd_kernel, NWAVES * 64, LDS_BYTES) != hipSuccess || per_cu < 1) { fprintf(stderr, "kernel_launch: occupancy query reports %d\n", per_cu); }
        (void)hipGetLastError();
        grid = cus;
    }
    if (grid < 0) return;
    if (hipMemsetAsync((char*)d_ws + WS_CTL, 0, CTL_ZERO_BYTES, stream) != hipSuccess) return;
    Args a{};
    for (int i = 0; i < 21; ++i) a.in[i] = (const float*)d_in[i];
    a.out = (float*)d_out; a.ws = (unsigned char*)d_ws; a.pad = 0;
#if MK_LAUNCHES == 1
    a.ph_lo = 0; a.ph_hi = NPH; a.use_bar = 1;
    hipLaunchKernelGGL(fwd_kernel, dim3(grid), dim3(NWAVES * 64), LDS_BYTES, stream, a);
#else
    for (int p = 0; p < NPH; ++p) { a.ph_lo = p; a.ph_hi = p + 1; a.use_bar = 0; hipLaunchKernelGGL(fwd_kernel, dim3(grid), dim3(NWAVES * 64), LDS_BYTES, stream, a); }
#endif
    const hipError_t le = hipPeekAtLastError();
    if (le != hipSuccess) fprintf(stderr, "kernel_launch: launch failed: %s\n", hipGetErrorName(le));
}
```

```cpp
#define MK_LAUNCHES 1
#include <hip/hip_runtime.h>
#include <hip/hip_bf16.h>
#include <cstdio>
#include <cstdint>

namespace pg8 {
#define PG8_LAS __attribute__((address_space(3)))
typedef unsigned short bf16_t;
typedef short bf16x8 __attribute__((ext_vector_type(8)));
typedef float f32x4 __attribute__((ext_vector_type(4)));
typedef unsigned u32x4 __attribute__((ext_vector_type(4)));
constexpr int BM = 256, BK = 64, HALF = 128, HTB = HALF * BK * 2  , STAGE_BYTES = 8 * HTB, NXCD = 8, WGM = 4;

__host__ __device__ __forceinline__ int lds_byte(int r, int c) { const int st = (r >> 4) * 2 + (c >> 5), rr = r & 15, cc = c & 31, ob = rr * 64 + cc * 2; return st * 1024 + (ob ^ (((ob >> 9) & 1) << 5)); }
__host__ __device__ __forceinline__ void stage_rc(int b, int& R, int& C) { const int st = b / 1024, sb = b % 1024, swz = sb ^ (((sb >> 9) & 1) << 5); R = (st >> 1) * 16 + swz / 64; C = (st & 1) * 32 + (swz % 64) / 2; }
__host__ __device__ __forceinline__ int perm32(int rho) { const int n = rho >> 4, i = rho & 15; return 8 * (i >> 2) + 4 * n + (i & 3); }

__device__ __forceinline__ int xb_lane_pg8() { int z = 0; asm volatile("" : "+v"(z)); return (int)__builtin_amdgcn_mbcnt_hi(~0u, __builtin_amdgcn_mbcnt_lo(~0u, (unsigned)z)); }
struct Unit { int pm, pn, z, k0, zo; };
struct Gemm { const bf16_t* A; const bf16_t* Bt; int M, N, K; size_t zsA, zsB; int lda, ldb; };

struct StaticOrder {
    int nM, nN, nwg, G, c, wgm;
    __host__ __device__ void init(int M, int N, int G_, int c_, int wgm_ = WGM) { nM = M / BM; nN = N / BM; nwg = nM * nN; G = G_; c = c_; wgm = wgm_; }
    __host__ __device__ bool tile(long L, Unit& u) const {
        if (L >= nwg) return false;
        int wgid = (int)L; { const int q = nwg / NXCD, r = nwg % NXCD, xcd = wgid % NXCD, off = wgid / NXCD; wgid = (xcd < r ? xcd * (q + 1) : r * (q + 1) + (xcd - r) * q) + off; }
        const int nig = wgm * nN, gid = wgid / nig, fm = gid * wgm, gsz = (nM - fm) < wgm ? (nM - fm) : wgm;
        u.pm = fm + ((wgid % nig) % gsz); u.pn = (wgid % nig) / gsz; u.z = 0; u.k0 = 0; u.zo = 0; return true;
    }
    __host__ __device__ bool next(int i, Unit& u) const { return tile((long)i * G + c, u); }
    __device__ __forceinline__ void a_ready(const Unit&) const {}
    __device__ __forceinline__ void done(const Unit&) const {}
};
template <int NZ> struct SlabOrder : StaticOrder {
    __host__ __device__ bool next(int i, Unit& u) const { if (!tile((long)(i / NZ) * G + c, u)) return false; u.z = i % NZ; return true; }
};

template <int NS, int NZ = 1> struct SplitKOrder {
    int nM, nN, nwg, G, c, pm0, Kc;
    __host__ __device__ void init(int M, int N, int G_, int c_, int pm0_, int Kc_) { nM = M / BM; nN = N / BM; nwg = nM * nN * NS * NZ; G = G_; c = c_; pm0 = pm0_; Kc = Kc_; }
    __host__ __device__ bool next(int i, Unit& u) const { const long L = (long)i * G + c; if (L >= nwg) return false; const int t = (int)L / (NS * NZ), rem = (int)L % (NS * NZ), z = rem / NS, ks = rem % NS;
        u.pm = pm0 + t / nN; u.pn = t % nN; u.z = z; u.k0 = ks * Kc; u.zo = z * NS + ks; return true; }
    __device__ __forceinline__ void a_ready(const Unit&) const {}
    __device__ __forceinline__ void done(const Unit&) const {}
};
typedef float f32x2_t __attribute__((ext_vector_type(2))); typedef __bf16 bf16x2_t __attribute__((ext_vector_type(2)));
__device__ __forceinline__ unsigned cvt_pk_bf16(float lo, float hi) { const f32x2_t v = {lo, hi}; const bf16x2_t b = __builtin_convertvector(v, bf16x2_t); return __builtin_bit_cast(unsigned, b); }
__device__ __forceinline__ float bf_lo(unsigned w) { return __uint_as_float(w << 16); }
__device__ __forceinline__ float bf_hi(unsigned w) { return __uint_as_float(w & 0xffff0000u); }

template <int ACT  > struct EpiBf16 {
    static constexpr bool PERM = true, AFTER_DRAIN = false;
    bf16_t* O; int ldc; size_t zsO;
    __device__ __forceinline__ void operator()(const f32x4 (&acc)[2][2][4][2], const Unit& u, int wr, int wc, int fr, int fq) const {
        const int row0 = u.pm * BM + wr * 64 + fr; const int col0 = u.pn * BM + wc * 32 + 8 * fq;
#pragma unroll
        for (int ai = 0; ai < 2; ++ai)
#pragma unroll
            for (int m = 0; m < 4; ++m) { bf16_t* rowp = O + (size_t)u.zo * zsO + (size_t)(row0 + ai * HALF + m * 16) * ldc + col0;
#pragma unroll
                for (int bj = 0; bj < 2; ++bj) { f32x4 v0 = acc[ai][bj][m][0], v1 = acc[ai][bj][m][1];
                    if (ACT == 2) {
#pragma unroll
                        for (int j = 0; j < 4; ++j) { const float a = fmaxf(v0[j], 0.f), b = fmaxf(v1[j], 0.f); v0[j] = a * a; v1[j] = b * b; } }
                    u32x4 w; w.x = cvt_pk_bf16(v0[0], v0[1]); w.y = cvt_pk_bf16(v0[2], v0[3]); w.z = cvt_pk_bf16(v1[0], v1[1]); w.w = cvt_pk_bf16(v1[2], v1[3]);
                    *(u32x4*)(rowp + bj * HALF) = w; } }
    }
};
struct EpiF32 {
    static constexpr bool PERM = false, AFTER_DRAIN = false;
    float* C; int ldc; size_t zsC;
    __device__ __forceinline__ void operator()(const f32x4 (&acc)[2][2][4][2], const Unit& u, int wr, int wc, int fr, int fq) const {
        const int row0 = u.pm * BM + wr * 64 + fr, col0 = u.pn * BM + wc * 32 + 4 * fq;
#pragma unroll
        for (int ai = 0; ai < 2; ++ai)
#pragma unroll
            for (int m = 0; m < 4; ++m) { float* rowp = C + (size_t)u.zo * zsC + (size_t)(row0 + ai * HALF + m * 16) * ldc + col0;
#pragma unroll
                for (int bj = 0; bj < 2; ++bj)
#pragma unroll
                    for (int n = 0; n < 2; ++n) *(f32x4*)(rowp + bj * HALF + n * 16) = acc[ai][bj][m][n]; }
    }
};
template <bool ACCUM> struct EpiGate {
    static constexpr bool PERM = true, AFTER_DRAIN = false;
    bf16_t* U; int ldc; const bf16_t* GT; int ldg; size_t zsU;
    __device__ __forceinline__ void operator()(const f32x4 (&acc)[2][2][4][2], const Unit& u, int wr, int wc, int fr, int fq) const {
        const int row0 = u.pm * BM + wr * 64 + fr; const int col0 = u.pn * BM + wc * 32 + 8 * fq;
#pragma unroll
        for (int ai = 0; ai < 2; ++ai)
#pragma unroll
            for (int m = 0; m < 4; ++m) { const size_t row = (size_t)(row0 + ai * HALF + m * 16); bf16_t* rowp = U + (ACCUM ? (size_t)0 : (size_t)u.z * zsU) + row * ldc + col0; const bf16_t* gp = GT + row * ldg + (size_t)u.z * 2048 + col0;
#pragma unroll
                for (int bj = 0; bj < 2; ++bj) { const u32x4 gw = *(const u32x4*)(gp + bj * HALF); u32x4 pw = (u32x4){0u, 0u, 0u, 0u}; if (ACCUM && u.z > 0) pw = *(const u32x4*)(rowp + bj * HALF);
                    const f32x4 v0 = acc[ai][bj][m][0], v1 = acc[ai][bj][m][1]; const float a[8] = {v0[0], v0[1], v0[2], v0[3], v1[0], v1[1], v1[2], v1[3]};
                    float o[8];
#pragma unroll
                    for (int j = 0; j < 4; ++j) { const unsigned g2 = gw[j], p2 = pw[j];
                        const float s0 = __builtin_amdgcn_rcpf(1.f + __expf(-bf_lo(g2))), s1 = __builtin_amdgcn_rcpf(1.f + __expf(-bf_hi(g2)));
                        o[2 * j] = bf_lo(p2) + s0 * a[2 * j]; o[2 * j + 1] = bf_hi(p2) + s1 * a[2 * j + 1]; }
                    u32x4 w; w.x = cvt_pk_bf16(o[0], o[1]); w.y = cvt_pk_bf16(o[2], o[3]); w.z = cvt_pk_bf16(o[4], o[5]); w.w = cvt_pk_bf16(o[6], o[7]);
                    *(u32x4*)(rowp + bj * HALF) = w; } }
    }
};

template <class Epi, class Sched, bool ALIGN_EPI = false, bool SP2 = false>
__device__ __forceinline__ void gemm_phase(PG8_LAS unsigned char* lds, const Gemm g, const Sched& S, const Epi& E, const int wave0) {
    int tid_ = wave0 * 64 + xb_lane_pg8();
    const int tid = tid_, wid = __builtin_amdgcn_readfirstlane(tid >> 6), lane = tid & 63, wr = wid >> 2, wc = wid & 3, fr = lane & 15, fq = lane >> 4;
    const int K = g.K, nt = K / BK;
    unsigned voffA[2], voffB[2];
#pragma unroll
    for (int i = 0; i < 2; ++i) { int R, C; stage_rc(tid * 16 + i * 8192, R, C); const int Rb = Epi::PERM ? ((R & ~31) + perm32(R & 31)) : R;
        voffA[i] = (unsigned)(R * g.lda + C) * 2u; voffB[i] = (unsigned)(Rb * g.ldb + C) * 2u; }
    const size_t kstep = (size_t)(BK * 2);
    const size_t hstepA = (size_t)HALF * g.lda * 2, hstepB = (size_t)HALF * g.ldb * 2;
    const size_t tstepA = 2 * hstepA, tstepB = 2 * hstepB;
    const unsigned ldsw = (unsigned)wid * 1024u;
    const int aoff = lds_byte(wr * 64 + fr, fq * 8), boff = lds_byte(wc * 32 + fr, fq * 8);
#define PG8_SA(b, h) (((b) * 2 + (h)) * HTB)
#define PG8_SB(b, h) ((4 + (b) * 2 + (h)) * HTB)
#define PG8_STAGE(bufoff, gbase, voff) do { _Pragma("unroll") for (int _i = 0; _i < 2; ++_i) \
        __builtin_amdgcn_global_load_lds((const unsigned*)((const char*)(gbase) + (voff)[_i]), (PG8_LAS unsigned*)(lds + (bufoff) + ldsw + _i * 8192), 16, 0, 0); } while (0)
#define PG8_LDA(dst, b, h) do { _Pragma("unroll") for (int m = 0; m < 4; ++m) _Pragma("unroll") for (int k = 0; k < 2; ++k) dst[m][k] = *(const PG8_LAS bf16x8*)(lds + PG8_SA(b, h) + aoff + m * 2048 + k * 1024); } while (0)
#define PG8_LDB(dst, b, h) do { _Pragma("unroll") for (int n = 0; n < 2; ++n) _Pragma("unroll") for (int k = 0; k < 2; ++k) dst[n][k] = *(const PG8_LAS bf16x8*)(lds + PG8_SB(b, h) + boff + n * 2048 + k * 1024); } while (0)
#define PG8_MMA(ai, bj, At, Bt) do { __builtin_amdgcn_s_setprio(1); _Pragma("unroll") for (int m = 0; m < 4; ++m) _Pragma("unroll") for (int n = 0; n < 2; ++n) _Pragma("unroll") for (int k = 0; k < 2; ++k) \
        acc[ai][bj][m][n] = __builtin_amdgcn_mfma_f32_16x16x32_bf16(Bt[n][k], At[m][k], acc[ai][bj][m][n], 0, 0, 0); __builtin_amdgcn_s_setprio(0); } while (0)
#define PG8_WAIT_V(n) asm volatile("s_waitcnt vmcnt(" #n ")" ::: "memory")
#define PG8_WAIT_L(n) asm volatile("s_waitcnt lgkmcnt(" #n ")" ::: "memory")
#define PG8_BAR __builtin_amdgcn_s_barrier()
#define PG8_SCHED __builtin_amdgcn_sched_barrier(0)
    Unit cur, nxt; int ui = 0;
    if (!S.next(0, cur)) return;
    f32x4 acc[2][2][4][2];
#pragma unroll
    for (int a = 0; a < 2; ++a)
#pragma unroll
        for (int b = 0; b < 2; ++b)
#pragma unroll
            for (int m = 0; m < 4; ++m)
#pragma unroll
                for (int n = 0; n < 2; ++n) acc[a][b][m][n] = (f32x4){0.f, 0.f, 0.f, 0.f};
    bf16x8 At[4][2], B0[2][2], B1[2][2];
    const char* cA = (const char*)g.A + (size_t)cur.z * g.zsA + (size_t)cur.pm * tstepA + (size_t)cur.k0 * 2; const char* cB = (const char*)g.Bt + (size_t)cur.z * g.zsB + (size_t)cur.pn * tstepB + (size_t)cur.k0 * 2;
    S.a_ready(cur);
    if constexpr (SP2) {
        PG8_STAGE(PG8_SB(0, 0), cB, voffB); PG8_STAGE(PG8_SB(0, 1), cB + hstepB, voffB); PG8_STAGE(PG8_SA(0, 0), cA, voffA); PG8_STAGE(PG8_SA(0, 1), cA + hstepA, voffA);
        if (wr == 1) PG8_BAR;
        PG8_WAIT_V(2); PG8_BAR;
        PG8_STAGE(PG8_SB(1, 0), cB + kstep, voffB); PG8_STAGE(PG8_SA(1, 0), cA + kstep, voffA); PG8_STAGE(PG8_SB(1, 1), cB + hstepB + kstep, voffB);
        PG8_WAIT_V(6); PG8_BAR;
    } else {
        PG8_STAGE(PG8_SB(0, 0), cB, voffB); PG8_STAGE(PG8_SA(0, 0), cA, voffA); PG8_STAGE(PG8_SB(0, 1), cB + hstepB, voffB); PG8_STAGE(PG8_SA(0, 1), cA + hstepA, voffA);
        if (wr == 1) PG8_BAR;
        PG8_WAIT_V(4); PG8_BAR;
        PG8_STAGE(PG8_SB(1, 0), cB + kstep, voffB); PG8_STAGE(PG8_SA(1, 0), cA + kstep, voffA); PG8_STAGE(PG8_SB(1, 1), cB + hstepB + kstep, voffB);
        PG8_WAIT_V(6); PG8_BAR;
    }
    for (;;) {
        const bool has_next = S.next(ui + 1, nxt);
        const char* nA = has_next ? (const char*)g.A + (size_t)nxt.z * g.zsA + (size_t)nxt.pm * tstepA + (size_t)nxt.k0 * 2 : cA; const char* nB = has_next ? (const char*)g.Bt + (size_t)nxt.z * g.zsB + (size_t)nxt.pn * tstepB + (size_t)nxt.k0 * 2 : cB;
        for (int t = 0; t < nt; t += 2) {
            const bool last = (t == nt - 2);
            const char* a1 = cA + (size_t)(t + 1) * kstep;
            const char* a2 = last ? nA : cA + (size_t)(t + 2) * kstep; const char* b2 = last ? nB : cB + (size_t)(t + 2) * kstep;
            const char* a3 = a2 + kstep; const char* b3 = b2 + kstep;
            if (last && has_next) S.a_ready(nxt);
            if constexpr (SP2) {
            PG8_LDB(B0, 0, 0); PG8_LDB(B1, 0, 1); PG8_SCHED; PG8_LDA(At, 0, 0); PG8_STAGE(PG8_SA(1, 1), a1 + hstepA, voffA);
            PG8_WAIT_V(8); PG8_WAIT_L(0); PG8_BAR; PG8_MMA(0, 0, At, B0); PG8_MMA(0, 1, At, B1); PG8_BAR; PG8_SCHED;
            PG8_LDA(At, 0, 1); PG8_STAGE(PG8_SB(0, 0), b2, voffB); PG8_STAGE(PG8_SB(0, 1), b2 + hstepB, voffB); PG8_STAGE(PG8_SA(0, 0), a2, voffA);
            PG8_WAIT_V(8); PG8_WAIT_L(0); PG8_BAR; PG8_MMA(1, 0, At, B0); PG8_MMA(1, 1, At, B1); PG8_BAR; PG8_SCHED;
            PG8_LDB(B0, 1, 0); PG8_LDB(B1, 1, 1); PG8_SCHED; PG8_LDA(At, 1, 0); PG8_STAGE(PG8_SA(0, 1), a2 + hstepA, voffA);
            PG8_WAIT_V(8); PG8_WAIT_L(0); PG8_BAR; PG8_MMA(0, 0, At, B0); PG8_MMA(0, 1, At, B1); PG8_BAR; PG8_SCHED;
            PG8_LDA(At, 1, 1); PG8_STAGE(PG8_SB(1, 0), b3, voffB); PG8_STAGE(PG8_SB(1, 1), b3 + hstepB, voffB); PG8_STAGE(PG8_SA(1, 0), a3, voffA);
            PG8_WAIT_V(8); PG8_WAIT_L(0); PG8_BAR; PG8_MMA(1, 0, At, B0); PG8_MMA(1, 1, At, B1); PG8_BAR; PG8_SCHED;
            } else {
            PG8_LDB(B0, 0, 0); PG8_SCHED; PG8_LDA(At, 0, 0); PG8_STAGE(PG8_SA(1, 1), a1 + hstepA, voffA);
            PG8_WAIT_L(8); PG8_BAR; PG8_WAIT_L(0); PG8_MMA(0, 0, At, B0); PG8_BAR; PG8_SCHED;
            PG8_LDB(B1, 0, 1); PG8_STAGE(PG8_SB(0, 0), b2, voffB);
            PG8_BAR; PG8_WAIT_L(0); PG8_MMA(0, 1, At, B1); PG8_BAR;
            PG8_LDA(At, 0, 1); PG8_STAGE(PG8_SA(0, 0), a2, voffA);
            PG8_BAR; PG8_WAIT_L(0); PG8_MMA(1, 0, At, B0); PG8_BAR; PG8_SCHED;
            PG8_STAGE(PG8_SB(0, 1), b2 + hstepB, voffB);
            PG8_WAIT_V(6); PG8_BAR; PG8_MMA(1, 1, At, B1); PG8_BAR;
            PG8_LDB(B0, 1, 0); PG8_SCHED; PG8_LDA(At, 1, 0); PG8_STAGE(PG8_SA(0, 1), a2 + hstepA, voffA);
            PG8_WAIT_L(8); PG8_BAR; PG8_WAIT_L(0); PG8_MMA(0, 0, At, B0); PG8_BAR; PG8_SCHED;
            PG8_LDB(B1, 1, 1); PG8_STAGE(PG8_SB(1, 0), b3, voffB);
            PG8_BAR; PG8_WAIT_L(0); PG8_MMA(0, 1, At, B1); PG8_BAR;
            PG8_LDA(At, 1, 1); PG8_STAGE(PG8_SA(1, 0), a3, voffA);
            PG8_BAR; PG8_WAIT_L(0); PG8_MMA(1, 0, At, B0); PG8_BAR; PG8_SCHED;
            PG8_STAGE(PG8_SB(1, 1), b3 + hstepB, voffB);
            PG8_WAIT_V(6); PG8_BAR; PG8_MMA(1, 1, At, B1); PG8_BAR;
            }
        }
        if constexpr (ALIGN_EPI) { if (wr == 0) PG8_BAR; }
        if constexpr (!Epi::AFTER_DRAIN) { E(acc, cur, wr, wc, fr, fq); S.done(cur); }
        if (!has_next) break;
#pragma unroll
        for (int a = 0; a < 2; ++a)
#pragma unroll
            for (int b = 0; b < 2; ++b)
#pragma unroll
                for (int m = 0; m < 4; ++m)
#pragma unroll
                    for (int n = 0; n < 2; ++n) acc[a][b][m][n] = (f32x4){0.f, 0.f, 0.f, 0.f};
        cur = nxt; cA = nA; cB = nB; ++ui;
        if constexpr (ALIGN_EPI) { if (wr == 1) PG8_BAR; }
    }
    PG8_WAIT_V(0);
    if constexpr (!ALIGN_EPI) { if (wr == 0) PG8_BAR; }
    PG8_BAR;
    if constexpr (Epi::AFTER_DRAIN) { E.fused(acc, cur, wr, wc, fr, fq, lds, wid, lane); S.done(cur); }
#undef PG8_SA
#undef PG8_SB
#undef PG8_STAGE
#undef PG8_LDA
#undef PG8_LDB
#undef PG8_MMA
#undef PG8_WAIT_V
#undef PG8_WAIT_L
#undef PG8_BAR
#undef PG8_SCHED
}
}

constexpr int DM = 2048, NB = 4, SEQ = 2048, DEPTH = 4, GW = 64, CTXL = 256, DFF = 8192;
constexpr int ML = NB * SEQ, MC = NB * CTXL, MT = ML + MC;
constexpr int NIN = 17440, NINP = 17664;
constexpr int NHEAD = 8;
constexpr float LN_EPS = 1e-5f, RMS_EPS = 1e-6f;
constexpr float DN_ALPHA = 1.6817928305074290f;
constexpr int PC_AQ = 0, PC_AI = 1024, PC_AG = 2048, PC_AFF = 3072, PC_AFB = 4096, PC_BQ = 5120, PC_BK = 5632, PC_BV = 6144, PC_BG = 7168,
              PC_CQ = 8192, PC_CK = 9216, PC_CV = 10240, PC_GT = 11264, PC_GK = 17408;
__host__ __device__ __forceinline__ int in_src_col(int n) { return n < 8192 ? n : (n < 17408 ? n + 32 : (n < 17440 ? 8192 + (n - 17408) : -1)); }

constexpr size_t MiB = 1u << 20;
constexpr size_t WS_CTL = 0, CTL_ZERO_BYTES = 1 * MiB;
constexpr size_t WS_MODP = 1 * MiB;
constexpr size_t WS_MOD = WS_MODP + 16 * MiB;
constexpr size_t WS_TAB = WS_MOD + 1 * MiB;
constexpr size_t TAB_LB = 0, TAB_RR = 32768, TAB_RC = 32768 + 4096;
constexpr size_t WS_WIN = WS_TAB + 1 * MiB;
constexpr size_t WS_WBR = WS_WIN + 277 * MiB;
constexpr size_t WS_WOUT = WS_WBR + 48 * MiB;
constexpr size_t WS_WM1 = WS_WOUT + 32 * MiB;
constexpr size_t WS_WM2 = WS_WM1 + 128 * MiB;
constexpr size_t WS_XS = WS_WM2 + 128 * MiB;
constexpr size_t WS_H = WS_XS + 72 * MiB;
constexpr size_t WS_P = WS_H + 36 * MiB;
constexpr size_t WS_Y = WS_P + 311 * MiB;
constexpr size_t WS_U = WS_Y + 54 * MiB;
constexpr size_t WS_MIX = WS_U + 36 * MiB;
constexpr size_t WS_HM = WS_MIX + 72 * MiB;
constexpr size_t WS_SCAN = WS_HM + 144 * MiB;
constexpr size_t WS_PART = WS_SCAN + 400 * MiB;
constexpr size_t WS_UC = WS_PART + 96 * MiB;
constexpr size_t WS_END = WS_UC + 12 * MiB;
static_assert((size_t)4 * NINP * 2048 * 2 <= 277 * MiB && (size_t)MT * NINP * 2 <= 311 * MiB, "ws map");

constexpr int RING_OFF = 0, RING_BYTES = 131072;
constexpr int LDS_BYTES = 163840;
constexpr int LDSCTL_OFF = LDS_BYTES - 1024, MISC_OFF = LDSCTL_OFF + 320;
constexpr int NWAVES = 8;

#define GAS __attribute__((address_space(1)))
#define LAS __attribute__((address_space(3)))
typedef unsigned short bf16;
typedef unsigned v4u __attribute__((ext_vector_type(4)));
typedef unsigned v2u __attribute__((ext_vector_type(2)));
typedef float f32x4 __attribute__((ext_vector_type(4)));
typedef float f32x2 __attribute__((ext_vector_type(2)));
typedef short bf16x8 __attribute__((ext_vector_type(8)));
typedef GAS unsigned gu32;
#define RLX_AGENT __ATOMIC_RELAXED, __HIP_MEMORY_SCOPE_AGENT
#define LDS_WAIT() asm volatile("s_waitcnt lgkmcnt(0)" ::: "memory")
#define VM_WAIT() asm volatile("s_waitcnt vmcnt(0)" ::: "memory")
typedef float f32x2_t __attribute__((ext_vector_type(2))); typedef __bf16 bf16x2_t __attribute__((ext_vector_type(2)));
__device__ __forceinline__ unsigned pk2(float lo, float hi) { const f32x2_t v = {lo, hi}; const bf16x2_t b = __builtin_convertvector(v, bf16x2_t); return __builtin_bit_cast(unsigned, b); }
__device__ __forceinline__ unsigned f2bf(float f) { return pk2(f, 0.f) & 0xffffu; }
__device__ __forceinline__ float bflo(unsigned w) { return __uint_as_float(w << 16); }
__device__ __forceinline__ float bfhi(unsigned w) { return __uint_as_float(w & 0xffff0000u); }
__device__ __forceinline__ float bf2f(bf16 h) { return __uint_as_float(((unsigned)h) << 16); }
__device__ __forceinline__ float sigmoidf_(float x) { return __builtin_amdgcn_rcpf(1.f + __expf(-x)); }
__device__ __forceinline__ float wave_sum(float v) {
#pragma unroll
    for (int o = 1; o < 64; o <<= 1) v += __shfl_xor(v, o);
    return v;
}
constexpr int CW_TMO = 0, CW_CODE = 1, CW_BAR = 4096, CW_QUEUE = 16384;

#define XB_TMO      128
#define XB_XCNT(j)  (256  + 64 * (j))
#define XB_XSUB(j)  (1280 + 64 * (j))
#define XB_XGEN(j)  (2304 + 64 * (j))
#define XB_TOP      3328
#define XB_TOPGEN   3392
#define XCD_BAR_WORDS 3456
#define XB_SPIN_CAP (1u << 18)

__device__ __forceinline__ unsigned xb_ld(unsigned* p)              { return __hip_atomic_load(p, __ATOMIC_RELAXED, __HIP_MEMORY_SCOPE_AGENT); }
__device__ __forceinline__ unsigned xb_add(unsigned* p, unsigned v) { return __hip_atomic_fetch_add(p, v, __ATOMIC_RELAXED, __HIP_MEMORY_SCOPE_AGENT); }
__device__ __forceinline__ unsigned xb_xcc_id() { return (unsigned)__builtin_amdgcn_s_getreg((3 << 11) | 20) & 0xFu; }
#define XB_SPIN(cond, bar) do { unsigned _sp = 0; while (cond) { __builtin_amdgcn_s_sleep(1); \
    if ((++_sp & 255u) == 0u) { if (xb_ld(&(bar)[XB_TMO])) break; if (_sp > XB_SPIN_CAP) { atomicAdd(&(bar)[XB_TMO], 1u); break; } } } } while (0)

__device__ __forceinline__ int xb_lane() { int z = 0; asm volatile("" : "+v"(z)); return (int)__builtin_amdgcn_mbcnt_hi(~0u, __builtin_amdgcn_mbcnt_lo(~0u, (unsigned)z)); }
struct XcdBarrier {
    unsigned* bar; unsigned x;
    int wave;
    volatile LAS unsigned* st;
};

__device__ __forceinline__ XcdBarrier xcd_barrier_post(unsigned* bar, volatile LAS unsigned* st) {
    XcdBarrier b; b.bar = bar; b.x = xb_xcc_id(); b.st = st; b.wave = __builtin_amdgcn_readfirstlane((int)threadIdx.x >> 6);
    if (threadIdx.x == 0) (void)xb_add(&bar[XB_XCNT(b.x)], 1u);
    return b;
}
__device__ __forceinline__ void xcd_barrier_complete(unsigned* bar, unsigned x, unsigned& nloc, unsigned& nx) {
    const unsigned G = gridDim.x * gridDim.y * gridDim.z;
    unsigned sum, cnt, mine, sp = 0u;
    for (;;) {
        sum = 0u; cnt = 0u; mine = 0u;
#pragma unroll
        for (unsigned j = 0; j < 16; ++j) { const unsigned c = xb_ld(&bar[XB_XCNT(j)]); sum += c; cnt += (c > 0u) ? 1u : 0u; mine = (j == x) ? c : mine; }
        if (sum == G) break;
        __builtin_amdgcn_s_sleep(1);
        if ((++sp & 255u) == 0u) { if (xb_ld(&bar[XB_TMO])) break; if (sp > XB_SPIN_CAP) { atomicAdd(&bar[XB_TMO], 1u); break; } }
    }
    nloc = mine > 0u ? mine : 1u; nx = cnt > 0u ? cnt : 1u;
}

__device__ __forceinline__ void xcd_barrier(const XcdBarrier& b) {
    asm volatile("s_waitcnt vmcnt(0)" ::: "memory");
    __syncthreads();
    if (b.wave == 0 && xb_lane() == 0) {
        unsigned* bar = b.bar;
        __builtin_amdgcn_s_waitcnt(0);
        unsigned nloc = b.st[0], nx = b.st[1];
        if (nloc == 0u) { xcd_barrier_complete(bar, b.x, nloc, nx); b.st[0] = nloc; b.st[1] = nx; }
        const unsigned old = xb_add(&bar[XB_XSUB(b.x)], 1u);
        const unsigned gen = old / nloc;
        if (old + 1u == (gen + 1u) * nloc) {
            __builtin_amdgcn_fence(__ATOMIC_RELEASE, "agent");
            asm volatile("s_waitcnt vmcnt(0)" ::: "memory");
            const unsigned og = xb_add(&bar[XB_TOP], 1u);
            const unsigned tg = og / nx;
            if (og + 1u == (tg + 1u) * nx) xb_add(&bar[XB_TOPGEN], 1u);
            else XB_SPIN(xb_ld(&bar[XB_TOPGEN]) == tg, bar);
            __builtin_amdgcn_fence(__ATOMIC_ACQUIRE, "agent");
            xb_add(&bar[XB_XGEN(b.x)], 1u);
            asm volatile("s_waitcnt vmcnt(0)" ::: "memory");
        } else {
            XB_SPIN(xb_ld(&bar[XB_XGEN(b.x)]) == gen, bar);
            __builtin_amdgcn_fence(__ATOMIC_ACQUIRE, "agent");
            asm volatile("s_waitcnt vmcnt(0)" ::: "memory");
        }
    }
    __syncthreads();
}


typedef const float* cfp_t; typedef __attribute__((address_space(4))) const cfp_t* kin_t;
__device__ __forceinline__ kin_t kin_launder(kin_t p) { asm volatile("" : "+s"(p)); return p; }
#define FIN(k) (kin_launder(F.kin)[k])
struct Frame {
    LAS unsigned char* lds;
    volatile LAS unsigned* MISC;
    gu32* ctl;
    int tid, lane, wave;
    int vcu, G;
    unsigned char* ws;
    kin_t kin;
    float* out;
};

__device__ __forceinline__ void p0_transpose_item(const float* W, int ldw, int src_col0, int k0, bf16* WT, int K, int dst_row0, LAS float* scr, int lane) {
    const int kr = lane >> 3, nc = lane & 7;
    f32x4 v[8];
    if (src_col0 >= 0) { const float* wp = W + (size_t)(k0 + kr) * ldw + src_col0 + 4 * nc;
#pragma unroll
        for (int i = 0; i < 8; ++i) v[i] = *(const GAS f32x4*)(wp + (size_t)(8 * i) * ldw);
    } else {
#pragma unroll
        for (int i = 0; i < 8; ++i) v[i] = (f32x4){0.f, 0.f, 0.f, 0.f};
    }
#pragma unroll
    for (int i = 0; i < 8; ++i) { LAS float* d = scr + (8 * i + kr) * 33 + 4 * nc; d[0] = v[i][0]; d[1] = v[i][1]; d[2] = v[i][2]; d[3] = v[i][3]; }
    LDS_WAIT(); asm volatile("" ::: "memory");
    const int c = lane & 7;
#pragma unroll
    for (int j = 0; j < 4; ++j) { const int n = (lane >> 3) + 8 * j; const LAS float* s = scr + (8 * c) * 33 + n;
        v4u o; o.x = pk2(s[0 * 33], s[1 * 33]); o.y = pk2(s[2 * 33], s[3 * 33]); o.z = pk2(s[4 * 33], s[5 * 33]); o.w = pk2(s[6 * 33], s[7 * 33]);
        *(GAS v4u*)(WT + (size_t)(dst_row0 + n) * K + k0 + 8 * c) = o; }
    LDS_WAIT(); asm volatile("" ::: "memory");
}
constexpr int CV_IIN = 32 * (NINP / 32), CV_IBR = 3 * 16 * 64, CV_IOUT = 32 * 64, CV_IM1 = 32 * 256, CV_IM2 = 128 * 64, CV_IL = CV_IIN + CV_IBR + CV_IOUT + CV_IM1 + CV_IM2;
constexpr int CV_P0 = 11168, CV_P1 = 18168, CV_P2 = 27168;
__device__ __forceinline__ void convert_items(Frame& F, int l, int r_lo, int r_hi, int widx, int nw) {
    LAS float* scr = (LAS float*)(F.lds + RING_OFF + F.wave * 8448); const int lane = xb_lane();
    for (int it = r_lo + widx; it < r_hi; it += nw) { int r = it;
        if (r < CV_IIN) { const int nbk = NINP / 32, kb = r / nbk, nb = r % nbk; p0_transpose_item(FIN(6) + (size_t)l * 2048 * NIN, NIN, in_src_col(32 * nb), 64 * kb, (bf16*)(F.ws + WS_WIN) + (size_t)l * NINP * 2048, 2048, 32 * nb, scr, lane); continue; } r -= CV_IIN;
        if (r < CV_IBR) { const int n = r / 1024, rr = r % 1024, kb = rr / 64, nb = rr % 64; p0_transpose_item(FIN(13) + (size_t)(l * 3 + n) * 1024 * 2048, 2048, 32 * nb, 64 * kb, (bf16*)(F.ws + WS_WBR) + (size_t)(l * 3 + n) * 2048 * 1024, 1024, 32 * nb, scr, lane); continue; } r -= CV_IBR;
        if (r < CV_IOUT) { const int kb = r / 64, nb = r % 64; p0_transpose_item(FIN(14) + (size_t)l * 2048 * 2048, 2048, 32 * nb, 64 * kb, (bf16*)(F.ws + WS_WOUT) + (size_t)l * 2048 * 2048, 2048, 32 * nb, scr, lane); continue; } r -= CV_IOUT;
        if (r < CV_IM1) { const int kb = r / 256, nb = r % 256; p0_transpose_item(FIN(19) + (size_t)l * 2048 * 8192, 8192, 32 * nb, 64 * kb, (bf16*)(F.ws + WS_WM1) + (size_t)l * 8192 * 2048, 2048, 32 * nb, scr, lane); continue; } r -= CV_IM1;
        { const int kb = r / 64, nb = r % 64; p0_transpose_item(FIN(20) + (size_t)l * 8192 * 2048, 2048, 32 * nb, 64 * kb, (bf16*)(F.ws + WS_WM2) + (size_t)l * 2048 * 8192, 8192, 32 * nb, scr, lane); }
    }
}
__device__ __forceinline__ void convert_pocket(Frame& F, int lnext, int r_lo, int r_hi, int first_idle) {
    const int c = (int)blockIdx.x; if (lnext >= DEPTH || c < first_idle) return;
    convert_items(F, lnext, r_lo, r_hi, (c - first_idle) * NWAVES + F.wave, ((int)gridDim.x - first_idle) * NWAVES);
}
__device__ __forceinline__ void p0_prologue(Frame& FF) {
    Frame F = FF; F.lane = xb_lane(); F.tid = F.wave * 64 + F.lane;
    LAS float* scr = (LAS float*)(F.lds + RING_OFF + F.wave * 8448);
    LAS float* sil = (LAS float*)(F.lds + RING_OFF + 69632);
    const int gw = F.vcu * NWAVES + F.wave, NGW = F.G * NWAVES;
    for (int i = F.tid; i < 5 * 2048; i += NWAVES * 64) { const int b = i >> 11, k = i & 2047; const float v = (b < 4) ? FIN(1)[b * 2048 + k] : FIN(3)[k]; sil[i] = v * sigmoidf_(v); }
    { float* LB = (float*)(F.ws + WS_TAB + TAB_LB);
      for (int i = gw * 64 + F.lane; i < 2048; i += NGW * 64) { float e[4], mx = -1e30f;
#pragma unroll
          for (int l = 0; l < 4; ++l) { e[l] = FIN(7)[l * 2048 + i]; mx = fmaxf(mx, e[l]); }
          float s = 0.f;
#pragma unroll
          for (int l = 0; l < 4; ++l) { e[l] = expf(e[l] - mx); s += e[l]; }
          const float inv = 1.f / s; float cum = 0.f;
#pragma unroll
          for (int l = 0; l < 4; ++l) { LB[l * 2048 + i] = cum; cum += e[l] * inv; } }
      f32x2* RR = (f32x2*)(F.ws + WS_TAB + TAB_RR); f32x2* RC = (f32x2*)(F.ws + WS_TAB + TAB_RC);
      for (int i = gw * 64 + F.lane; i < 96 * 16; i += NGW * 64) { const int p = i >> 4, j = i & 15; const int pos = p < 32 ? p : p - 32;
          const float fr = expf(-(float)j * (9.210340371976184f / 16.f)); const float ang = (float)pos * fr; const f32x2 cs = {cosf(ang), sinf(ang)};
          if (p < 32) RR[p * 16 + j] = cs; else RC[(p - 32) * 16 + j] = cs; } }
    __syncthreads();
    for (int u = gw; u < 3072; u += NGW) { const int l = u / 768, r = u % 768, cb = r >> 4, ks = r & 15; const int c0 = cb * 256 + 4 * F.lane;
        f32x4 acc[5];
#pragma unroll
        for (int b = 0; b < 5; ++b) acc[b] = (f32x4){0.f, 0.f, 0.f, 0.f};
        const float* wp = FIN(4) + ((size_t)l * 2048 + ks * 128) * 12288 + c0;
#pragma unroll 8
        for (int k = 0; k < 128; ++k) { const f32x4 w = *(const GAS f32x4*)(wp + (size_t)k * 12288);
#pragma unroll
            for (int b = 0; b < 5; ++b) acc[b] += w * sil[b * 2048 + ks * 128 + k]; }
        float* mp = (float*)(F.ws + WS_MODP) + ((size_t)(ks * 4 + l) * 5) * 12288 + c0;
#pragma unroll
        for (int b = 0; b < 5; ++b) *(GAS f32x4*)(mp + (size_t)b * 12288) = acc[b]; }
    convert_items(F, 0, 0, CV_IL, gw, NGW);
    for (int l = 1; l < DEPTH; ++l) convert_items(F, l, 0, F.G == 256 ? CV_P0 : CV_IL, gw, NGW);
}
__device__ __forceinline__ void p0b_modreduce(Frame& FF) {
    Frame F = FF; F.lane = xb_lane(); F.tid = F.wave * 64 + F.lane;
    const float* mp = (const float*)(F.ws + WS_MODP); float* mo = (float*)(F.ws + WS_MOD);
    for (int i = (F.vcu * NWAVES + F.wave) * 64 + F.lane; i < 4 * 5 * 12288; i += F.G * NWAVES * 64) { const int l = i / (5 * 12288), c = i % 12288;
        float s = FIN(5)[l * 12288 + c];
#pragma unroll
        for (int ks = 0; ks < 16; ++ks) s += mp[(size_t)ks * (4 * 5 * 12288) + i];
        mo[i] = s; }
}
__device__ __forceinline__ int row_modb(int row) { return row < ML ? (row >> 11) : 4; }
__device__ __forceinline__ const float* row_input(const Frame& F, int row) { return row < ML ? FIN(0) + (size_t)row * DM : FIN(2) + (size_t)(row - ML) * DM; }
__device__ __forceinline__ void store_modulated(const f32x4 (&v)[8], const float* sc, const float* sh, bf16* hrow, int lane) {
#pragma unroll
    for (int j = 0; j < 8; ++j) { const int c = 4 * lane + 256 * j; const f32x4 s = *(const GAS f32x4*)(sc + c), t = *(const GAS f32x4*)(sh + c);
        const f32x4 o = v[j] * (s + 1.0f) + t; v2u w; w.x = pk2(o[0], o[1]); w.y = pk2(o[2], o[3]); *(GAS v2u*)(hrow + c) = w; }
}
__device__ __forceinline__ void p0c_modulate(Frame& FF) {
    Frame F = FF; F.lane = xb_lane(); F.tid = F.wave * 64 + F.lane;
    const float* mo = (const float*)(F.ws + WS_MOD); bf16* H = (bf16*)(F.ws + WS_H);
    for (int row = F.vcu * NWAVES + F.wave; row < MT; row += F.G * NWAVES) { const float* xr = row_input(F, row); const float* mb = mo + (size_t)row_modb(row) * 12288;
        f32x4 v[8];
#pragma unroll
        for (int j = 0; j < 8; ++j) v[j] = *(const GAS f32x4*)(xr + 4 * F.lane + 256 * j);
        store_modulated(v, mb + 1 * 2048, mb + 0 * 2048, H + (size_t)row * DM, F.lane); }
}
__device__ __forceinline__ void ln_rows(Frame& F, const float* xbase, const float* mixbase, int nslab, float* obase, bf16* hbase, int row0, int nr, bool hm, LAS float* V, int lane, int wave) {
    f32x4 xn[8], mn[8];
    const bool part = nslab > 0;
    const unsigned ol = (unsigned)(16 * lane);
#define LN_UB(p) ([&]() -> const char* { const char* b_ = (const char*)(p); asm volatile("" : "+s"(b_)); return b_; }())
#define LN_LOAD(row) do { const char* xr_ = LN_UB(xbase + (size_t)(row) * DM); _Pragma("unroll") for (int j = 0; j < 8; ++j) xn[j] = *(const GAS f32x4*)(xr_ + ol + 1024 * j); \
        if (!part) { const char* mr_ = LN_UB((const bf16*)mixbase + (size_t)(row) * DM); _Pragma("unroll") for (int j = 0; j < 8; ++j) { const v2u w_ = *(const GAS v2u*)(mr_ + (ol >> 1) + 512 * j); mn[j] = (f32x4){bflo(w_.x), bfhi(w_.x), bflo(w_.y), bfhi(w_.y)}; } } \
        else { const bf16* pr0_ = (const bf16*)mixbase + (size_t)((row) - ML) * DM; _Pragma("unroll") for (int j = 0; j < 8; ++j) mn[j] = (f32x4){0.f, 0.f, 0.f, 0.f}; \
            _Pragma("nounroll") for (int ks = 0; ks < nslab; ++ks) { const char* ps_ = LN_UB(pr0_ + (size_t)ks * MC * DM); _Pragma("unroll") for (int j = 0; j < 8; ++j) { const v2u w_ = *(const GAS v2u*)(ps_ + (ol >> 1) + 512 * j); mn[j] += (f32x4){bflo(w_.x), bfhi(w_.x), bflo(w_.y), bfhi(w_.y)}; } } } } while (0)
    if (nr > 0) LN_LOAD(row0 + wave);
    for (int i = 0; i < nr; ++i) { const int row = row0 + wave + 8 * i;
        f32x4 v[8]; float s = 0.f;
#pragma unroll
        for (int j = 0; j < 8; ++j) { const f32x4 g = *(const LAS f32x4*)(V + 0 * 2048 + 4 * lane + 256 * j); v[j] = xn[j] * DN_ALPHA + g * mn[j]; s += (v[j][0] + v[j][1]) + (v[j][2] + v[j][3]); }
        __builtin_amdgcn_sched_barrier(0);
        if (i + 1 < nr) LN_LOAD(row + 8);
        __builtin_amdgcn_sched_barrier(0);
        const float mean = wave_sum(s) * (1.f / DM); float q = 0.f;
#pragma unroll
        for (int j = 0; j < 8; ++j) { v[j] = v[j] - mean; q += (v[j][0] * v[j][0] + v[j][1] * v[j][1]) + (v[j][2] * v[j][2] + v[j][3] * v[j][3]); }
        const float rstd = 1.0f / sqrtf(wave_sum(q) * (1.f / DM) + LN_EPS);
        char* orow = (char*)(obase + (size_t)row * DM) + ol; char* hrow = (char*)(hbase + (size_t)row * DM) + (ol >> 1);
#pragma unroll
        for (int j = 0; j < 8; ++j) { const f32x4 g = *(const LAS f32x4*)(V + 1 * 2048 + 4 * lane + 256 * j), b = *(const LAS f32x4*)(V + 2 * 2048 + 4 * lane + 256 * j);
            v[j] = v[j] * rstd * g + b; *(GAS f32x4*)(orow + 1024 * j) = v[j];
            if (hm) { const f32x4 sc = *(const LAS f32x4*)(V + 3 * 2048 + 4 * lane + 256 * j), sh = *(const LAS f32x4*)(V + 4 * 2048 + 4 * lane + 256 * j); const f32x4 o = v[j] * sc + sh;
                v2u w; w.x = pk2(o[0], o[1]); w.y = pk2(o[2], o[3]); *(GAS v2u*)(hrow + 512 * j) = w; }
            if (j & 1) __builtin_amdgcn_sched_barrier(0); }
    }
#undef LN_LOAD
#undef LN_UB
}
__device__ __forceinline__ void ln_phase(Frame& FF, int l, int gi, const float* lng, const float* lnb, int lh, int hmod, bool first, bool to_out, int nrows, bool dry, int nslab) {
    Frame F = FF; F.lane = xb_lane(); F.tid = F.wave * 64 + F.lane;
    const float* mo = (const float*)(F.ws + WS_MOD); float* XS = (float*)(F.ws + WS_XS); const float* MIX = (const float*)(F.ws + WS_MIX); bf16* H = dry ? (bf16*)(F.ws + WS_HM + 72 * MiB) : (bf16*)(F.ws + WS_H);
    LAS float* V = (LAS float*)(F.lds + RING_OFF);
    if (F.G != 256) {
        for (int row = F.vcu * NWAVES + F.wave; row < nrows; row += F.G * NWAVES) { const int mb = row_modb(row);
            const float* xr = first ? row_input(F, row) : XS + (size_t)row * DM; const float* gv = mo + ((size_t)l * 5 + mb) * 12288 + gi * 2048;
            f32x4 v[8]; float s = 0.f;
#pragma unroll
            for (int j = 0; j < 8; ++j) { const int c = 4 * F.lane + 256 * j; const f32x4 xv = *(const GAS f32x4*)(xr + c), g = *(const GAS f32x4*)(gv + c); f32x4 mv;
                if (row < ML) { const v2u w_ = *(const GAS v2u*)((const bf16*)MIX + (size_t)row * DM + c); mv = (f32x4){bflo(w_.x), bfhi(w_.x), bflo(w_.y), bfhi(w_.y)}; }
                else { const bf16* pr = (const bf16*)(F.ws + WS_PART) + (size_t)(row - ML) * DM + c; mv = (f32x4){0.f, 0.f, 0.f, 0.f}; for (int ks = 0; ks < nslab; ++ks) { const v2u w_ = *(const GAS v2u*)(pr + (size_t)ks * MC * DM); mv += (f32x4){bflo(w_.x), bfhi(w_.x), bflo(w_.y), bfhi(w_.y)}; } }
                v[j] = xv * DN_ALPHA + g * mv; s += (v[j][0] + v[j][1]) + (v[j][2] + v[j][3]); }
            const float mean = wave_sum(s) * (1.f / DM); float q = 0.f;
#pragma unroll
            for (int j = 0; j < 8; ++j) { v[j] = v[j] - mean; q += (v[j][0] * v[j][0] + v[j][1] * v[j][1]) + (v[j][2] * v[j][2] + v[j][3] * v[j][3]); }
            const float rstd = 1.0f / sqrtf(wave_sum(q) * (1.f / DM) + LN_EPS);
            float* orow = dry ? (float*)(F.ws + WS_HM) + (size_t)row * DM : (to_out ? F.out + (size_t)row * DM : XS + (size_t)row * DM);
#pragma unroll
            for (int j = 0; j < 8; ++j) { const int c = 4 * F.lane + 256 * j; const f32x4 g = *(const GAS f32x4*)(lng + c), b = *(const GAS f32x4*)(lnb + c); v[j] = v[j] * rstd * g + b; *(GAS f32x4*)(orow + c) = v[j]; }
            if (hmod >= 0) { const float* mh = mo + ((size_t)lh * 5 + mb) * 12288; store_modulated(v, mh + (hmod + 1) * 2048, mh + hmod * 2048, H + (size_t)row * DM, F.lane); } }
        return;
    }
    float* obase = dry ? (float*)(F.ws + WS_HM) : (to_out ? F.out : XS);
#pragma unroll 1
    for (int seg = 0; seg < 2; ++seg) {
        if (seg == 1 && nrows <= ML) break;
        const int mb = seg == 0 ? (F.vcu >> 6) : 4;
        __syncthreads();
        { const float* gv = mo + ((size_t)l * 5 + mb) * 12288 + gi * 2048; const float* mh = mo + ((size_t)(hmod >= 0 ? lh : l) * 5 + mb) * 12288; const int c = 4 * F.tid;
          *(LAS f32x4*)(V + 0 * 2048 + c) = *(const GAS f32x4*)(gv + c); *(LAS f32x4*)(V + 1 * 2048 + c) = *(const GAS f32x4*)(lng + c); *(LAS f32x4*)(V + 2 * 2048 + c) = *(const GAS f32x4*)(lnb + c);
          if (hmod >= 0) { *(LAS f32x4*)(V + 3 * 2048 + c) = *(const GAS f32x4*)(mh + (hmod + 1) * 2048 + c) + 1.0f; *(LAS f32x4*)(V + 4 * 2048 + c) = *(const GAS f32x4*)(mh + hmod * 2048 + c); } }
        LDS_WAIT(); __syncthreads();
        if (seg == 0) ln_rows(F, first ? FIN(0) : XS, MIX, 0, obase, H, 32 * F.vcu, 4, hmod >= 0, V, F.lane, F.wave);
        else ln_rows(F, first ? FIN(2) - (size_t)ML * DM : XS, (const float*)(F.ws + WS_PART), nslab, obase, H, ML + 4 * F.vcu, F.wave < 4 ? 1 : 0, hmod >= 0, V, F.lane, F.wave);
    }
}

typedef float f32x16 __attribute__((ext_vector_type(16)));
constexpr int NCH = 144;
constexpr size_t SC_QA = 0, SC_KA = SC_QA + 18 * MiB, SC_EA = SC_KA + 36 * MiB, SC_KTA = SC_EA + 72 * MiB, SC_AEA = SC_KTA + 36 * MiB, SC_BEA = SC_AEA + 2 * MiB, SC_VTA = SC_BEA + 2 * MiB, SC_SPA = SC_VTA + 18 * MiB,
                 SC_QB = SC_SPA + 72 * MiB, SC_KB = SC_QB + 9 * MiB, SC_EB = SC_KB + 9 * MiB, SC_KTB = SC_EB + 36 * MiB, SC_AEB = SC_KTB + 18 * MiB, SC_BEB = SC_AEB + 1 * MiB, SC_VTB = SC_BEB + 1 * MiB, SC_SPB = SC_VTB + 18 * MiB, SC_END = SC_SPB + 36 * MiB;
static_assert(SC_END <= 400 * MiB, "scan scratch");
template <int DK> struct ScanBufs {
    bf16* Q;
    bf16* K;
    unsigned short* E;
    bf16* KT;
    float* AE;
    float* BE;
    bf16* VT;
    bf16* SP;
};
__device__ __forceinline__ ScanBufs<128> bufsA(unsigned char* ws) { unsigned char* s = ws + WS_SCAN; return ScanBufs<128>{(bf16*)(s + SC_QA), (bf16*)(s + SC_KA), (unsigned short*)(s + SC_EA), (bf16*)(s + SC_KTA), (float*)(s + SC_AEA), (float*)(s + SC_BEA), (bf16*)(s + SC_VTA), (bf16*)(s + SC_SPA)}; }
__device__ __forceinline__ ScanBufs<64> bufsB(unsigned char* ws) { unsigned char* s = ws + WS_SCAN; return ScanBufs<64>{(bf16*)(s + SC_QB), (bf16*)(s + SC_QB)  , (unsigned short*)(s + SC_EB), (bf16*)(s + SC_KTB), (float*)(s + SC_AEB), (float*)(s + SC_BEB), (bf16*)(s + SC_VTB), (bf16*)(s + SC_SPB)}; }
typedef _Float16 h2_t __attribute__((ext_vector_type(2)));
__device__ __forceinline__ unsigned pkh2(float a, float b) { const h2_t v = {(_Float16)a, (_Float16)b}; return __builtin_bit_cast(unsigned, v); }
__device__ __forceinline__ float hlo(unsigned w) { return (float)__builtin_bit_cast(h2_t, w)[0]; }
__device__ __forceinline__ float hhi(unsigned w) { return (float)__builtin_bit_cast(h2_t, w)[1]; }
__device__ __forceinline__ float ex2(float x) { return __builtin_amdgcn_exp2f(x); }
__device__ __forceinline__ float clampe(float x) { return __builtin_amdgcn_fmed3f(x, -115.f, 115.f); }
__device__ __forceinline__ float bfe(const v4u& w, int c) { return (c & 1) ? bfhi(w[c >> 1]) : bflo(w[c >> 1]); }
__device__ __forceinline__ float bfe2(const v2u& w, int c) { return (c & 1) ? bfhi(w[c >> 1]) : bflo(w[c >> 1]); }

template <int NC, int CPH> __device__ __forceinline__ void store_groups(LAS v4u* Wl, const v4u (&o)[NC], bf16* hb, size_t HS, int lane) {
#pragma unroll
    for (int c = 0; c < NC; ++c) Wl[lane * NC + c] = o[c];
    LDS_WAIT();
#pragma unroll
    for (int i = 0; i < NC; ++i) { const int sidx = i * 64 + lane; const v4u v = Wl[sidx]; *(GAS v4u*)(hb + (size_t)(sidx / CPH) * HS + (size_t)(sidx % CPH) * 8) = v; }
    LDS_WAIT();
}
template <int DIR> __device__ __forceinline__ void prep_hgrn_f(const ScanBufs<128>& A, const bf16* P, const float* LB, int g, int half, int lane, LAS v4u* Wl) {
    const int ch = half * 512 + 8 * lane, h = ch >> 7, d = ch & 127; const size_t row0 = (size_t)g * 64;
    const bf16* fp = P + row0 * NINP + (DIR ? PC_AFB : PC_AFF) + ch; const bf16* qp = P + row0 * NINP + PC_AQ + ch;
    float lb[8], cum[8];
    { const f32x4 a = *(const GAS f32x4*)(LB + DIR * 1024 + ch), b = *(const GAS f32x4*)(LB + DIR * 1024 + ch + 4);
#pragma unroll
      for (int c = 0; c < 4; ++c) { lb[c] = a[c]; lb[4 + c] = b[c]; } }
#pragma unroll
    for (int c = 0; c < 8; ++c) cum[c] = 0.f;
    unsigned short* Ep = A.E + ((size_t)DIR * MT + row0) * 1024 + ch; bf16* Kp = A.K + ((size_t)DIR * MT + row0) * 1024 + ch;
    bf16* kt = A.KT + (((((size_t)DIR * NCH + g) * 8 + half * 4) * 8) * 128) * 8;
    v4u fn[4], qn[4];
#pragma unroll
    for (int j = 0; j < 4; ++j) { fn[j] = *(const GAS v4u*)(fp + (size_t)((DIR ? 0 : 60) + j) * NINP); qn[j] = *(const GAS v4u*)(qp + (size_t)((DIR ? 0 : 60) + j) * NINP); }
    for (int i8 = 0; i8 < 8; ++i8) { const int t8 = DIR ? i8 : 7 - i8;
        float kp[8][8];
#pragma unroll
        for (int hh = 0; hh < 2; ++hh) { const int hf = DIR ? hh : 1 - hh;
            v4u f[4], qf[4];
#pragma unroll
            for (int j = 0; j < 4; ++j) { f[j] = fn[j]; qf[j] = qn[j]; }
            { const int hgn = 2 * i8 + hh + 1; if (hgn < 16) { const int tb = DIR ? 4 * hgn : 60 - 4 * hgn;
#pragma unroll
                for (int j = 0; j < 4; ++j) { fn[j] = *(const GAS v4u*)(fp + (size_t)(tb + j) * NINP); qn[j] = *(const GAS v4u*)(qp + (size_t)(tb + j) * NINP); } } }
#pragma unroll
            for (int jj = 0; jj < 4; ++jj) { const int j = DIR ? jj : 3 - jj; const int t = t8 * 8 + hf * 4 + j; float ev[8], kv[8];
#pragma unroll
                for (int c = 0; c < 8; ++c) { const float x = bfe(f[j], c); const float sg = sigmoidf_(x); const float la = __log2f(lb[c] + (1.f - lb[c]) * sg); const float k = (1.f - lb[c]) * (1.f - sg);
                    const float xq = bfe(qf[j], c); const float qv = xq * sigmoidf_(xq) * 0.08838834764831845f;
                    const float e = cum[c]; cum[c] += la; kv[c] = k * ex2(e); kp[hf * 4 + j][c] = kv[c]; ev[c] = qv * ex2(fminf(-e, 126.f)); }
                { v4u ew; ew.x = pk2(ev[0], ev[1]); ew.y = pk2(ev[2], ev[3]); ew.z = pk2(ev[4], ev[5]); ew.w = pk2(ev[6], ev[7]); *(GAS v4u*)(Ep + (size_t)t * 1024) = ew; }
                v4u kw; kw.x = pk2(kv[0], kv[1]); kw.y = pk2(kv[2], kv[3]); kw.z = pk2(kv[4], kv[5]); kw.w = pk2(kv[6], kv[7]); *(GAS v4u*)(Kp + (size_t)t * 1024) = kw; } }
        { v4u og[8];
#pragma unroll
          for (int c = 0; c < 8; ++c) { og[c].x = pk2(kp[0][c], kp[1][c]); og[c].y = pk2(kp[2][c], kp[3][c]); og[c].z = pk2(kp[4][c], kp[5][c]); og[c].w = pk2(kp[6][c], kp[7][c]); }
          store_groups<8, 128>(Wl, og, kt + (size_t)t8 * 128 * 8, (size_t)8 * 128 * 8, lane); }
    }
    float* be = A.BE + (((size_t)DIR * NCH + g) * 8 + h) * 128 + d; float* ae = A.AE + (((size_t)DIR * NCH + g) * 8 + h) * 128 + d;
    *(GAS f32x4*)be = (f32x4){cum[0], cum[1], cum[2], cum[3]}; *(GAS f32x4*)(be + 4) = (f32x4){cum[4], cum[5], cum[6], cum[7]};
    *(GAS f32x4*)ae = (f32x4){ex2(cum[0]), ex2(cum[1]), ex2(cum[2]), ex2(cum[3])}; *(GAS f32x4*)(ae + 4) = (f32x4){ex2(cum[4]), ex2(cum[5]), ex2(cum[6]), ex2(cum[7])};
}
template <int DIR> __device__ __forceinline__ void prep_gla_k(const ScanBufs<64>& B, const bf16* P, const float* w2g, const float* b2g, const f32x2* RR, const LAS f32x2* RC  , int g, int half, int lane, LAS v4u* Wl, LAS v4u* Gl  ) {
    const int ch = half * 256 + 4 * lane, h = ch >> 6, d = ch & 63; const size_t row0 = (size_t)g * 64;
    float w2[16][4];
#pragma unroll
    for (int r = 0; r < 16; ++r) { const f32x4 w = *(const GAS f32x4*)(w2g + ((size_t)DIR * 16 + r) * 512 + ch); w2[r][0] = w[0]; w2[r][1] = w[1]; w2[r][2] = w[2]; w2[r][3] = w[3]; }
    const f32x4 b2 = *(const GAS f32x4*)(b2g + (size_t)DIR * 512 + ch);
    const bool lat = g < 128; const int grow = g & 31; const int j0 = d & 15; const bool isrow = d < 32; const bool second = (d & 16) != 0;
    f32x2 csr[4];
#pragma unroll
    for (int c = 0; c < 4; ++c) csr[c] = RR[grow * 16 + j0 + c];
    float cum[4] = {0.f, 0.f, 0.f, 0.f};
    const bf16* kp0 = P + row0 * NINP + PC_BK + ch; const bf16* lp0 = P + row0 * NINP + PC_GK + 16 * DIR; const bf16* qp0 = P + row0 * NINP + PC_BQ + ch;
    unsigned short* Ep = B.E + ((size_t)DIR * MT + row0) * 512 + ch; bf16* Kp = B.K + ((size_t)DIR * MT + row0) * 512 + ch;
    bf16* kt = B.KT + (((((size_t)DIR * NCH + g) * 8 + half * 4) * 8) * 64) * 8;
    { const bf16* lp = lp0 + (size_t)lane * NINP; const v4u a = *(const GAS v4u*)lp, b = *(const GAS v4u*)(lp + 8); Gl[2 * lane] = a; Gl[2 * lane + 1] = b; }
    v2u krn[4], qrn[4];
#pragma unroll
    for (int j = 0; j < 4; ++j) { const size_t ro = (size_t)((DIR ? 0 : 60) + j) * NINP; krn[j] = *(const GAS v2u*)(kp0 + ro); qrn[j] = *(const GAS v2u*)(qp0 + ro); }
    LDS_WAIT();
    for (int i8 = 0; i8 < 8; ++i8) { const int t8 = DIR ? i8 : 7 - i8;
        float kp[8][4];
#pragma unroll
        for (int hh = 0; hh < 2; ++hh) { const int hf = DIR ? hh : 1 - hh;
            v2u kr[4], qr2[4]; v4u l0[4], l1[4];
#pragma unroll
            for (int j = 0; j < 4; ++j) { kr[j] = krn[j]; qr2[j] = qrn[j]; }
            { const int hgn = 2 * i8 + hh + 1; if (hgn < 16) { const int tb = DIR ? 4 * hgn : 60 - 4 * hgn;
#pragma unroll
                for (int j = 0; j < 4; ++j) { const size_t ro = (size_t)(tb + j) * NINP; krn[j] = *(const GAS v2u*)(kp0 + ro); qrn[j] = *(const GAS v2u*)(qp0 + ro); } } }
#pragma unroll
            for (int j = 0; j < 4; ++j) { const int tt_ = t8 * 8 + hf * 4 + j; l0[j] = Gl[2 * tt_]; l1[j] = Gl[2 * tt_ + 1]; }
#pragma unroll
            for (int jj = 0; jj < 4; ++jj) { const int j = DIR ? jj : 3 - jj; const int t = t8 * 8 + hf * 4 + j; float ev[4], kv[4];
                f32x2 csc[4];
                { const LAS f32x4* rc4 = (const LAS f32x4*)(RC + t * 16 + j0); const f32x4 ra = rc4[0], rb = rc4[1];
                  csc[0] = isrow ? csr[0] : (f32x2){ra[0], ra[1]}; csc[1] = isrow ? csr[1] : (f32x2){ra[2], ra[3]}; csc[2] = isrow ? csr[2] : (f32x2){rb[0], rb[1]}; csc[3] = isrow ? csr[3] : (f32x2){rb[2], rb[3]}; }
#pragma unroll
                for (int c = 0; c < 4; ++c) { float x = b2[c];
#pragma unroll
                    for (int r = 0; r < 8; ++r) { x += bfe(l0[j], r) * w2[r][c]; x += bfe(l1[j], r) * w2[8 + r][c]; }
                    const float la = (fminf(x, 0.f) * 1.4426950408889634f - __log2f(1.f + __expf(-fabsf(x)))) * 0.0625f;
                    float k = bfe2(kr[j], c), q = bfe2(qr2[j], c);
                    if (lat) { const f32x2 cs = csc[c]; const float pt = __shfl_xor(k, 4), pq = __shfl_xor(q, 4); k = k * cs.x + (second ? pt : -pt) * cs.y; q = q * cs.x + (second ? pq : -pq) * cs.y; }
                    const float e = cum[c]; cum[c] += la; kv[c] = k * ex2(e); kp[hf * 4 + j][c] = kv[c]; ev[c] = q * 0.125f * ex2(fminf(-e, 126.f)); }
                { v2u ew; ew.x = pk2(ev[0], ev[1]); ew.y = pk2(ev[2], ev[3]); *(GAS v2u*)(Ep + (size_t)t * 512) = ew; }
                { v2u kw; kw.x = pk2(kv[0], kv[1]); kw.y = pk2(kv[2], kv[3]); *(GAS v2u*)(Kp + (size_t)t * 512) = kw; } } }
        { v4u og[4];
#pragma unroll
          for (int c = 0; c < 4; ++c) { og[c].x = pk2(kp[0][c], kp[1][c]); og[c].y = pk2(kp[2][c], kp[3][c]); og[c].z = pk2(kp[4][c], kp[5][c]); og[c].w = pk2(kp[6][c], kp[7][c]); }
          store_groups<4, 64>(Wl, og, kt + (size_t)t8 * 64 * 8, (size_t)8 * 64 * 8, lane); }
    }
    float* be = B.BE + (((size_t)DIR * NCH + g) * 8 + h) * 64 + d; float* ae = B.AE + (((size_t)DIR * NCH + g) * 8 + h) * 64 + d;
    *(GAS f32x4*)be = (f32x4){cum[0], cum[1], cum[2], cum[3]}; *(GAS f32x4*)ae = (f32x4){ex2(cum[0]), ex2(cum[1]), ex2(cum[2]), ex2(cum[3])};
}
__device__ __forceinline__ void prep_vt(const bf16* P, int vcol, bf16* VT, int g, int half, int lane, LAS v4u* Wl) {
    const int ch = half * 512 + 8 * lane, h = ch >> 7, d = ch & 127; const size_t row0 = (size_t)g * 64; const bf16* vp = P + row0 * NINP + vcol + ch; bf16* vt = VT + ((((size_t)g * 8 + half * 4) * 8) * 128) * 8;
    for (int t8 = 0; t8 < 8; ++t8) { v4u f[8];
#pragma unroll
        for (int j = 0; j < 8; ++j) f[j] = *(const GAS v4u*)(vp + (size_t)(t8 * 8 + j) * NINP);
        v4u og[8];
#pragma unroll
        for (int c = 0; c < 8; ++c) {
#pragma unroll
            for (int q = 0; q < 4; ++q) { const unsigned a = f[2 * q][c >> 1], b = f[2 * q + 1][c >> 1]; og[c][q] = (c & 1) ? ((a >> 16) | (b & 0xffff0000u)) : ((a & 0xffffu) | (b << 16)); } }
        store_groups<8, 128>(Wl, og, vt + (size_t)t8 * 128 * 8, (size_t)8 * 128 * 8, lane); }
}
__device__ __forceinline__ void mixer_phase1(Frame& FF, int l) {
    Frame F = FF; F.lane = xb_lane(); F.tid = F.wave * 64 + F.lane;
    const bf16* P = (const bf16*)(F.ws + WS_P);
    const ScanBufs<128> A = bufsA(F.ws); const ScanBufs<64> B = bufsB(F.ws);
    const float* LB = (const float*)(F.ws + WS_TAB + TAB_LB) + (size_t)l * 2048;
    const f32x2* RR = (const f32x2*)(F.ws + WS_TAB + TAB_RR); const f32x2* RC = (const f32x2*)(F.ws + WS_TAB + TAB_RC);
    const int gw = F.vcu * NWAVES + F.wave, NGW = F.G * NWAVES;
    LAS v4u* Wl = (LAS v4u*)(F.lds + F.wave * 8192);
    LAS f32x2* RCl = (LAS f32x2*)(F.lds + 65536);
    { const v4u v = *(const GAS v4u*)((const char*)RC + F.tid * 16); *(LAS v4u*)((LAS unsigned char*)RCl + F.tid * 16) = v; }
    LDS_WAIT(); __syncthreads();
    LAS v4u* Gl = (LAS v4u*)(F.lds + 73728 + F.wave * 2048);
    constexpr int U_F = NCH * 4, U_K = NCH * 4, U_V = NCH * 4, U_QA = 0, U_QB = 0, U_ALL = U_F + U_K + U_V + U_QA + U_QB;
    int u0 = -1;
    const bool deal = (F.G == 256); if (deal) { const int w = F.wave, cu = F.vcu;
        if (w < 4) u0 = w * 256 + cu;
        else if (w == 4 && cu < 128) u0 = 1024 + cu;
        else { const int li = cu < 128 ? cu * 3 + (w - 5) : 384 + (cu - 128) * 4 + (w - 4); if (U_F + U_K + li < U_ALL) u0 = U_F + U_K + li; }
    }
    const int ustep = deal ? 1 : NGW; const int uend = deal ? 1 : U_ALL;
    for (int ui = deal ? 0 : gw; ui < uend; ui += ustep) { const int u = deal ? u0 : ui; if (u < 0) continue;
        int r = u; const int lane = xb_lane();
        if (r < U_F) { const int half = r & 1, dir = (r >> 1) & 1, g = r >> 2; if (dir == 0) prep_hgrn_f<0>(A, P, LB, g, half, lane, Wl); else prep_hgrn_f<1>(A, P, LB, g, half, lane, Wl); continue; } r -= U_F;
        if (r < U_K) { const int half = r & 1, dir = (r >> 1) & 1, g = r >> 2; const float* w2g = FIN(9) + (size_t)l * 2 * 16 * 512; const float* b2g = FIN(10) + (size_t)l * 2 * 512;
            if (dir == 0) prep_gla_k<0>(B, P, w2g, b2g, RR, RCl, g, half, lane, Wl, Gl); else prep_gla_k<1>(B, P, w2g, b2g, RR, RCl, g, half, lane, Wl, Gl); continue; } r -= U_K;
        if (r < U_V) { const int half = r & 1, mix = (r >> 1) & 1, g = r >> 2; if (mix == 0) prep_vt(P, PC_AI, A.VT, g, half, lane, Wl); else prep_vt(P, PC_BV, B.VT, g, half, lane, Wl); continue; } r -= U_V;
        if (r < U_QA) { const int half = r & 1, g = r >> 1; const int ch = half * 512 + 8 * lane; const size_t row0 = (size_t)g * 64;
            for (int t8 = 0; t8 < 8; ++t8) { v4u f[8];
#pragma unroll
                for (int j = 0; j < 8; ++j) f[j] = *(const GAS v4u*)(P + (row0 + t8 * 8 + j) * NINP + PC_AQ + ch);
#pragma unroll
                for (int j = 0; j < 8; ++j) { float q[8];
#pragma unroll
                    for (int c = 0; c < 8; ++c) { const float x = bfe(f[j], c); q[c] = x * sigmoidf_(x) * 0.08838834764831845f; }
                    v4u o; o.x = pk2(q[0], q[1]); o.y = pk2(q[2], q[3]); o.z = pk2(q[4], q[5]); o.w = pk2(q[6], q[7]); *(GAS v4u*)(A.Q + (row0 + t8 * 8 + j) * 1024 + ch) = o; } }
            continue; } r -= U_QA;
        { const int g = r; const int ch = 8 * lane, d = ch & 63; const size_t row0 = (size_t)g * 64;
          const bool lat = g < 128; const int grow = g & 31; const int j0 = d & 15; const bool isrow = d < 32; const bool second = (d & 16) != 0;
          f32x2 csr[8];
#pragma unroll
          for (int c = 0; c < 8; ++c) csr[c] = RR[grow * 16 + j0 + c];
          for (int t8 = 0; t8 < 8; ++t8) { v4u f[8];
#pragma unroll
              for (int j = 0; j < 8; ++j) f[j] = *(const GAS v4u*)(P + (row0 + t8 * 8 + j) * NINP + PC_BQ + ch);
#pragma unroll
              for (int j = 0; j < 8; ++j) { float q[8]; const int t = t8 * 8 + j;
#pragma unroll
                  for (int c = 0; c < 8; ++c) { float x = bfe(f[j], c);
                      if (lat) { const f32x2 cs = isrow ? csr[c] : RC[t * 16 + j0 + c]; const float pt = __shfl_xor(x, 2); x = x * cs.x + (second ? pt : -pt) * cs.y; }
                      q[c] = x * 0.125f; }
                  v4u o; o.x = pk2(q[0], q[1]); o.y = pk2(q[2], q[3]); o.z = pk2(q[4], q[5]); o.w = pk2(q[6], q[7]); *(GAS v4u*)(B.Q + (row0 + t) * 512 + ch) = o; } } }
    }
}

__device__ __forceinline__ int scan_chunk(int b, int dir, int s) { return s < 4 ? 128 + 4 * b + (dir ? 3 - s : s) : 32 * b + (dir ? 31 - (s - 4) : (s - 4)); }
template <int DK> struct P2Frag { bf16x8 a[4]; bf16x8 bv[2][4]; f32x4 ae[4]; };
template <int DK> __device__ __forceinline__ void p2_load(P2Frag<DK>& f, const ScanBufs<DK>& S, int dir, int g, int h, int dkb, int dvb, int r, int hi) {
    const bf16* kt = S.KT + (((((size_t)dir * NCH + g) * 8 + h) * 8 + hi) * DK + dkb * 32 + r) * 8;
    const bf16* vt = S.VT + ((((size_t)g * 8 + h) * 8 + hi) * 128 + dvb * 64 + r) * 8;
    const float* ae = S.AE + (((size_t)dir * NCH + g) * 8 + h) * DK + dkb * 32 + 4 * hi;
#pragma unroll
    for (int kk = 0; kk < 4; ++kk) { f.a[kk] = *(const GAS bf16x8*)(kt + (size_t)kk * 2 * DK * 8); f.bv[0][kk] = *(const GAS bf16x8*)(vt + (size_t)kk * 2 * 128 * 8); f.bv[1][kk] = *(const GAS bf16x8*)(vt + (size_t)kk * 2 * 128 * 8 + 32 * 8); f.ae[kk] = *(const GAS f32x4*)(ae + 8 * kk); }
}
template <int DK> __device__ __forceinline__ void scan_state_unit(const ScanBufs<DK>& S, int unit, int lane, bool skip_ctx_store) {
    constexpr int NKB = DK / 32;
    const int dvb = unit & 1, dkb = (unit >> 1) % NKB, rest = (unit >> 1) / NKB; const int dir = rest & 1, h = (rest >> 1) & 7, b = rest >> 4;
    const int r = lane & 31, hi = lane >> 5;
    f32x16 acc[2]; acc[0] = f32x16{}; acc[1] = f32x16{};
    P2Frag<DK> cur, nxt; p2_load<DK>(cur, S, dir, scan_chunk(b, dir, 0), h, dkb, dvb, r, hi);
    for (int s = 0; s < 36; ++s) {
        const int g = scan_chunk(b, dir, s);
        if (s + 1 < 36) p2_load<DK>(nxt, S, dir, scan_chunk(b, dir, s + 1), h, dkb, dvb, r, hi);
        if (!(skip_ctx_store && s < 4)) {
            bf16* sp = S.SP + (((((size_t)dir * NCH + g) * 8 + h) * (DK / 8) + dkb * 4) * 128 + dvb * 64 + r) * 8 + 4 * hi;
#pragma unroll
            for (int j = 0; j < 2; ++j)
#pragma unroll
                for (int q = 0; q < 4; ++q) { v2u o; o.x = pk2(acc[j][4 * q], acc[j][4 * q + 1]); o.y = pk2(acc[j][4 * q + 2], acc[j][4 * q + 3]); *(GAS v2u*)(sp + ((size_t)q * 128 + j * 32) * 8) = o; }
        }
#pragma unroll
        for (int j = 0; j < 2; ++j)
#pragma unroll
            for (int q = 0; q < 4; ++q)
#pragma unroll
                for (int i = 0; i < 4; ++i) acc[j][4 * q + i] *= cur.ae[q][i];
#pragma unroll
        for (int kk = 0; kk < 4; ++kk) { acc[0] = __builtin_amdgcn_mfma_f32_32x32x16_bf16(cur.a[kk], cur.bv[0][kk], acc[0], 0, 0, 0); acc[1] = __builtin_amdgcn_mfma_f32_32x32x16_bf16(cur.a[kk], cur.bv[1][kk], acc[1], 0, 0, 0); }
        cur = nxt;
    }
}

constexpr int P3_ALP = 144, P3_WBYTES = 4 * 32 * P3_ALP, P3_STP = 272;
static_assert(32 * P3_STP <= 2 * 32 * P3_ALP, "output staging fits a t block's score rows");
template <int DK> __device__ __forceinline__ void scan_out_wave(const ScanBufs<DK>& S, int g, int h, const bf16* P, int gcol, const float* gain, bf16* Y, LAS unsigned char* W, int lane) {
    const int r = lane & 31, hi = lane >> 5;
    constexpr int NK = DK / 16, HD = 8 * DK;
    const size_t row0 = (size_t)g * 64;
    const unsigned oRow = (unsigned)((r * HD + 8 * hi) * 2);
    const unsigned oGrp = (unsigned)(((hi * 128 + r) * 8) * 2);
    const unsigned oHi4 = (unsigned)(8 * hi * 4), oHi2 = (unsigned)(8 * hi * 2);
#define UB(base) ([&]() -> const char* { const char* b_ = (const char*)(base); asm volatile("" : "+s"(b_)); return b_; }())
#define LDV(ub, off) (*(const GAS v4u*)((ub) + (off)))
#define LD16(base, off) ([&]() -> v4u { const char* b_ = (const char*)(base); asm volatile("" : "+s"(b_)); return *(const GAS v4u*)(b_ + (off)); }())
#define LD16F(base, off) ([&]() -> f32x4 { const char* b_ = (const char*)(base); asm volatile("" : "+s"(b_)); return *(const GAS f32x4*)(b_ + (off)); }())
#define P3_BLOCK(ti, si, DIAG, KA, QA) do { f32x16 acc_ = f32x16{}; _Pragma("unroll") for (int kk = 0; kk < NK; ++kk) acc_ = __builtin_amdgcn_mfma_f32_32x32x16_bf16(__builtin_bit_cast(bf16x8, KA[kk]), __builtin_bit_cast(bf16x8, QA[kk]), acc_, 0, 0, 0); \
            if (DIAG) { _Pragma("unroll") for (int e = 0; e < 16; ++e) { const int sl_ = (e & 3) + 8 * (e >> 2) + 4 * hi; const bool keep_ = dir == 0 ? (sl_ <= r) : (sl_ >= r); acc_[e] = keep_ ? acc_[e] : 0.f; } } \
            LAS unsigned char* ap_ = W + (((ti) * 2 + dir) * 32 + r) * P3_ALP + (32 * (si) + 4 * hi) * 2; \
            _Pragma("unroll") for (int q = 0; q < 4; ++q) { v2u o_; o_.x = pk2(acc_[4 * q], acc_[4 * q + 1]); o_.y = pk2(acc_[4 * q + 2], acc_[4 * q + 3]); *(LAS v2u*)(ap_ + 16 * q) = o_; } } while (0)
#define P3_ZERO(ti, si) do { LAS unsigned char* ap_ = W + (((ti) * 2 + dir) * 32 + r) * P3_ALP + (32 * (si) + 4 * hi) * 2; _Pragma("unroll") for (int q = 0; q < 4; ++q) *(LAS v2u*)(ap_ + 16 * q) = (v2u){0u, 0u}; } while (0)
#pragma unroll
    for (int dir = 0; dir < 2; ++dir) {
        const char* Qh = (const char*)(S.E + ((size_t)dir * MT + row0) * HD + h * DK); const char* Ku = (const char*)(S.K + ((size_t)dir * MT + row0) * HD + h * DK);
        v4u ka0[NK], ka1[NK], qa0[NK], qa1[NK];
        { const char* k0_ = UB(Ku); const char* k1_ = UB(Ku + (size_t)32 * HD * 2); const char* q0_ = UB(Qh); const char* q1_ = UB(Qh + (size_t)32 * HD * 2);
#pragma unroll
          for (int kk = 0; kk < NK; ++kk) { ka0[kk] = LDV(k0_ + 32 * kk, oRow); qa0[kk] = LDV(q0_ + 32 * kk, oRow); }
#pragma unroll
          for (int kk = 0; kk < NK; ++kk) { ka1[kk] = LDV(k1_ + 32 * kk, oRow); qa1[kk] = LDV(q1_ + 32 * kk, oRow); } }
        P3_BLOCK(0, 0, true, ka0, qa0);
        if (dir == 0) { P3_BLOCK(1, 0, false, ka0, qa1); P3_ZERO(0, 1); } else { P3_BLOCK(0, 1, false, ka1, qa0); P3_ZERO(1, 0); }
        P3_BLOCK(1, 1, true, ka1, qa1);
    }
#undef P3_BLOCK
#undef P3_ZERO
    LDS_WAIT();
    const char* VTu = (const char*)(S.VT + (((size_t)g * 8 + h) * 8) * 128 * 8);
    for (int tt = 0; tt < 2; ++tt) {
        f32x16 acc[4];
#pragma unroll
        for (int dvt = 0; dvt < 4; ++dvt) acc[dvt] = f32x16{};
        const LAS unsigned char* Wt = W + (size_t)tt * 2 * 32 * P3_ALP;
        const int tl = lane >> 3, seg = lane & 7; const size_t rowt = row0 + 32 * tt;
        const char* Gu = (const char*)(P + rowt * NINP + gcol + h * 128); const unsigned og = (unsigned)((tl * NINP + seg * 8) * 2);
        struct Raw8 { v4u x[8]; }; Raw8 A0, A1;
        constexpr int NST = 2 * (2 + NK);
#define P3_SLOAD(R, st) do { constexpr int dir_ = (st) / (2 + NK), j_ = (st) % (2 + NK); \
            if ((st) >= NST) { _Pragma("unroll") for (int j = 0; j < 8; ++j) { const char* gb_ = UB(Gu + ((size_t)(8 * (j >> 1)) * NINP + (j & 1) * 64) * 2); R.x[j] = LDV(gb_, og); } } \
            else if (j_ < 2) { _Pragma("unroll") for (int k2 = 0; k2 < 2; ++k2) { const char* vb_ = UB(VTu + (size_t)(2 * j_ + k2) * 2 * 128 * 16); _Pragma("unroll") for (int dvt = 0; dvt < 4; ++dvt) R.x[k2 * 4 + dvt] = LDV(vb_ + 32 * dvt * 16, oGrp); } } \
            else { constexpr int kk_ = j_ - 2; const char* sb_ = UB((const char*)(S.SP + ((((size_t)dir_ * NCH + g) * 8 + h) * (DK / 8)) * 128 * 8) + (size_t)kk_ * 2 * 128 * 16); \
                const char* qb_ = UB((const char*)(S.E + ((size_t)dir_ * MT + rowt) * HD + h * DK) + 32 * kk_); const char* bb_ = UB((const char*)(S.AE + (((size_t)dir_ * NCH + g) * 8 + h) * DK) + 64 * kk_); \
                _Pragma("unroll") for (int dvt = 0; dvt < 4; ++dvt) R.x[dvt] = LDV(sb_ + 32 * dvt * 16, oGrp); \
                R.x[4] = LDV(qb_, oRow); R.x[5] = R.x[4]; R.x[6] = LDV(bb_, oHi4); R.x[7] = LDV(bb_ + 16, oHi4); } \
            __builtin_amdgcn_sched_barrier(0); } while (0)
#define P3_SCOMP(R, st) do { constexpr int dir_ = (st) / (2 + NK), j_ = (st) % (2 + NK); \
            if (j_ < 2) { const LAS unsigned char* ap_ = Wt + (dir_ * 32 + r) * P3_ALP + (8 * hi) * 2; \
                _Pragma("unroll") for (int k2 = 0; k2 < 2; ++k2) { const bf16x8 af_ = *(const LAS bf16x8*)(ap_ + 32 * (2 * j_ + k2)); \
                    _Pragma("unroll") for (int dvt = 0; dvt < 4; ++dvt) acc[dvt] = __builtin_amdgcn_mfma_f32_32x32x16_bf16(__builtin_bit_cast(bf16x8, R.x[k2 * 4 + dvt]), af_, acc[dvt], 0, 0, 0); } } \
            else { const v4u qw_ = R.x[4]; const f32x4 b0_ = __builtin_bit_cast(f32x4, R.x[6]), b1_ = __builtin_bit_cast(f32x4, R.x[7]); v4u qa_;     \
                qa_.x = pk2(bflo(qw_.x) * b0_[0], bfhi(qw_.x) * b0_[1]); qa_.y = pk2(bflo(qw_.y) * b0_[2], bfhi(qw_.y) * b0_[3]); qa_.z = pk2(bflo(qw_.z) * b1_[0], bfhi(qw_.z) * b1_[1]); qa_.w = pk2(bflo(qw_.w) * b1_[2], bfhi(qw_.w) * b1_[3]); \
                _Pragma("unroll") for (int dvt = 0; dvt < 4; ++dvt) acc[dvt] = __builtin_amdgcn_mfma_f32_32x32x16_bf16(__builtin_bit_cast(bf16x8, R.x[dvt]), __builtin_bit_cast(bf16x8, qa_), acc[dvt], 0, 0, 0); } \
            __builtin_amdgcn_sched_barrier(0); } while (0)
#define P3_STEP2(st) do { P3_SLOAD(A1, (st) + 1); P3_SCOMP(A0, (st)); P3_SLOAD(A0, (st) + 2); P3_SCOMP(A1, (st) + 1); } while (0)
        P3_SLOAD(A0, 0);
        P3_STEP2(0); P3_STEP2(2); P3_STEP2(4); P3_STEP2(6); P3_STEP2(8); P3_STEP2(10);
        if (NK == 8) { P3_STEP2(12); P3_STEP2(14); P3_STEP2(16); P3_STEP2(18); }
#undef P3_SLOAD
#undef P3_SCOMP
#undef P3_STEP2
        float ss = 0.f;
#pragma unroll
        for (int dvt = 0; dvt < 4; ++dvt)
#pragma unroll
            for (int e = 0; e < 16; ++e) ss += acc[dvt][e] * acc[dvt][e];
        ss += __shfl_xor(ss, 32);
        const float rstd = 1.0f / sqrtf(ss * (1.f / 128.f) + RMS_EPS);
        LAS unsigned char* st = W + (size_t)tt * 2 * 32 * P3_ALP;
#pragma unroll
        for (int dvt = 0; dvt < 4; ++dvt)
#pragma unroll
            for (int q = 0; q < 4; ++q) { v2u o; o.x = pk2(acc[dvt][4 * q] * rstd, acc[dvt][4 * q + 1] * rstd); o.y = pk2(acc[dvt][4 * q + 2] * rstd, acc[dvt][4 * q + 3] * rstd); *(LAS v2u*)(st + r * P3_STP + (32 * dvt + 8 * q + 4 * hi) * 2) = o; }
        LDS_WAIT();
        { char* Yu = (char*)(Y + rowt * 1024 + h * 128); const unsigned oy = (unsigned)((tl * 1024 + seg * 8) * 2);
#pragma unroll
          for (int j = 0; j < 8; ++j) { const int rr = 8 * (j >> 1), hf = j & 1; const v4u ow = *(const LAS v4u*)(st + (tl + rr) * P3_STP + hf * 128 + seg * 16); const v4u gw = A0.x[j];
              const float* gn = gain + hf * 64 + seg * 8; const f32x4 n0 = *(const GAS f32x4*)gn, n1 = *(const GAS f32x4*)(gn + 4); v4u y;
#pragma unroll
              for (int c = 0; c < 4; ++c) { const float z0 = bflo(gw[c]), z1 = bfhi(gw[c]); const float na = c < 2 ? n0[2 * c] : n1[2 * c - 4], nb = c < 2 ? n0[2 * c + 1] : n1[2 * c - 3];
                  y[c] = pk2(bflo(ow[c]) * na * z0 * sigmoidf_(z0), bfhi(ow[c]) * nb * z1 * sigmoidf_(z1)); }
              *(GAS v4u*)(Yu + oy + ((size_t)rr * 1024 + hf * 64) * 2) = y; } }
        LDS_WAIT();
    }
#undef LD16
#undef LD16F
#undef UB
#undef LDV
}
__device__ __forceinline__ void mixer_phase3(Frame& FF, int l) {
    Frame F = FF; F.lane = xb_lane(); F.tid = F.wave * 64 + F.lane; const int lane = F.lane;
    const bf16* P = (const bf16*)(F.ws + WS_P); bf16* Y = (bf16*)(F.ws + WS_Y);
    const ScanBufs<128> A = bufsA(F.ws); const ScanBufs<64> B = bufsB(F.ws);
    const int nch = (l == DEPTH - 1) ? 128 : NCH;
    const int nu = nch * 8;
    LAS unsigned char* W = F.lds + F.wave * P3_WBYTES;
    const int NGW = F.G * NWAVES; const int gw0 = F.wave * F.G + F.vcu; const int gw1 = (F.G == 256) ? ((F.wave == 5) ? NGW + F.vcu : 2 * nu) : gw0 + NGW;
    for (int ui = 0; ui < 16; ++ui) { const int u = ui == 0 ? gw0 : (F.G == 256 ? (ui == 1 ? gw1 : 2 * nu) : gw0 + ui * NGW); if (u >= 2 * nu) break;
        const int ln = xb_lane();
        if (u < nu) scan_out_wave<128>(A, u >> 3, u & 7, P, PC_AG, FIN(8) + l * 128, Y, W, ln);
        else { const int v = u - nu; scan_out_wave<64>(B, v >> 3, v & 7, P, PC_BG, FIN(11) + l * 128, Y + (size_t)MT * 1024, W, ln); }
    }
}
namespace nat {
using s16x4 = __attribute__((ext_vector_type(4))) short; using u32x4 = __attribute__((ext_vector_type(4))) unsigned;
#define KSWZ(row, colB) ((row) * 256 + ((colB) ^ (((row) & 7) << 4)))
#define SBAR() __builtin_amdgcn_sched_barrier(0)
__device__ __forceinline__ int crow(int r, int hi) { return (r & 3) + 8 * (r >> 2) + 4 * hi; }
__device__ __forceinline__ unsigned cvtpk(float lo, float hi) {
  unsigned r; asm volatile("v_cvt_pk_bf16_f32 %0, %1, %2" : "=v"(r) : "v"(lo), "v"(hi)); return r;
}
__device__ __forceinline__ void finishSM(f32x16& p0, f32x16& p1, float alpha, float& l_reg, bf16x8& pa0, bf16x8& pa1, bf16x8& pa2, bf16x8& pa3) {
  for (int r = 0; r < 16; ++r) p1[r] = __builtin_amdgcn_exp2f(p1[r]);
  float ps = 0; for (int r = 0; r < 16; ++r) ps += p0[r]; for (int r = 0; r < 16; ++r) ps += p1[r];
  { auto rr = __builtin_amdgcn_permlane32_swap(__float_as_uint(ps), __float_as_uint(ps), false, false);
    ps = __uint_as_float(rr[0]) + __uint_as_float(rr[1]); }
  l_reg = l_reg * alpha + ps;
#define PK4(P, BASE, OUT) do { unsigned a0 = cvtpk(P[BASE + 0], P[BASE + 1]), a1 = cvtpk(P[BASE + 2], P[BASE + 3]);   \
    unsigned b0 = cvtpk(P[BASE + 4], P[BASE + 5]), b1 = cvtpk(P[BASE + 6], P[BASE + 7]);                              \
    auto r0 = __builtin_amdgcn_permlane32_swap(a0, b0, false, false); auto r1 = __builtin_amdgcn_permlane32_swap(a1, b1, false, false); \
    u32x4 w = {r0[0], r1[0], r0[1], r1[1]}; OUT = *reinterpret_cast<bf16x8*>(&w); } while (0)
  PK4(p0, 0, pa0); PK4(p0, 8, pa1); PK4(p1, 0, pa2); PK4(p1, 8, pa3);
#undef PK4
}
__device__ __forceinline__ void qkt(f32x16& p0, f32x16& p1, const bf16* Ks, const bf16x8* qr, int r32, int hi) {
  p0 = f32x16{}; p1 = f32x16{};
  for (int d0 = 0; d0 < 8; ++d0) { int cb = (d0 * 16 + hi * 8) * 2;
    bf16x8 b0 = *reinterpret_cast<const bf16x8*>((const char*)Ks + KSWZ(r32, cb));
    bf16x8 b1 = *reinterpret_cast<const bf16x8*>((const char*)Ks + KSWZ(32 + r32, cb));
    p0 = __builtin_amdgcn_mfma_f32_32x32x16_bf16(b0, qr[d0], p0, 0, 0, 0);
    p1 = __builtin_amdgcn_mfma_f32_32x32x16_bf16(b1, qr[d0], p1, 0, 0, 0); }
}
__device__ __forceinline__ int v_st(int k, int c) { const int kk = (k & ~0xC) | ((k & 4) << 1) | ((k & 8) >> 1); return ((kk >> 3) * 4 + (c >> 5)) * 512 + ((kk & 7) * 32 + (c & 31)) * 2; }
__device__ __forceinline__ int v_rd_base(int lane) { return ((lane & 3) << 3) | (((lane >> 2) & 3) << 6) | (((lane >> 4) & 1) << 5) | (((lane >> 5) & 1) << 8); }
constexpr int v_rd_off(int d0, int ks, int half) { return d0 * 512 + ks * 4096 + half * 2048; }
template <int OFF> __device__ __forceinline__ s16x4 tr_read(int vb) {
  s16x4 r; asm volatile("ds_read_b64_tr_b16 %0, %1 offset:%2" : "=&v"(r) : "v"(vb), "i"(OFF) : "memory"); return r;
}
template <int D0> __device__ __forceinline__ void pv_one(f32x16& od, int vb, bf16x8 pa0, bf16x8 pa1, bf16x8 pa2, bf16x8 pa3) {
  const s16x4 l0 = tr_read<v_rd_off(D0, 0, 0)>(vb), h0 = tr_read<v_rd_off(D0, 0, 1)>(vb), l1 = tr_read<v_rd_off(D0, 1, 0)>(vb), h1 = tr_read<v_rd_off(D0, 1, 1)>(vb);
  const s16x4 l2 = tr_read<v_rd_off(D0, 2, 0)>(vb), h2 = tr_read<v_rd_off(D0, 2, 1)>(vb), l3 = tr_read<v_rd_off(D0, 3, 0)>(vb), h3 = tr_read<v_rd_off(D0, 3, 1)>(vb);
  asm volatile("s_waitcnt lgkmcnt(0)" ::: "memory"); SBAR();
#define PK(L, H) (bf16x8){L[0], L[1], L[2], L[3], H[0], H[1], H[2], H[3]}
  od = __builtin_amdgcn_mfma_f32_32x32x16_bf16(pa0, PK(l0, h0), od, 0, 0, 0);
  od = __builtin_amdgcn_mfma_f32_32x32x16_bf16(pa1, PK(l1, h1), od, 0, 0, 0);
  od = __builtin_amdgcn_mfma_f32_32x32x16_bf16(pa2, PK(l2, h2), od, 0, 0, 0);
  od = __builtin_amdgcn_mfma_f32_32x32x16_bf16(pa3, PK(l3, h3), od, 0, 0, 0);
#undef PK
}
__device__ __forceinline__ void pv_d0(f32x16* o, int vb, bf16x8 pa0, bf16x8 pa1, bf16x8 pa2, bf16x8 pa3) {
  pv_one<0>(o[0], vb, pa0, pa1, pa2, pa3); pv_one<1>(o[1], vb, pa0, pa1, pa2, pa3); pv_one<2>(o[2], vb, pa0, pa1, pa2, pa3); pv_one<3>(o[3], vb, pa0, pa1, pa2, pa3);
}

constexpr int SHM_V = 64 * 128 * 2, SHM_K = 64 * 128 * 2, SHM_ATTN = 2 * SHM_V + 2 * SHM_K + 8 * 64 * 4;
constexpr int NAT_TAB = SHM_ATTN, NAT_TABW = 128, NAT_MISC = NAT_TAB + 15 * NAT_TABW * 4, NAT_LDS = NAT_MISC + 16;
constexpr float C2 = 0.088388347648318440f * 1.4426950408889634f;
constexpr float THR2 = 8.f * 1.4426950408889634f;
constexpr float NEGB = -1e30f;
template <bool WIN> __device__ __forceinline__ void partialSM(f32x16& p0, f32x16& p1, float& m_reg, float& mn, float& alpha, bool rowok, const float* tb, int t0) {
  if (WIN) {
    if (rowok) {
#pragma unroll
      for (int r = 0; r < 16; ++r) { const int cr = (r & 3) + 8 * (r >> 2);
        const float b0 = tb[cr], b1 = tb[cr + 32];
        p0[r] = ((unsigned)(cr + t0) < 16u) ? fmaf(p0[r], C2, b0) : NEGB;
        p1[r] = ((unsigned)(cr + 32 + t0) < 16u) ? fmaf(p1[r], C2, b1) : NEGB; }
    } else {
#pragma unroll
      for (int r = 0; r < 16; ++r) { p0[r] = NEGB; p1[r] = NEGB; }
    }
  } else {
#pragma unroll
    for (int r = 0; r < 16; ++r) { p0[r] *= C2; p1[r] *= C2; }
  }
  float pmax = p0[0];
#pragma unroll
  for (int r = 1; r < 16; ++r) pmax = fmaxf(pmax, p0[r]);
#pragma unroll
  for (int r = 0; r < 16; ++r) pmax = fmaxf(pmax, p1[r]);
  { auto rr = __builtin_amdgcn_permlane32_swap(__float_as_uint(pmax), __float_as_uint(pmax), false, false);
    pmax = fmaxf(__uint_as_float(rr[0]), __uint_as_float(rr[1])); }
  if (__builtin_expect(__all(pmax - m_reg <= THR2), 1)) { mn = m_reg; alpha = 1.f; }
  else { mn = fmaxf(m_reg, pmax); alpha = __builtin_amdgcn_exp2f(m_reg - mn); m_reg = mn; }
#pragma unroll
  for (int r = 0; r < 16; ++r) { p0[r] -= mn; p1[r] -= mn; }
#pragma unroll
  for (int r = 0; r < 16; ++r) p0[r] = __builtin_amdgcn_exp2f(p0[r]);
}
__device__ __forceinline__ void natten_unit(const bf16* __restrict__ P, bf16* __restrict__ Y, const float* __restrict__ rpbh, long qrow0, long crow0, long wrow0, int h, int NT, bool win, int r0, int ws0, char* lds, int tid) {
  const int wid = __builtin_amdgcn_readfirstlane(tid >> 6), lane = tid & 63, r32 = lane & 31, hi = lane >> 5;
  bf16* V_lds = (bf16*)lds; bf16* K_lds = (bf16*)(lds + 2 * SHM_V);
  float* ws = (float*)(lds + 2 * SHM_V + 2 * SHM_K) + wid * 64; float* li_l = ws; float* al_l = ws + 32;
  float* tab = (float*)(lds + NAT_TAB);
  __syncthreads();
  if (win) { for (int i = tid; i < 15 * NAT_TABW; i += 512) { const int dr = i >> 7, dc = (i & 127) - 48; tab[i] = (dc >= 0 && dc <= 30) ? rpbh[dr * 31 + dc] * 1.4426950408889634f : 0.f; } }
  float m_reg = -1e30f, l_reg = 0; f32x16 o[4] = {}; bf16x8 qr[8];
  { const char* Qb = (const char*)(P + (size_t)(qrow0 + wid * 32) * NINP + PC_CQ + h * 128); const unsigned qoff = (unsigned)((r32 * NINP + hi * 8) * 2);
#pragma unroll
    for (int d0 = 0; d0 < 8; ++d0) qr[d0] = *(const GAS bf16x8*)(Qb + qoff + d0 * 32); }
  const int sr = tid >> 4, sc = (tid & 15) * 8, vst0 = v_st(sr, sc), vst1 = v_st(32 + sr, sc);
  const int vb0 = (int)(uintptr_t)V_lds + v_rd_base(lane);
  const unsigned kvoff = (unsigned)((sr * NINP + h * 128 + sc) * 2);
  const char* Pk = (const char*)(P + PC_CK); const char* Pv = (const char*)(P + PC_CV);
  const int qgr = r0 + (wid >> 1), qc = 32 * (wid & 1) + r32;
  const int rs = min(max(qgr - 4, 0), 24), cs = min(max(qc - 8, 0), 48);
  const int t0 = 4 * hi - cs; const float* tbl = tab + 63 - qc + 4 * hi;
  bf16x8 vs0, vs1, ks0, ks1;
#define TROW(t) ((t) < 4 ? crow0 + 64 * (t) : wrow0 + 64 * ((t) - 4))
#define SLOAD(t) do { const size_t rb_ = (size_t)(TROW(t)) * (NINP * 2); const char* kb_ = Pk + rb_; const char* vb_ = Pv + rb_; \
    vs0 = *(const GAS bf16x8*)(vb_ + kvoff); vs1 = *(const GAS bf16x8*)(vb_ + (size_t)32 * NINP * 2 + kvoff); \
    ks0 = *(const GAS bf16x8*)(kb_ + kvoff); ks1 = *(const GAS bf16x8*)(kb_ + (size_t)32 * NINP * 2 + kvoff); } while (0)
#define SWRITE(b) do { *(bf16x8*)((char*)V_lds + (b) * SHM_V + vst0) = vs0; *(bf16x8*)((char*)V_lds + (b) * SHM_V + vst1) = vs1; const int kc = sc * 2; \
    *(bf16x8*)((char*)K_lds + (b) * SHM_K + KSWZ(sr, kc)) = ks0; *(bf16x8*)((char*)K_lds + (b) * SHM_K + KSWZ(32 + sr, kc)) = ks1; } while (0)
#define RESC(a) do { if (__any((a) < 1.f)) { if (hi == 0) al_l[r32] = (a); asm volatile("s_waitcnt lgkmcnt(0)" ::: "memory"); \
    for (int d = 0; d < 4; ++d) for (int r = 0; r < 16; ++r) o[d][r] *= al_l[crow(r, hi)]; } } while (0)
  f32x16 p0, p1; float mn, al; bf16x8 pa0, pa1, pa2, pa3;
  SLOAD(0); asm volatile("s_waitcnt vmcnt(0)" ::: "memory"); SWRITE(0); SLOAD(1);
  for (int t = 0; t < NT; ++t) {
    const int buf = t & 1;
    asm volatile("s_waitcnt lgkmcnt(0)" ::: "memory"); __syncthreads();
    if (t + 1 < NT) { asm volatile("s_waitcnt vmcnt(0)" ::: "memory"); SWRITE(buf ^ 1); if (t + 2 < NT) SLOAD(t + 2); }
    const int kr_ = ws0 + t - 4; const bool wtile = win && t >= 4; const bool ok_ = (unsigned)(kr_ - rs) < 8u;
    if (!wtile || ok_) {
        SBAR(); qkt(p0, p1, (bf16*)((char*)K_lds + buf * SHM_K), qr, r32, hi);
        if (!wtile) partialSM<false>(p0, p1, m_reg, mn, al, true, tbl, t0);
        else { const int dr_ = min(max(kr_ - qgr + 7, 0), 14); partialSM<true>(p0, p1, m_reg, mn, al, true, tbl + dr_ * NAT_TABW, t0); }
        finishSM(p0, p1, al, l_reg, pa0, pa1, pa2, pa3); SBAR();
        RESC(al);
        pv_d0(o, vb0 + buf * (int)SHM_V, pa0, pa1, pa2, pa3);
    }
  }
  if (hi == 0) li_l[r32] = l_reg; asm volatile("s_waitcnt lgkmcnt(0)" ::: "memory");
  float rli[16];
#pragma unroll
  for (int r = 0; r < 16; ++r) rli[r] = __builtin_amdgcn_rcpf(li_l[crow(r, hi)]);
  char* Ob = (char*)(Y + (size_t)(qrow0 + wid * 32) * 1024 + h * 128); const unsigned ooff = (unsigned)((4 * hi * 1024 + r32) * 2);
#pragma unroll
  for (int r = 0; r < 16; ++r) { const int orow = (r & 3) + 8 * (r >> 2);
#pragma unroll
    for (int d0 = 0; d0 < 4; ++d0) *(GAS bf16*)(Ob + ooff + (orow * 1024 + d0 * 32) * 2) = (bf16)f2bf(o[d0][r] * rli[r]); }
  asm volatile("s_waitcnt vmcnt(0)" ::: "memory");
#undef TROW
#undef SLOAD
#undef SWRITE
#undef RESC
}
}

__device__ __forceinline__ void mixer_phase2(Frame& FF, int l, int rep) {
    Frame F = FF; F.lane = xb_lane(); F.tid = F.wave * 64 + F.lane; const int lane = F.lane, tid = F.tid;
    { const ScanBufs<128> A = bufsA(F.ws); const ScanBufs<64> B = bufsB(F.ws);
      const int gw = F.vcu * NWAVES + F.wave; const bool lastl = (l == DEPTH - 1);
      if (gw < 512) scan_state_unit<128>(A, gw, lane, lastl);
      else if (gw < 768) scan_state_unit<64>(B, gw - 512, lane, lastl); }
    const bf16* P = (const bf16*)(F.ws + WS_P); bf16* Y = (bf16*)(F.ws + WS_Y) + (size_t)2 * MT * 1024;
    const float* rpb = FIN(12) + (size_t)l * 8 * 15 * 31;
    const int total = (l == DEPTH - 1) ? 256 : 288;
    volatile LAS unsigned* slot = (volatile LAS unsigned*)(F.lds + nat::NAT_MISC);
    gu32* qhead = F.ctl + CW_QUEUE + 64 * (l + 4 * rep);
    for (;;) {
        __syncthreads();
        if (tid == 0) *slot = __hip_atomic_fetch_add(qhead, 1u, RLX_AGENT);
        __syncthreads();
        const int idx = (int)__builtin_amdgcn_readfirstlane(*slot);
        if (idx >= total) break;
        if (idx < 256) { int bh, r0;
            if (idx < 192) { bh = idx / 6; r0 = 4 + 4 * (idx % 6); } else { const int i = idx - 192; bh = i >> 1; r0 = (i & 1) ? 28 : 0; }
            const int b = bh >> 3, h = bh & 7; const int ws0 = (r0 == 0) ? 0 : (r0 == 28 ? 24 : min(r0 - 4, 20)); const int nwin = (r0 == 0 || r0 == 28) ? 8 : 12;
            nat::natten_unit(P, Y, rpb + h * 15 * 31, (long)b * 2048 + 64 * r0, (long)ML + b * 256, (long)b * 2048 + 64 * ws0, h, 4 + nwin, true, r0, ws0, (char*)F.lds, tid);
        } else { const int bh = idx - 256, b = bh >> 3, h = bh & 7;
            nat::natten_unit(P, Y, rpb, (long)ML + b * 256, (long)ML + b * 256, 0, h, 4, false, 0, 0, (char*)F.lds, tid); }
    }
}


#ifndef WGM_IN
#define WGM_IN 4
#endif
#ifndef WGM_BR
#define WGM_BR 4
#endif
#ifndef WGM_OUT
#define WGM_OUT 4
#endif
#ifndef WGM_M1
#define WGM_M1 4
#endif
#ifndef WGM_M2
#define WGM_M2 2
#endif
constexpr int NPH_PRE = 3, NPH_LAYER = 10, NPH = NPH_PRE + DEPTH * NPH_LAYER;
struct Args { const float* in[21]; float* out; unsigned char* ws; int ph_lo, ph_hi, use_bar, pad; };
__global__ void __launch_bounds__(NWAVES * 64, 2) fwd_kernel(Args args) {
    extern __shared__ __attribute__((aligned(16))) unsigned char lds[];
    Frame F;
    F.lds = (LAS unsigned char*)lds;
    F.MISC = (volatile LAS unsigned*)(F.lds + MISC_OFF);
    F.wave = __builtin_amdgcn_readfirstlane((int)threadIdx.x >> 6); F.lane = xb_lane(); F.tid = F.wave * 64 + F.lane;
    F.G = gridDim.x; { const int bx = blockIdx.x; F.vcu = (F.G % 8 == 0) ? (bx % 8) * (F.G / 8) + bx / 8 : bx; }
    F.ws = args.ws; F.ctl = (gu32*)(args.ws + WS_CTL); F.out = args.out;
    F.kin = (kin_t)__builtin_amdgcn_kernarg_segment_ptr();
    for (int u = F.tid; u < (LDS_BYTES - LDSCTL_OFF) / 4; u += NWAVES * 64) ((LAS unsigned*)(F.lds + LDSCTL_OFF))[u] = 0u;
    __syncthreads();
    const bool use_bar = args.use_bar != 0;
    XcdBarrier bar; bar.bar = (unsigned*)(F.ctl + CW_BAR); bar.x = 0; bar.st = nullptr; bar.wave = F.wave;
    if (use_bar) bar = xcd_barrier_post((unsigned*)(F.ctl + CW_BAR), F.MISC + 8);
    const int lo = args.ph_lo, hi = args.ph_hi;
#define IN(k) (lo <= (k) && (k) < hi)
#ifndef REP_KIND
#define REP_KIND -1
#endif
#define RUN(kind, ...) do { _Pragma("nounroll") for (int rep_ = 0; rep_ < ((REP_KIND == (kind)) ? 2 : 1); ++rep_) { __VA_ARGS__; } } while (0)
#define SEAM(k) do { if (IN((k) + 1)) { if (use_bar) { xcd_barrier(bar); if (REP_KIND == 9) xcd_barrier(bar); } else if (F.tid == 0) __hip_atomic_store(F.ctl + CW_TMO, 0xBADBA0u, RLX_AGENT); } } while (0)
    unsigned char* ws = args.ws;
    if (IN(0)) { RUN(0, p0_prologue(F)); SEAM(0); }
    if (IN(1)) { p0b_modreduce(F); SEAM(1); }
    if (IN(2)) { p0c_modulate(F); SEAM(2); }
    for (int l = 0; l < DEPTH; ++l) {
        const int pb = NPH_PRE + l * NPH_LAYER;
        const bool lastl = (l == DEPTH - 1);
        const int Mg = lastl ? ML : MT;
        if (IN(pb + 0)) {
            RUN(1, { pg8::Gemm g{(const bf16*)(ws + WS_H), (const bf16*)(ws + WS_WIN) + (size_t)l * NINP * 2048, MT, NINP, 2048, 0, 0, 2048, 2048}; pg8::StaticOrder S; S.init(MT, NINP, F.G, (int)blockIdx.x, WGM_IN);
            pg8::EpiBf16<0> E{(bf16*)(ws + WS_P), NINP, 0};
            pg8::gemm_phase<pg8::EpiBf16<0>, pg8::StaticOrder, true, true>(F.lds + RING_OFF, g, S, E, F.wave); });
            if (F.G == 256) convert_pocket(F, l + 1, CV_P0, CV_P1, (MT / 256) * (NINP / 256) - 9 * 256);
            SEAM(pb + 0);
        }
        if (IN(pb + 1)) { RUN(2, mixer_phase1(F, l)); SEAM(pb + 1); }
        if (IN(pb + 2)) { mixer_phase2(F, l, 0); if (REP_KIND == 3) mixer_phase2(F, l, 1); SEAM(pb + 2); }
        if (IN(pb + 3)) { RUN(4, mixer_phase3(F, l)); SEAM(pb + 3); }
        if (IN(pb + 4)) {
            RUN(5, { pg8::Gemm g{(const bf16*)(ws + WS_Y), (const bf16*)(ws + WS_WBR) + (size_t)l * 3 * 2048 * 1024, ML, 2048, 1024, (size_t)MT * 1024 * 2, (size_t)2048 * 1024 * 2, 1024, 1024}; pg8::SlabOrder<3> S; S.init(ML, 2048, F.G, (int)blockIdx.x, WGM_BR);
            pg8::EpiGate<true> E{(bf16*)(ws + WS_U), 2048, (const bf16*)(ws + WS_P) + PC_GT, NINP, 0};
            pg8::gemm_phase<pg8::EpiGate<true>, pg8::SlabOrder<3>, true, true>(F.lds + RING_OFF, g, S, E, F.wave);
            if (!lastl) { pg8::Gemm g2 = g; g2.M = MC; pg8::SplitKOrder<1, 3> S2; S2.init(MC, 2048, F.G, (int)blockIdx.x, ML / 256, 1024);
                pg8::EpiGate<false> E2{(bf16*)(ws + WS_UC) - (size_t)ML * 2048, 2048, (const bf16*)(ws + WS_P) + PC_GT, NINP, (size_t)MC * 2048};
                pg8::gemm_phase<pg8::EpiGate<false>, pg8::SplitKOrder<1, 3>, true, true>(F.lds + RING_OFF, g2, S2, E2, F.wave); } });
            if (F.G == 256 && !lastl) convert_pocket(F, l + 1, CV_P1, CV_P2, 96);
            SEAM(pb + 4);
        }
        if (IN(pb + 5)) {
            RUN(6, { pg8::Gemm g{(const bf16*)(ws + WS_U), (const bf16*)(ws + WS_WOUT) + (size_t)l * 2048 * 2048, ML, 2048, 2048, 0, 0, 2048, 2048}; pg8::StaticOrder S; S.init(ML, 2048, F.G, (int)blockIdx.x, WGM_OUT);
            pg8::EpiBf16<0> E{(bf16*)(ws + WS_MIX), 2048, 0};
            pg8::gemm_phase<pg8::EpiBf16<0>, pg8::StaticOrder, true, true>(F.lds + RING_OFF, g, S, E, F.wave);
            if (!lastl) { pg8::Gemm g2{(const bf16*)(ws + WS_UC) - (size_t)ML * 2048, (const bf16*)(ws + WS_WOUT) + (size_t)l * 2048 * 2048, MC, 2048, 1024, (size_t)MC * 2048 * 2, 0, 2048, 2048}; pg8::SplitKOrder<2, 3> S2; S2.init(MC, 2048, F.G, (int)blockIdx.x, ML / 256, 1024);
                pg8::EpiBf16<0> E2{(bf16*)(ws + WS_PART) - (size_t)ML * 2048, 2048, (size_t)MC * 2048};
                pg8::gemm_phase<pg8::EpiBf16<0>, pg8::SplitKOrder<2, 3>, true, true>(F.lds + RING_OFF, g2, S2, E2, F.wave); } });
            SEAM(pb + 5);
        }
        if (IN(pb + 6)) { if (REP_KIND == 10) ln_phase(F, l, 2, FIN(15) + l * DM, FIN(16) + l * DM, l, 3, l == 0, false, Mg, true, 6); ln_phase(F, l, 2, FIN(15) + l * DM, FIN(16) + l * DM, l, 3, l == 0, false, Mg, false, 6); SEAM(pb + 6); }
        if (IN(pb + 7)) {
            RUN(7, { pg8::Gemm g{(const bf16*)(ws + WS_H), (const bf16*)(ws + WS_WM1) + (size_t)l * 8192 * 2048, Mg, DFF, 2048, 0, 0, 2048, 2048}; pg8::StaticOrder S; S.init(Mg, DFF, F.G, (int)blockIdx.x, WGM_M1);
            pg8::EpiBf16<2> E{(bf16*)(ws + WS_HM), DFF, 0};
            pg8::gemm_phase<pg8::EpiBf16<2>, pg8::StaticOrder, true, true>(F.lds + RING_OFF, g, S, E, F.wave); });
            if (F.G == 256 && !lastl) convert_pocket(F, l + 1, CV_P2, CV_IL, 128);
            SEAM(pb + 7);
        }
        if (IN(pb + 8)) {
            RUN(8, { pg8::Gemm g{(const bf16*)(ws + WS_HM), (const bf16*)(ws + WS_WM2) + (size_t)l * 2048 * 8192, ML, 2048, DFF, 0, 0, DFF, DFF}; pg8::StaticOrder S; S.init(ML, 2048, F.G, (int)blockIdx.x, WGM_M2);
            pg8::EpiBf16<0> E{(bf16*)(ws + WS_MIX), 2048, 0};
            pg8::gemm_phase<pg8::EpiBf16<0>, pg8::StaticOrder, true, true>(F.lds + RING_OFF, g, S, E, F.wave);
            if (!lastl) { pg8::Gemm g2{(const bf16*)(ws + WS_HM), (const bf16*)(ws + WS_WM2) + (size_t)l * 2048 * 8192, MC, 2048, 1024, 0, 0, DFF, DFF}; pg8::SplitKOrder<8> S2; S2.init(MC, 2048, F.G, (int)blockIdx.x, ML / 256, 1024);
                pg8::EpiBf16<0> E2{(bf16*)(ws + WS_PART) - (size_t)ML * 2048, 2048, (size_t)MC * 2048};
                pg8::gemm_phase<pg8::EpiBf16<0>, pg8::SplitKOrder<8>, true, true>(F.lds + RING_OFF, g2, S2, E2, F.wave); } });
            SEAM(pb + 8);
        }
        if (IN(pb + 9)) { if (REP_KIND == 10) ln_phase(F, l, 5, FIN(17) + l * DM, FIN(18) + l * DM, l + 1, lastl ? -1 : 0, false, lastl, Mg, true, 8); ln_phase(F, l, 5, FIN(17) + l * DM, FIN(18) + l * DM, l + 1, lastl ? -1 : 0, false, lastl, Mg, false, 8); SEAM(pb + 9); }
    }
#undef IN
#undef SEAM
}

#ifndef MK_LAUNCHES
#define MK_LAUNCHES 1
#endif
extern "C" void kernel_launch(void* const* d_in, const int* in_sizes, int n_in, void* d_out, int out_size, void* d_ws, size_t ws_size, hipStream_t stream) {
    static int grid = 0;
    if (grid == 0) {
        if (n_in != 21 || out_size != ML * DM || ws_size < WS_END) { fprintf(stderr, "kernel_launch: unexpected shapes: n_in %d out %d ws %zu (need %zu)\n", n_in, out_size, ws_size, (size_t)WS_END); grid = -1; return; }
        int dev = 0, cus = 0, per_cu = 0;
        if (hipGetDevice(&dev) != hipSuccess || hipDeviceGetAttribute(&cus, hipDeviceAttributeMultiprocessorCount, dev) != hipSuccess) { grid = -1; return; }
        if (hipFuncSetAttribute((const void*)fwd_kernel, hipFuncAttributeMaxDynamicSharedMemorySize, LDS_BYTES) != hipSuccess) { fprintf(stderr, "kernel_launch: hipFuncSetAttribute failed\n"); grid = -1; return; }
        if (hipOccupancyMaxActiveBlocksPerMultiprocessor(&per_cu, (const void*)fwd_kernel, NWAVES * 64, LDS_BYTES) != hipSuccess || per_cu < 1) { fprintf(stderr, "kernel_launch: occupancy query reports %d\n", per_cu); }
        (void)hipGetLastError();
        grid = cus;
    }
    if (grid < 0) return;
    if (hipMemsetAsync((char*)d_ws + WS_CTL, 0, CTL_ZERO_BYTES, stream) != hipSuccess) return;
    Args a{};
    for (int i = 0; i < 21; ++i) a.in[i] = (const float*)d_in[i];
    a.out = (float*)d_out; a.ws = (unsigned char*)d_ws; a.pad = 0;
#if MK_LAUNCHES == 1
    a.ph_lo = 0; a.ph_hi = NPH; a.use_bar = 1;
    hipLaunchKernelGGL(fwd_kernel, dim3(grid), dim3(NWAVES * 64), LDS_BYTES, stream, a);
#else
    for (int p = 0; p < NPH; ++p) { a.ph_lo = p; a.ph_hi = p + 1; a.use_bar = 0; hipLaunchKernelGGL(fwd_kernel, dim3(grid), dim3(NWAVES * 64), LDS_BYTES, stream, a); }
#endif
    const hipError_t le = hipPeekAtLastError();
    if (le != hipSuccess) fprintf(stderr, "kernel_launch: launch failed: %s\n", hipGetErrorName(le));
}
```

```cpp
#define MK_LAUNCHES 1
#include <hip/hip_runtime.h>
#include <hip/hip_bf16.h>
#include <cstdio>
#include <cstdint>

namespace pg8 {
#define PG8_LAS __attribute__((address_space(3)))
typedef unsigned short bf16_t;
typedef short bf16x8 __attribute__((ext_vector_type(8)));
typedef float f32x4 __attribute__((ext_vector_type(4)));
typedef unsigned u32x4 __attribute__((ext_vector_type(4)));
constexpr int BM = 256, BK = 64, HALF = 128, HTB = HALF * BK * 2  , STAGE_BYTES = 8 * HTB, NXCD = 8, WGM = 4;

__host__ __device__ __forceinline__ int lds_byte(int r, int c) { const int st = (r >> 4) * 2 + (c >> 5), rr = r & 15, cc = c & 31, ob = rr * 64 + cc * 2; return st * 1024 + (ob ^ (((ob >> 9) & 1) << 5)); }
__host__ __device__ __forceinline__ void stage_rc(int b, int& R, int& C) { const int st = b / 1024, sb = b % 1024, swz = sb ^ (((sb >> 9) & 1) << 5); R = (st >> 1) * 16 + swz / 64; C = (st & 1) * 32 + (swz % 64) / 2; }
__host__ __device__ __forceinline__ int perm32(int rho) { const int n = rho >> 4, i = rho & 15; return 8 * (i >> 2) + 4 * n + (i & 3); }

__device__ __forceinline__ int xb_lane_pg8() { int z = 0; asm volatile("" : "+v"(z)); return (int)__builtin_amdgcn_mbcnt_hi(~0u, __builtin_amdgcn_mbcnt_lo(~0u, (unsigned)z)); }
struct Unit { int pm, pn, z, k0, zo; };
struct Gemm { const bf16_t* A; const bf16_t* Bt; int M, N, K; size_t zsA, zsB; int lda, ldb; };

struct StaticOrder {
    int nM, nN, nwg, G, c, wgm;
    __host__ __device__ void init(int M, int N, int G_, int c_, int wgm_ = WGM) { nM = M / BM; nN = N / BM; nwg = nM * nN; G = G_; c = c_; wgm = wgm_; }
    __host__ __device__ bool tile(long L, Unit& u) const {
        if (L >= nwg) return false;
        int wgid = (int)L; { const int q = nwg / NXCD, r = nwg % NXCD, xcd = wgid % NXCD, off = wgid / NXCD; wgid = (xcd < r ? xcd * (q + 1) : r * (q + 1) + (xcd - r) * q) + off; }
        const int nig = wgm * nN, gid = wgid / nig, fm = gid * wgm, gsz = (nM - fm) < wgm ? (nM - fm) : wgm;
        u.pm = fm + ((wgid % nig) % gsz); u.pn = (wgid % nig) / gsz; u.z = 0; u.k0 = 0; u.zo = 0; return true;
    }
    __host__ __device__ bool next(int i, Unit& u) const { return tile((long)i * G + c, u); }
    __device__ __forceinline__ void a_ready(const Unit&) const {}
    __device__ __forceinline__ void done(const Unit&) const {}
};
template <int NZ> struct SlabOrder : StaticOrder {
    __host__ __device__ bool next(int i, Unit& u) const { if (!tile((long)(i / NZ) * G + c, u)) return false; u.z = i % NZ; return true; }
};

template <int NS, int NZ = 1> struct SplitKOrder {
    int nM, nN, nwg, G, c, pm0, Kc;
    __host__ __device__ void init(int M, int N, int G_, int c_, int pm0_, int Kc_) { nM = M / BM; nN = N / BM; nwg = nM * nN * NS * NZ; G = G_; c = c_; pm0 = pm0_; Kc = Kc_; }
    __host__ __device__ bool next(int i, Unit& u) const { const long L = (long)i * G + c; if (L >= nwg) return false; const int t = (int)L / (NS * NZ), rem = (int)L % (NS * NZ), z = rem / NS, ks = rem % NS;
        u.pm = pm0 + t / nN; u.pn = t % nN; u.z = z; u.k0 = ks * Kc; u.zo = z * NS + ks; return true; }
    __device__ __forceinline__ void a_ready(const Unit&) const {}
    __device__ __forceinline__ void done(const Unit&) const {}
};
typedef float f32x2_t __attribute__((ext_vector_type(2))); typedef __bf16 bf16x2_t __attribute__((ext_vector_type(2)));
__device__ __forceinline__ unsigned cvt_pk_bf16(float lo, float hi) { const f32x2_t v = {lo, hi}; const bf16x2_t b = __builtin_convertvector(v, bf16x2_t); return __builtin_bit_cast(unsigned, b); }
__device__ __forceinline__ float bf_lo(unsigned w) { return __uint_as_float(w << 16); }
__device__ __forceinline__ float bf_hi(unsigned w) { return __uint_as_float(w & 0xffff0000u); }

template <int ACT  > struct EpiBf16 {
    static constexpr bool PERM = true, AFTER_DRAIN = false;
    bf16_t* O; int ldc; size_t zsO;
    __device__ __forceinline__ void operator()(const f32x4 (&acc)[2][2][4][2], const Unit& u, int wr, int wc, int fr, int fq) const {
        const int row0 = u.pm * BM + wr * 64 + fr; const int col0 = u.pn * BM + wc * 32 + 8 * fq;
#pragma unroll
        for (int ai = 0; ai < 2; ++ai)
#pragma unroll
            for (int m = 0; m < 4; ++m) { bf16_t* rowp = O + (size_t)u.zo * zsO + (size_t)(row0 + ai * HALF + m * 16) * ldc + col0;
#pragma unroll
                for (int bj = 0; bj < 2; ++bj) { f32x4 v0 = acc[ai][bj][m][0], v1 = acc[ai][bj][m][1];
                    if (ACT == 2) {
#pragma unroll
                        for (int j = 0; j < 4; ++j) { const float a = fmaxf(v0[j], 0.f), b = fmaxf(v1[j], 0.f); v0[j] = a * a; v1[j] = b * b; } }
                    u32x4 w; w.x = cvt_pk_bf16(v0[0], v0[1]); w.y = cvt_pk_bf16(v0[2], v0[3]); w.z = cvt_pk_bf16(v1[0], v1[1]); w.w = cvt_pk_bf16(v1[2], v1[3]);
                    *(u32x4*)(rowp + bj * HALF) = w; } }
    }
};
struct EpiF32 {
    static constexpr bool PERM = false, AFTER_DRAIN = false;
    float* C; int ldc; size_t zsC;
    __device__ __forceinline__ void operator()(const f32x4 (&acc)[2][2][4][2], const Unit& u, int wr, int wc, int fr, int fq) const {
        const int row0 = u.pm * BM + wr * 64 + fr, col0 = u.pn * BM + wc * 32 + 4 * fq;
#pragma unroll
        for (int ai = 0; ai < 2; ++ai)
#pragma unroll
            for (int m = 0; m < 4; ++m) { float* rowp = C + (size_t)u.zo * zsC + (size_t)(row0 + ai * HALF + m * 16) * ldc + col0;
#pragma unroll
                for (int bj = 0; bj < 2; ++bj)
#pragma unroll
                    for (int n = 0; n < 2; ++n) *(f32x4*)(rowp + bj * HALF + n * 16) = acc[ai][bj][m][n]; }
    }
};
template <bool ACCUM> struct EpiGate {
    static constexpr bool PERM = true, AFTER_DRAIN = false;
    bf16_t* U; int ldc; const bf16_t* GT; int ldg; size_t zsU;
    __device__ __forceinline__ void operator()(const f32x4 (&acc)[2][2][4][2], const Unit& u, int wr, int wc, int fr, int fq) const {
        const int row0 = u.pm * BM + wr * 64 + fr; const int col0 = u.pn * BM + wc * 32 + 8 * fq;
#pragma unroll
        for (int ai = 0; ai < 2; ++ai)
#pragma unroll
            for (int m = 0; m < 4; ++m) { const size_t row = (size_t)(row0 + ai * HALF + m * 16); bf16_t* rowp = U + (ACCUM ? (size_t)0 : (size_t)u.z * zsU) + row * ldc + col0; const bf16_t* gp = GT + row * ldg + (size_t)u.z * 2048 + col0;
#pragma unroll
                for (int bj = 0; bj < 2; ++bj) { const u32x4 gw = *(const u32x4*)(gp + bj * HALF); u32x4 pw = (u32x4){0u, 0u, 0u, 0u}; if (ACCUM && u.z > 0) pw = *(const u32x4*)(rowp + bj * HALF);
                    const f32x4 v0 = acc[ai][bj][m][0], v1 = acc[ai][bj][m][1]; const float a[8] = {v0[0], v0[1], v0[2], v0[3], v1[0], v1[1], v1[2], v1[3]};
                    float o[8];
#pragma unroll
                    for (int j = 0; j < 4; ++j) { const unsigned g2 = gw[j], p2 = pw[j];
                        const float s0 = __builtin_amdgcn_rcpf(1.f + __expf(-bf_lo(g2))), s1 = __builtin_amdgcn_rcpf(1.f + __expf(-bf_hi(g2)));
                        o[2 * j] = bf_lo(p2) + s0 * a[2 * j]; o[2 * j + 1] = bf_hi(p2) + s1 * a[2 * j + 1]; }
                    u32x4 w; w.x = cvt_pk_bf16(o[0], o[1]); w.y = cvt_pk_bf16(o[2], o[3]); w.z = cvt_pk_bf16(o[4], o[5]); w.w = cvt_pk_bf16(o[6], o[7]);
                    *(u32x4*)(rowp + bj * HALF) = w; } }
    }
};

template <class Epi, class Sched, bool ALIGN_EPI = false, bool SP2 = false>
__device__ __forceinline__ void gemm_phase(PG8_LAS unsigned char* lds, const Gemm g, const Sched& S, const Epi& E, const int wave0) {
    int tid_ = wave0 * 64 + xb_lane_pg8();
    const int tid = tid_, wid = __builtin_amdgcn_readfirstlane(tid >> 6), lane = tid & 63, wr = wid >> 2, wc = wid & 3, fr = lane & 15, fq = lane >> 4;
    const int K = g.K, nt = K / BK;
    unsigned voffA[2], voffB[2];
#pragma unroll
    for (int i = 0; i < 2; ++i) { int R, C; stage_rc(tid * 16 + i * 8192, R, C); const int Rb = Epi::PERM ? ((R & ~31) + perm32(R & 31)) : R;
        voffA[i] = (unsigned)(R * g.lda + C) * 2u; voffB[i] = (unsigned)(Rb * g.ldb + C) * 2u; }
    const size_t kstep = (size_t)(BK * 2);
    const size_t hstepA = (size_t)HALF * g.lda * 2, hstepB = (size_t)HALF * g.ldb * 2;
    const size_t tstepA = 2 * hstepA, tstepB = 2 * hstepB;
    const unsigned ldsw = (unsigned)wid * 1024u;
    const int aoff = lds_byte(wr * 64 + fr, fq * 8), boff = lds_byte(wc * 32 + fr, fq * 8);
#define PG8_SA(b, h) (((b) * 2 + (h)) * HTB)
#define PG8_SB(b, h) ((4 + (b) * 2 + (h)) * HTB)
#define PG8_STAGE(bufoff, gbase, voff) do { _Pragma("unroll") for (int _i = 0; _i < 2; ++_i) \
        __builtin_amdgcn_global_load_lds((const unsigned*)((const char*)(gbase) + (voff)[_i]), (PG8_LAS unsigned*)(lds + (bufoff) + ldsw + _i * 8192), 16, 0, 0); } while (0)
#define PG8_LDA(dst, b, h) do { _Pragma("unroll") for (int m = 0; m < 4; ++m) _Pragma("unroll") for (int k = 0; k < 2; ++k) dst[m][k] = *(const PG8_LAS bf16x8*)(lds + PG8_SA(b, h) + aoff + m * 2048 + k * 1024); } while (0)
#define PG8_LDB(dst, b, h) do { _Pragma("unroll") for (int n = 0; n < 2; ++n) _Pragma("unroll") for (int k = 0; k < 2; ++k) dst[n][k] = *(const PG8_LAS bf16x8*)(lds + PG8_SB(b, h) + boff + n * 2048 + k * 1024); } while (0)
#define PG8_MMA(ai, bj, At, Bt) do { __builtin_amdgcn_s_setprio(1); _Pragma("unroll") for (int m = 0; m < 4; ++m) _Pragma("unroll") for (int n = 0; n < 2; ++n) _Pragma("unroll") for (int k = 0; k < 2; ++k) \
        acc[ai][bj][m][n] = __builtin_amdgcn_mfma_f32_16x16x32_bf16(Bt[n][k], At[m][k], acc[ai][bj][m][n], 0, 0, 0); __builtin_amdgcn_s_setprio(0); } while (0)
#define PG8_WAIT_V(n) asm volatile("s_waitcnt vmcnt(" #n ")" ::: "memory")
#define PG8_WAIT_L(n) asm volatile("s_waitcnt lgkmcnt(" #n ")" ::: "memory")
#define PG8_BAR __builtin_amdgcn_s_barrier()
#define PG8_SCHED __builtin_amdgcn_sched_barrier(0)
    Unit cur, nxt; int ui = 0;
    if (!S.next(0, cur)) return;
    f32x4 acc[2][2][4][2];
#pragma unroll
    for (int a = 0; a < 2; ++a)
#pragma unroll
        for (int b = 0; b < 2; ++b)
#pragma unroll
            for (int m = 0; m < 4; ++m)
#pragma unroll
                for (int n = 0; n < 2; ++n) acc[a][b][m][n] = (f32x4){0.f, 0.f, 0.f, 0.f};
    bf16x8 At[4][2], B0[2][2], B1[2][2];
    const char* cA = (const char*)g.A + (size_t)cur.z * g.zsA + (size_t)cur.pm * tstepA + (size_t)cur.k0 * 2; const char* cB = (const char*)g.Bt + (size_t)cur.z * g.zsB + (size_t)cur.pn * tstepB + (size_t)cur.k0 * 2;
    S.a_ready(cur);
    if constexpr (SP2) {
        PG8_STAGE(PG8_SB(0, 0), cB, voffB); PG8_STAGE(PG8_SB(0, 1), cB + hstepB, voffB); PG8_STAGE(PG8_SA(0, 0), cA, voffA); PG8_STAGE(PG8_SA(0, 1), cA + hstepA, voffA);
        if (wr == 1) PG8_BAR;
        PG8_WAIT_V(2); PG8_BAR;
        PG8_STAGE(PG8_SB(1, 0), cB + kstep, voffB); PG8_STAGE(PG8_SA(1, 0), cA + kstep, voffA); PG8_STAGE(PG8_SB(1, 1), cB + hstepB + kstep, voffB);
        PG8_WAIT_V(6); PG8_BAR;
    } else {
        PG8_STAGE(PG8_SB(0, 0), cB, voffB); PG8_STAGE(PG8_SA(0, 0), cA, voffA); PG8_STAGE(PG8_SB(0, 1), cB + hstepB, voffB); PG8_STAGE(PG8_SA(0, 1), cA + hstepA, voffA);
        if (wr == 1) PG8_BAR;
        PG8_WAIT_V(4); PG8_BAR;
        PG8_STAGE(PG8_SB(1, 0), cB + kstep, voffB); PG8_STAGE(PG8_SA(1, 0), cA + kstep, voffA); PG8_STAGE(PG8_SB(1, 1), cB + hstepB + kstep, voffB);
        PG8_WAIT_V(6); PG8_BAR;
    }
    for (;;) {
        const bool has_next = S.next(ui + 1, nxt);
        const char* nA = has_next ? (const char*)g.A + (size_t)nxt.z * g.zsA + (size_t)nxt.pm * tstepA + (size_t)nxt.k0 * 2 : cA; const char* nB = has_next ? (const char*)g.Bt + (size_t)nxt.z * g.zsB + (size_t)nxt.pn * tstepB + (size_t)nxt.k0 * 2 : cB;
        for (int t = 0; t < nt; t += 2) {
            const bool last = (t == nt - 2);
            const char* a1 = cA + (size_t)(t + 1) * kstep;
            const char* a2 = last ? nA : cA + (size_t)(t + 2) * kstep; const char* b2 = last ? nB : cB + (size_t)(t + 2) * kstep;
            const char* a3 = a2 + kstep; const char* b3 = b2 + kstep;
            if (last && has_next) S.a_ready(nxt);
            if constexpr (SP2) {
            PG8_LDB(B0, 0, 0); PG8_LDB(B1, 0, 1); PG8_SCHED; PG8_LDA(At, 0, 0); PG8_STAGE(PG8_SA(1, 1), a1 + hstepA, voffA);
            PG8_WAIT_V(8); PG8_WAIT_L(0); PG8_BAR; PG8_MMA(0, 0, At, B0); PG8_MMA(0, 1, At, B1); PG8_BAR; PG8_SCHED;
            PG8_LDA(At, 0, 1); PG8_STAGE(PG8_SB(0, 0), b2, voffB); PG8_STAGE(PG8_SB(0, 1), b2 + hstepB, voffB); PG8_STAGE(PG8_SA(0, 0), a2, voffA);
            PG8_WAIT_V(8); PG8_WAIT_L(0); PG8_BAR; PG8_MMA(1, 0, At, B0); PG8_MMA(1, 1, At, B1); PG8_BAR; PG8_SCHED;
            PG8_LDB(B0, 1, 0); PG8_LDB(B1, 1, 1); PG8_SCHED; PG8_LDA(At, 1, 0); PG8_STAGE(PG8_SA(0, 1), a2 + hstepA, voffA);
            PG8_WAIT_V(8); PG8_WAIT_L(0); PG8_BAR; PG8_MMA(0, 0, At, B0); PG8_MMA(0, 1, At, B1); PG8_BAR; PG8_SCHED;
            PG8_LDA(At, 1, 1); PG8_STAGE(PG8_SB(1, 0), b3, voffB); PG8_STAGE(PG8_SB(1, 1), b3 + hstepB, voffB); PG8_STAGE(PG8_SA(1, 0), a3, voffA);
            PG8_WAIT_V(8); PG8_WAIT_L(0); PG8_BAR; PG8_MMA(1, 0, At, B0); PG8_MMA(1, 1, At, B1); PG8_BAR; PG8_SCHED;
            } else {
            PG8_LDB(B0, 0, 0); PG8_SCHED; PG8_LDA(At, 0, 0); PG8_STAGE(PG8_SA(1, 1), a1 + hstepA, voffA);
            PG8_WAIT_L(8); PG8_BAR; PG8_WAIT_L(0); PG8_MMA(0, 0, At, B0); PG8_BAR; PG8_SCHED;
            PG8_LDB(B1, 0, 1); PG8_STAGE(PG8_SB(0, 0), b2, voffB);
            PG8_BAR; PG8_WAIT_L(0); PG8_MMA(0, 1, At, B1); PG8_BAR;
            PG8_LDA(At, 0, 1); PG8_STAGE(PG8_SA(0, 0), a2, voffA);
            PG8_BAR; PG8_WAIT_L(0); PG8_MMA(1, 0, At, B0); PG8_BAR; PG8_SCHED;
            PG8_STAGE(PG8_SB(0, 1), b2 + hstepB, voffB);
            PG8_WAIT_V(6); PG8_BAR; PG8_MMA(1, 1, At, B1); PG8_BAR;
            PG8_LDB(B0, 1, 0); PG8_SCHED; PG8_LDA(At, 1, 0); PG8_STAGE(PG8_SA(0, 1), a2 + hstepA, voffA);
            PG8_WAIT_L(8); PG8_BAR; PG8_WAIT_L(0); PG8_MMA(0, 0, At, B0); PG8_BAR; PG8_SCHED;
            PG8_LDB(B1, 1, 1); PG8_STAGE(PG8_SB(1, 0), b3, voffB);
            PG8_BAR; PG8_WAIT_L(0); PG8_MMA(0, 1, At, B1); PG8_BAR;
            PG8_LDA(At, 1, 1); PG8_STAGE(PG8_SA(1, 0), a3, voffA);
            PG8_BAR; PG8_WAIT_L(0); PG8_MMA(1, 0, At, B0); PG8_BAR; PG8_SCHED;
            PG8_STAGE(PG8_SB(1, 1), b3 + hstepB, voffB);
            PG8_WAIT_V(6); PG8_BAR; PG8_MMA(1, 1, At, B1); PG8_BAR;
            }
        }
        if constexpr (ALIGN_EPI) { if (wr == 0) PG8_BAR; }
        if constexpr (!Epi::AFTER_DRAIN) { E(acc, cur, wr, wc, fr, fq); S.done(cur); }
        if (!has_next) break;
#pragma unroll
        for (int a = 0; a < 2; ++a)
#pragma unroll
            for (int b = 0; b < 2; ++b)
#pragma unroll
                for (int m = 0; m < 4; ++m)
#pragma unroll
                    for (int n = 0; n < 2; ++n) acc[a][b][m][n] = (f32x4){0.f, 0.f, 0.f, 0.f};
        cur = nxt; cA = nA; cB = nB; ++ui;
        if constexpr (ALIGN_EPI) { if (wr == 1) PG8_BAR; }
    }
    PG8_WAIT_V(0);
    if constexpr (!ALIGN_EPI) { if (wr == 0) PG8_BAR; }
    PG8_BAR;
    if constexpr (Epi::AFTER_DRAIN) { E.fused(acc, cur, wr, wc, fr, fq, lds, wid, lane); S.done(cur); }
#undef PG8_SA
#undef PG8_SB
#undef PG8_STAGE
#undef PG8_LDA
#undef PG8_LDB
#undef PG8_MMA
#undef PG8_WAIT_V
#undef PG8_WAIT_L
#undef PG8_BAR
#undef PG8_SCHED
}
}

constexpr int DM = 2048, NB = 4, SEQ = 2048, DEPTH = 4, GW = 64, CTXL = 256, DFF = 8192;
constexpr int ML = NB * SEQ, MC = NB * CTXL, MT = ML + MC;
constexpr int NIN = 17440, NINP = 17664;
constexpr int NHEAD = 8;
constexpr float LN_EPS = 1e-5f, RMS_EPS = 1e-6f;
constexpr float DN_ALPHA = 1.6817928305074290f;
constexpr int PC_AQ = 0, PC_AI = 1024, PC_AG = 2048, PC_AFF = 3072, PC_AFB = 4096, PC_BQ = 5120, PC_BK = 5632, PC_BV = 6144, PC_BG = 7168,
              PC_CQ = 8192, PC_CK = 9216, PC_CV = 10240, PC_GT = 11264, PC_GK = 17408;
__host__ __device__ __forceinline__ int in_src_col(int n) { return n < 8192 ? n : (n < 17408 ? n + 32 : (n < 17440 ? 8192 + (n - 17408) : -1)); }

constexpr size_t MiB = 1u << 20;
constexpr size_t WS_CTL = 0, CTL_ZERO_BYTES = 1 * MiB;
constexpr size_t WS_MODP = 1 * MiB;
constexpr size_t WS_MOD = WS_MODP + 16 * MiB;
constexpr size_t WS_TAB = WS_MOD + 1 * MiB;
constexpr size_t TAB_LB = 0, TAB_RR = 32768, TAB_RC = 32768 + 4096;
constexpr size_t WS_WIN = WS_TAB + 1 * MiB;
constexpr size_t WS_WBR = WS_WIN + 277 * MiB;
constexpr size_t WS_WOUT = WS_WBR + 48 * MiB;
constexpr size_t WS_WM1 = WS_WOUT + 32 * MiB;
constexpr size_t WS_WM2 = WS_WM1 + 128 * MiB;
constexpr size_t WS_XS = WS_WM2 + 128 * MiB;
constexpr size_t WS_H = WS_XS + 72 * MiB;
constexpr size_t WS_P = WS_H + 36 * MiB;
constexpr size_t WS_Y = WS_P + 311 * MiB;
constexpr size_t WS_U = WS_Y + 54 * MiB;
constexpr size_t WS_MIX = WS_U + 36 * MiB;
constexpr size_t WS_HM = WS_MIX + 72 * MiB;
constexpr size_t WS_SCAN = WS_HM + 144 * MiB;
constexpr size_t WS_PART = WS_SCAN + 400 * MiB;
constexpr size_t WS_UC = WS_PART + 96 * MiB;
constexpr size_t WS_END = WS_UC + 12 * MiB;
static_assert((size_t)4 * NINP * 2048 * 2 <= 277 * MiB && (size_t)MT * NINP * 2 <= 311 * MiB, "ws map");

constexpr int RING_OFF = 0, RING_BYTES = 131072;
constexpr int LDS_BYTES = 163840;
constexpr int LDSCTL_OFF = LDS_BYTES - 1024, MISC_OFF = LDSCTL_OFF + 320;
constexpr int NWAVES = 8;

#define GAS __attribute__((address_space(1)))
#define LAS __attribute__((address_space(3)))
typedef unsigned short bf16;
typedef unsigned v4u __attribute__((ext_vector_type(4)));
typedef unsigned v2u __attribute__((ext_vector_type(2)));
typedef float f32x4 __attribute__((ext_vector_type(4)));
typedef float f32x2 __attribute__((ext_vector_type(2)));
typedef short bf16x8 __attribute__((ext_vector_type(8)));
typedef GAS unsigned gu32;
#define RLX_AGENT __ATOMIC_RELAXED, __HIP_MEMORY_SCOPE_AGENT
#define LDS_WAIT() asm volatile("s_waitcnt lgkmcnt(0)" ::: "memory")
#define VM_WAIT() asm volatile("s_waitcnt vmcnt(0)" ::: "memory")
typedef float f32x2_t __attribute__((ext_vector_type(2))); typedef __bf16 bf16x2_t __attribute__((ext_vector_type(2)));
__device__ __forceinline__ unsigned pk2(float lo, float hi) { const f32x2_t v = {lo, hi}; const bf16x2_t b = __builtin_convertvector(v, bf16x2_t); return __builtin_bit_cast(unsigned, b); }
__device__ __forceinline__ unsigned f2bf(float f) { return pk2(f, 0.f) & 0xffffu; }
__device__ __forceinline__ float bflo(unsigned w) { return __uint_as_float(w << 16); }
__device__ __forceinline__ float bfhi(unsigned w) { return __uint_as_float(w & 0xffff0000u); }
__device__ __forceinline__ float bf2f(bf16 h) { return __uint_as_float(((unsigned)h) << 16); }
__device__ __forceinline__ float sigmoidf_(float x) { return __builtin_amdgcn_rcpf(1.f + __expf(-x)); }
__device__ __forceinline__ float wave_sum(float v) {
#pragma unroll
    for (int o = 1; o < 64; o <<= 1) v += __shfl_xor(v, o);
    return v;
}
constexpr int CW_TMO = 0, CW_CODE = 1, CW_BAR = 4096, CW_QUEUE = 16384;

#define XB_TMO      128
#define XB_XCNT(j)  (256  + 64 * (j))
#define XB_XSUB(j)  (1280 + 64 * (j))
#define XB_XGEN(j)  (2304 + 64 * (j))
#define XB_TOP      3328
#define XB_TOPGEN   3392
#define XCD_BAR_WORDS 3456
#define XB_SPIN_CAP (1u << 18)

__device__ __forceinline__ unsigned xb_ld(unsigned* p)              { return __hip_atomic_load(p, __ATOMIC_RELAXED, __HIP_MEMORY_SCOPE_AGENT); }
__device__ __forceinline__ unsigned xb_add(unsigned* p, unsigned v) { return __hip_atomic_fetch_add(p, v, __ATOMIC_RELAXED, __HIP_MEMORY_SCOPE_AGENT); }
__device__ __forceinline__ unsigned xb_xcc_id() { return (unsigned)__builtin_amdgcn_s_getreg((3 << 11) | 20) & 0xFu; }
#define XB_SPIN(cond, bar) do { unsigned _sp = 0; while (cond) { __builtin_amdgcn_s_sleep(1); \
    if ((++_sp & 255u) == 0u) { if (xb_ld(&(bar)[XB_TMO])) break; if (_sp > XB_SPIN_CAP) { atomicAdd(&(bar)[XB_TMO], 1u); break; } } } } while (0)

__device__ __forceinline__ int xb_lane() { int z = 0; asm volatile("" : "+v"(z)); return (int)__builtin_amdgcn_mbcnt_hi(~0u, __builtin_amdgcn_mbcnt_lo(~0u, (unsigned)z)); }
struct XcdBarrier {
    unsigned* bar; unsigned x;
    int wave;
    volatile LAS unsigned* st;
};

__device__ __forceinline__ XcdBarrier xcd_barrier_post(unsigned* bar, volatile LAS unsigned* st) {
    XcdBarrier b; b.bar = bar; b.x = xb_xcc_id(); b.st = st; b.wave = __builtin_amdgcn_readfirstlane((int)threadIdx.x >> 6);
    if (threadIdx.x == 0) (void)xb_add(&bar[XB_XCNT(b.x)], 1u);
    return b;
}
__device__ __forceinline__ void xcd_barrier_complete(unsigned* bar, unsigned x, unsigned& nloc, unsigned& nx) {
    const unsigned G = gridDim.x * gridDim.y * gridDim.z;
    unsigned sum, cnt, mine, sp = 0u;
    for (;;) {
        sum = 0u; cnt = 0u; mine = 0u;
#pragma unroll
        for (unsigned j = 0; j < 16; ++j) { const unsigned c = xb_ld(&bar[XB_XCNT(j)]); sum += c; cnt += (c > 0u) ? 1u : 0u; mine = (j == x) ? c : mine; }
        if (sum == G) break;
        __builtin_amdgcn_s_sleep(1);
        if ((++sp & 255u) == 0u) { if (xb_ld(&bar[XB_TMO])) break; if (sp > XB_SPIN_CAP) { atomicAdd(&bar[XB_TMO], 1u); break; } }
    }
    nloc = mine > 0u ? mine : 1u; nx = cnt > 0u ? cnt : 1u;
}

__device__ __forceinline__ void xcd_barrier(const XcdBarrier& b) {
    asm volatile("s_waitcnt vmcnt(0)" ::: "memory");
    __syncthreads();
    if (b.wave == 0 && xb_lane() == 0) {
        unsigned* bar = b.bar;
        __builtin_amdgcn_s_waitcnt(0);
        unsigned nloc = b.st[0], nx = b.st[1];
        if (nloc == 0u) { xcd_barrier_complete(bar, b.x, nloc, nx); b.st[0] = nloc; b.st[1] = nx; }
        const unsigned old = xb_add(&bar[XB_XSUB(b.x)], 1u);
        const unsigned gen = old / nloc;
        if (old + 1u == (gen + 1u) * nloc) {
            __builtin_amdgcn_fence(__ATOMIC_RELEASE, "agent");
            asm volatile("s_waitcnt vmcnt(0)" ::: "memory");
            const unsigned og = xb_add(&bar[XB_TOP], 1u);
            const unsigned tg = og / nx;
            if (og + 1u == (tg + 1u) * nx) xb_add(&bar[XB_TOPGEN], 1u);
            else XB_SPIN(xb_ld(&bar[XB_TOPGEN]) == tg, bar);
            __builtin_amdgcn_fence(__ATOMIC_ACQUIRE, "agent");
            xb_add(&bar[XB_XGEN(b.x)], 1u);
            asm volatile("s_waitcnt vmcnt(0)" ::: "memory");
        } else {
            XB_SPIN(xb_ld(&bar[XB_XGEN(b.x)]) == gen, bar);
            __builtin_amdgcn_fence(__ATOMIC_ACQUIRE, "agent");
            asm volatile("s_waitcnt vmcnt(0)" ::: "memory");
        }
    }
    __syncthreads();
}


typedef const float* cfp_t; typedef __attribute__((address_space(4))) const cfp_t* kin_t;
__device__ __forceinline__ kin_t kin_launder(kin_t p) { asm volatile("" : "+s"(p)); return p; }
#define FIN(k) (kin_launder(F.kin)[k])
struct Frame {
    LAS unsigned char* lds;
    volatile LAS unsigned* MISC;
    gu32* ctl;
    int tid, lane, wave;
    int vcu, G;
    unsigned char* ws;
    kin_t kin;
    float* out;
};

__device__ __forceinline__ void p0_transpose_item(const float* W, int ldw, int src_col0, int k0, bf16* WT, int K, int dst_row0, LAS float* scr, int lane) {
    const int kr = lane >> 3, nc = lane & 7;
    f32x4 v[8];
    if (src_col0 >= 0) { const float* wp = W + (size_t)(k0 + kr) * ldw + src_col0 + 4 * nc;
#pragma unroll
        for (int i = 0; i < 8; ++i) v[i] = *(const GAS f32x4*)(wp + (size_t)(8 * i) * ldw);
    } else {
#pragma unroll
        for (int i = 0; i < 8; ++i) v[i] = (f32x4){0.f, 0.f, 0.f, 0.f};
    }
#pragma unroll
    for (int i = 0; i < 8; ++i) { LAS float* d = scr + (8 * i + kr) * 33 + 4 * nc; d[0] = v[i][0]; d[1] = v[i][1]; d[2] = v[i][2]; d[3] = v[i][3]; }
    LDS_WAIT(); asm volatile("" ::: "memory");
    const int c = lane & 7;
#pragma unroll
    for (int j = 0; j < 4; ++j) { const int n = (lane >> 3) + 8 * j; const LAS float* s = scr + (8 * c) * 33 + n;
        v4u o; o.x = pk2(s[0 * 33], s[1 * 33]); o.y = pk2(s[2 * 33], s[3 * 33]); o.z = pk2(s[4 * 33], s[5 * 33]); o.w = pk2(s[6 * 33], s[7 * 33]);
        *(GAS v4u*)(WT + (size_t)(dst_row0 + n) * K + k0 + 8 * c) = o; }
    LDS_WAIT(); asm volatile("" ::: "memory");
}
constexpr int CV_IIN = 32 * (NINP / 32), CV_IBR = 3 * 16 * 64, CV_IOUT = 32 * 64, CV_IM1 = 32 * 256, CV_IM2 = 128 * 64, CV_IL = CV_IIN + CV_IBR + CV_IOUT + CV_IM1 + CV_IM2;
constexpr int CV_P0 = 11168, CV_P1 = 18168, CV_P2 = 27168;
__device__ __forceinline__ void convert_items(Frame& F, int l, int r_lo, int r_hi, int widx, int nw) {
    LAS float* scr = (LAS float*)(F.lds + RING_OFF + F.wave * 8448); const int lane = xb_lane();
    for (int it = r_lo + widx; it < r_hi; it += nw) { int r = it;
        if (r < CV_IIN) { const int nbk = NINP / 32, kb = r / nbk, nb = r % nbk; p0_transpose_item(FIN(6) + (size_t)l * 2048 * NIN, NIN, in_src_col(32 * nb), 64 * kb, (bf16*)(F.ws + WS_WIN) + (size_t)l * NINP * 2048, 2048, 32 * nb, scr, lane); continue; } r -= CV_IIN;
        if (r < CV_IBR) { const int n = r / 1024, rr = r % 1024, kb = rr / 64, nb = rr % 64; p0_transpose_item(FIN(13) + (size_t)(l * 3 + n) * 1024 * 2048, 2048, 32 * nb, 64 * kb, (bf16*)(F.ws + WS_WBR) + (size_t)(l * 3 + n) * 2048 * 1024, 1024, 32 * nb, scr, lane); continue; } r -= CV_IBR;
        if (r < CV_IOUT) { const int kb = r / 64, nb = r % 64; p0_transpose_item(FIN(14) + (size_t)l * 2048 * 2048, 2048, 32 * nb, 64 * kb, (bf16*)(F.ws + WS_WOUT) + (size_t)l * 2048 * 2048, 2048, 32 * nb, scr, lane); continue; } r -= CV_IOUT;
        if (r < CV_IM1) { const int kb = r / 256, nb = r % 256; p0_transpose_item(FIN(19) + (size_t)l * 2048 * 8192, 8192, 32 * nb, 64 * kb, (bf16*)(F.ws + WS_WM1) + (size_t)l * 8192 * 2048, 2048, 32 * nb, scr, lane); continue; } r -= CV_IM1;
        { const int kb = r / 64, nb = r % 64; p0_transpose_item(FIN(20) + (size_t)l * 8192 * 2048, 2048, 32 * nb, 64 * kb, (bf16*)(F.ws + WS_WM2) + (size_t)l * 2048 * 8192, 8192, 32 * nb, scr, lane); }
    }
}
__device__ __forceinline__ void convert_pocket(Frame& F, int lnext, int r_lo, int r_hi, int first_idle) {
    const int c = (int)blockIdx.x; if (lnext >= DEPTH || c < first_idle) return;
    convert_items(F, lnext, r_lo, r_hi, (c - first_idle) * NWAVES + F.wave, ((int)gridDim.x - first_idle) * NWAVES);
}
__device__ __forceinline__ void p0_prologue(Frame& FF) {
    Frame F = FF; F.lane = xb_lane(); F.tid = F.wave * 64 + F.lane;
    LAS float* scr = (LAS float*)(F.lds + RING_OFF + F.wave * 8448);
    LAS float* sil = (LAS float*)(F.lds + RING_OFF + 69632);
    const int gw = F.vcu * NWAVES + F.wave, NGW = F.G * NWAVES;
    for (int i = F.tid; i < 5 * 2048; i += NWAVES * 64) { const int b = i >> 11, k = i & 2047; const float v = (b < 4) ? FIN(1)[b * 2048 + k] : FIN(3)[k]; sil[i] = v * sigmoidf_(v); }
    { float* LB = (float*)(F.ws + WS_TAB + TAB_LB);
      for (int i = gw * 64 + F.lane; i < 2048; i += NGW * 64) { float e[4], mx = -1e30f;
#pragma unroll
          for (int l = 0; l < 4; ++l) { e[l] = FIN(7)[l * 2048 + i]; mx = fmaxf(mx, e[l]); }
          float s = 0.f;
#pragma unroll
          for (int l = 0; l < 4; ++l) { e[l] = expf(e[l] - mx); s += e[l]; }
          const float inv = 1.f / s; float cum = 0.f;
#pragma unroll
          for (int l = 0; l < 4; ++l) { LB[l * 2048 + i] = cum; cum += e[l] * inv; } }
      f32x2* RR = (f32x2*)(F.ws + WS_TAB + TAB_RR); f32x2* RC = (f32x2*)(F.ws + WS_TAB + TAB_RC);
      for (int i = gw * 64 + F.lane; i < 96 * 16; i += NGW * 64) { const int p = i >> 4, j = i & 15; const int pos = p < 32 ? p : p - 32;
          const float fr = expf(-(float)j * (9.210340371976184f / 16.f)); const float ang = (float)pos * fr; const f32x2 cs = {cosf(ang), sinf(ang)};
          if (p < 32) RR[p * 16 + j] = cs; else RC[(p - 32) * 16 + j] = cs; } }
    __syncthreads();
    for (int u = gw; u < 3072; u += NGW) { const int l = u / 768, r = u % 768, cb = r >> 4, ks = r & 15; const int c0 = cb * 256 + 4 * F.lane;
        f32x4 acc[5];
#pragma unroll
        for (int b = 0; b < 5; ++b) acc[b] = (f32x4){0.f, 0.f, 0.f, 0.f};
        const float* wp = FIN(4) + ((size_t)l * 2048 + ks * 128) * 12288 + c0;
#pragma unroll 8
        for (int k = 0; k < 128; ++k) { const f32x4 w = *(const GAS f32x4*)(wp + (size_t)k * 12288);
#pragma unroll
            for (int b = 0; b < 5; ++b) acc[b] += w * sil[b * 2048 + ks * 128 + k]; }
        float* mp = (float*)(F.ws + WS_MODP) + ((size_t)(ks * 4 + l) * 5) * 12288 + c0;
#pragma unroll
        for (int b = 0; b < 5; ++b) *(GAS f32x4*)(mp + (size_t)b * 12288) = acc[b]; }
    convert_items(F, 0, 0, CV_IL, gw, NGW);
    for (int l = 1; l < DEPTH; ++l) convert_items(F, l, 0, F.G == 256 ? CV_P0 : CV_IL, gw, NGW);
}
__device__ __forceinline__ void p0b_modreduce(Frame& FF) {
    Frame F = FF; F.lane = xb_lane(); F.tid = F.wave * 64 + F.lane;
    const float* mp = (const float*)(F.ws + WS_MODP); float* mo = (float*)(F.ws + WS_MOD);
    for (int i = (F.vcu * NWAVES + F.wave) * 64 + F.lane; i < 4 * 5 * 12288; i += F.G * NWAVES * 64) { const int l = i / (5 * 12288), c = i % 12288;
        float s = FIN(5)[l * 12288 + c];
#pragma unroll
        for (int ks = 0; ks < 16; ++ks) s += mp[(size_t)ks * (4 * 5 * 12288) + i];
        mo[i] = s; }
}
__device__ __forceinline__ int row_modb(int row) { return row < ML ? (row >> 11) : 4; }
__device__ __forceinline__ const float* row_input(const Frame& F, int row) { return row < ML ? FIN(0) + (size_t)row * DM : FIN(2) + (size_t)(row - ML) * DM; }
__device__ __forceinline__ void store_modulated(const f32x4 (&v)[8], const float* sc, const float* sh, bf16* hrow, int lane) {
#pragma unroll
    for (int j = 0; j < 8; ++j) { const int c = 4 * lane + 256 * j; const f32x4 s = *(const GAS f32x4*)(sc + c), t = *(const GAS f32x4*)(sh + c);
        const f32x4 o = v[j] * (s + 1.0f) + t; v2u w; w.x = pk2(o[0], o[1]); w.y = pk2(o[2], o[3]); *(GAS v2u*)(hrow + c) = w; }
}
__device__ __forceinline__ void p0c_modulate(Frame& FF) {
    Frame F = FF; F.lane = xb_lane(); F.tid = F.wave * 64 + F.lane;
    const float* mo = (const float*)(F.ws + WS_MOD); bf16* H = (bf16*)(F.ws + WS_H);
    for (int row = F.vcu * NWAVES + F.wave; row < MT; row += F.G * NWAVES) { const float* xr = row_input(F, row); const float* mb = mo + (size_t)row_modb(row) * 12288;
        f32x4 v[8];
#pragma unroll
        for (int j = 0; j < 8; ++j) v[j] = *(const GAS f32x4*)(xr + 4 * F.lane + 256 * j);
        store_modulated(v, mb + 1 * 2048, mb + 0 * 2048, H + (size_t)row * DM, F.lane); }
}
__device__ __forceinline__ void ln_rows(Frame& F, const float* xbase, const float* mixbase, int nslab, float* obase, bf16* hbase, int row0, int nr, bool hm, LAS float* V, int lane, int wave) {
    f32x4 xn[8], mn[8];
    const bool part = nslab > 0;
    const unsigned ol = (unsigned)(16 * lane);
#define LN_UB(p) ([&]() -> const char* { const char* b_ = (const char*)(p); asm volatile("" : "+s"(b_)); return b_; }())
#define LN_LOAD(row) do { const char* xr_ = LN_UB(xbase + (size_t)(row) * DM); _Pragma("unroll") for (int j = 0; j < 8; ++j) xn[j] = *(const GAS f32x4*)(xr_ + ol + 1024 * j); \
        if (!part) { const char* mr_ = LN_UB((const bf16*)mixbase + (size_t)(row) * DM); _Pragma("unroll") for (int j = 0; j < 8; ++j) { const v2u w_ = *(const GAS v2u*)(mr_ + (ol >> 1) + 512 * j); mn[j] = (f32x4){bflo(w_.x), bfhi(w_.x), bflo(w_.y), bfhi(w_.y)}; } } \
        else { const bf16* pr0_ = (const bf16*)mixbase + (size_t)((row) - ML) * DM; _Pragma("unroll") for (int j = 0; j < 8; ++j) mn[j] = (f32x4){0.f, 0.f, 0.f, 0.f}; \
            _Pragma("nounroll") for (int ks = 0; ks < nslab; ++ks) { const char* ps_ = LN_UB(pr0_ + (size_t)ks * MC * DM); _Pragma("unroll") for (int j = 0; j < 8; ++j) { const v2u w_ = *(const GAS v2u*)(ps_ + (ol >> 1) + 512 * j); mn[j] += (f32x4){bflo(w_.x), bfhi(w_.x), bflo(w_.y), bfhi(w_.y)}; } } } } while (0)
    if (nr > 0) LN_LOAD(row0 + wave);
    for (int i = 0; i < nr; ++i) { const int row = row0 + wave + 8 * i;
        f32x4 v[8]; float s = 0.f;
#pragma unroll
        for (int j = 0; j < 8; ++j) { const f32x4 g = *(const LAS f32x4*)(V + 0 * 2048 + 4 * lane + 256 * j); v[j] = xn[j] * DN_ALPHA + g * mn[j]; s += (v[j][0] + v[j][1]) + (v[j][2] + v[j][3]); }
        __builtin_amdgcn_sched_barrier(0);
        if (i + 1 < nr) LN_LOAD(row + 8);
        __builtin_amdgcn_sched_barrier(0);
        const float mean = wave_sum(s) * (1.f / DM); float q = 0.f;
#pragma unroll
        for (int j = 0; j < 8; ++j) { v[j] = v[j] - mean; q += (v[j][0] * v[j][0] + v[j][1] * v[j][1]) + (v[j][2] * v[j][2] + v[j][3] * v[j][3]); }
        const float rstd = 1.0f / sqrtf(wave_sum(q) * (1.f / DM) + LN_EPS);
        char* orow = (char*)(obase + (size_t)row * DM) + ol; char* hrow = (char*)(hbase + (size_t)row * DM) + (ol >> 1);
#pragma unroll
        for (int j = 0; j < 8; ++j) { const f32x4 g = *(const LAS f32x4*)(V + 1 * 2048 + 4 * lane + 256 * j), b = *(const LAS f32x4*)(V + 2 * 2048 + 4 * lane + 256 * j);
            v[j] = v[j] * rstd * g + b; *(GAS f32x4*)(orow + 1024 * j) = v[j];
            if (hm) { const f32x4 sc = *(const LAS f32x4*)(V + 3 * 2048 + 4 * lane + 256 * j), sh = *(const LAS f32x4*)(V + 4 * 2048 + 4 * lane + 256 * j); const f32x4 o = v[j] * sc + sh;
                v2u w; w.x = pk2(o[0], o[1]); w.y = pk2(o[2], o[3]); *(GAS v2u*)(hrow + 512 * j) = w; }
            if (j & 1) __builtin_amdgcn_sched_barrier(0); }
    }
#undef LN_LOAD
#undef LN_UB
}
__device__ __forceinline__ void ln_phase(Frame& FF, int l, int gi, const float* lng, const float* lnb, int lh, int hmod, bool first, bool to_out, int nrows, bool dry, int nslab) {
    Frame F = FF; F.lane = xb_lane(); F.tid = F.wave * 64 + F.lane;
    const float* mo = (const float*)(F.ws + WS_MOD); float* XS = (float*)(F.ws + WS_XS); const float* MIX = (const float*)(F.ws + WS_MIX); bf16* H = dry ? (bf16*)(F.ws + WS_HM + 72 * MiB) : (bf16*)(F.ws + WS_H);
    LAS float* V = (LAS float*)(F.lds + RING_OFF);
    if (F.G != 256) {
        for (int row = F.vcu * NWAVES + F.wave; row < nrows; row += F.G * NWAVES) { const int mb = row_modb(row);
            const float* xr = first ? row_input(F, row) : XS + (size_t)row * DM; const float* gv = mo + ((size_t)l * 5 + mb) * 12288 + gi * 2048;
            f32x4 v[8]; float s = 0.f;
#pragma unroll
            for (int j = 0; j < 8; ++j) { const int c = 4 * F.lane + 256 * j; const f32x4 xv = *(const GAS f32x4*)(xr + c), g = *(const GAS f32x4*)(gv + c); f32x4 mv;
                if (row < ML) { const v2u w_ = *(const GAS v2u*)((const bf16*)MIX + (size_t)row * DM + c); mv = (f32x4){bflo(w_.x), bfhi(w_.x), bflo(w_.y), bfhi(w_.y)}; }
                else { const bf16* pr = (const bf16*)(F.ws + WS_PART) + (size_t)(row - ML) * DM + c; mv = (f32x4){0.f, 0.f, 0.f, 0.f}; for (int ks = 0; ks < nslab; ++ks) { const v2u w_ = *(const GAS v2u*)(pr + (size_t)ks * MC * DM); mv += (f32x4){bflo(w_.x), bfhi(w_.x), bflo(w_.y), bfhi(w_.y)}; } }
                v[j] = xv * DN_ALPHA + g * mv; s += (v[j][0] + v[j][1]) + (v[j][2] + v[j][3]); }
            const float mean = wave_sum(s) * (1.f / DM); float q = 0.f;
#pragma unroll
            for (int j = 0; j < 8; ++j) { v[j] = v[j] - mean; q += (v[j][0] * v[j][0] + v[j][1] * v[j][1]) + (v[j][2] * v[j][2] + v[j][3] * v[j][3]); }
            const float rstd = 1.0f / sqrtf(wave_sum(q) * (1.f / DM) + LN_EPS);
            float* orow = dry ? (float*)(F.ws + WS_HM) + (size_t)row * DM : (to_out ? F.out + (size_t)row * DM : XS + (size_t)row * DM);
#pragma unroll
            for (int j = 0; j < 8; ++j) { const int c = 4 * F.lane + 256 * j; const f32x4 g = *(const GAS f32x4*)(lng + c), b = *(const GAS f32x4*)(lnb + c); v[j] = v[j] * rstd * g + b; *(GAS f32x4*)(orow + c) = v[j]; }
            if (hmod >= 0) { const float* mh = mo + ((size_t)lh * 5 + mb) * 12288; store_modulated(v, mh + (hmod + 1) * 2048, mh + hmod * 2048, H + (size_t)row * DM, F.lane); } }
        return;
    }
    float* obase = dry ? (float*)(F.ws + WS_HM) : (to_out ? F.out : XS);
#pragma unroll 1
    for (int seg = 0; seg < 2; ++seg) {
        if (seg == 1 && nrows <= ML) break;
        const int mb = seg == 0 ? (F.vcu >> 6) : 4;
        __syncthreads();
        { const float* gv = mo + ((size_t)l * 5 + mb) * 12288 + gi * 2048; const float* mh = mo + ((size_t)(hmod >= 0 ? lh : l) * 5 + mb) * 12288; const int c = 4 * F.tid;
          *(LAS f32x4*)(V + 0 * 2048 + c) = *(const GAS f32x4*)(gv + c); *(LAS f32x4*)(V + 1 * 2048 + c) = *(const GAS f32x4*)(lng + c); *(LAS f32x4*)(V + 2 * 2048 + c) = *(const GAS f32x4*)(lnb + c);
          if (hmod >= 0) { *(LAS f32x4*)(V + 3 * 2048 + c) = *(const GAS f32x4*)(mh + (hmod + 1) * 2048 + c) + 1.0f; *(LAS f32x4*)(V + 4 * 2048 + c) = *(const GAS f32x4*)(mh + hmod * 2048 + c); } }
        LDS_WAIT(); __syncthreads();
        if (seg == 0) ln_rows(F, first ? FIN(0) : XS, MIX, 0, obase, H, 32 * F.vcu, 4, hmod >= 0, V, F.lane, F.wave);
        else ln_rows(F, first ? FIN(2) - (size_t)ML * DM : XS, (const float*)(F.ws + WS_PART), nslab, obase, H, ML + 4 * F.vcu, F.wave < 4 ? 1 : 0, hmod >= 0, V, F.lane, F.wave);
    }
}

typedef float f32x16 __attribute__((ext_vector_type(16)));
constexpr int NCH = 144;
constexpr size_t SC_QA = 0, SC_KA = SC_QA + 18 * MiB, SC_EA = SC_KA + 36 * MiB, SC_KTA = SC_EA + 72 * MiB, SC_AEA = SC_KTA + 36 * MiB, SC_BEA = SC_AEA + 2 * MiB, SC_VTA = SC_BEA + 2 * MiB, SC_SPA = SC_VTA + 18 * MiB,
                 SC_QB = SC_SPA + 72 * MiB, SC_KB = SC_QB + 9 * MiB, SC_EB = SC_KB + 9 * MiB, SC_KTB = SC_EB + 36 * MiB, SC_AEB = SC_KTB + 18 * MiB, SC_BEB = SC_AEB + 1 * MiB, SC_VTB = SC_BEB + 1 * MiB, SC_SPB = SC_VTB + 18 * MiB, SC_END = SC_SPB + 36 * MiB;
static_assert(SC_END <= 400 * MiB, "scan scratch");
template <int DK> struct ScanBufs {
    bf16* Q;
    bf16* K;
    unsigned short* E;
    bf16* KT;
    float* AE;
    float* BE;
    bf16* VT;
    bf16* SP;
};
__device__ __forceinline__ ScanBufs<128> bufsA(unsigned char* ws) { unsigned char* s = ws + WS_SCAN; return ScanBufs<128>{(bf16*)(s + SC_QA), (bf16*)(s + SC_KA), (unsigned short*)(s + SC_EA), (bf16*)(s + SC_KTA), (float*)(s + SC_AEA), (float*)(s + SC_BEA), (bf16*)(s + SC_VTA), (bf16*)(s + SC_SPA)}; }
__device__ __forceinline__ ScanBufs<64> bufsB(unsigned char* ws) { unsigned char* s = ws + WS_SCAN; return ScanBufs<64>{(bf16*)(s + SC_QB), (bf16*)(s + SC_QB)  , (unsigned short*)(s + SC_EB), (bf16*)(s + SC_KTB), (float*)(s + SC_AEB), (float*)(s + SC_BEB), (bf16*)(s + SC_VTB), (bf16*)(s + SC_SPB)}; }
typedef _Float16 h2_t __attribute__((ext_vector_type(2)));
__device__ __forceinline__ unsigned pkh2(float a, float b) { const h2_t v = {(_Float16)a, (_Float16)b}; return __builtin_bit_cast(unsigned, v); }
__device__ __forceinline__ float hlo(unsigned w) { return (float)__builtin_bit_cast(h2_t, w)[0]; }
__device__ __forceinline__ float hhi(unsigned w) { return (float)__builtin_bit_cast(h2_t, w)[1]; }
__device__ __forceinline__ float ex2(float x) { return __builtin_amdgcn_exp2f(x); }
__device__ __forceinline__ float clampe(float x) { return __builtin_amdgcn_fmed3f(x, -115.f, 115.f); }
__device__ __forceinline__ float bfe(const v4u& w, int c) { return (c & 1) ? bfhi(w[c >> 1]) : bflo(w[c >> 1]); }
__device__ __forceinline__ float bfe2(const v2u& w, int c) { return (c & 1) ? bfhi(w[c >> 1]) : bflo(w[c >> 1]); }

template <int NC, int CPH> __device__ __forceinline__ void store_groups(LAS v4u* Wl, const v4u (&o)[NC], bf16* hb, size_t HS, int lane) {
#pragma unroll
    for (int c = 0; c < NC; ++c) Wl[lane * NC + c] = o[c];
    LDS_WAIT();
#pragma unroll
    for (int i = 0; i < NC; ++i) { const int sidx = i * 64 + lane; const v4u v = Wl[sidx]; *(GAS v4u*)(hb + (size_t)(sidx / CPH) * HS + (size_t)(sidx % CPH) * 8) = v; }
    LDS_WAIT();
}
template <int DIR> __device__ __forceinline__ void prep_hgrn_f(const ScanBufs<128>& A, const bf16* P, const float* LB, int g, int half, int lane, LAS v4u* Wl) {
    const int ch = half * 512 + 8 * lane, h = ch >> 7, d = ch & 127; const size_t row0 = (size_t)g * 64;
    const bf16* fp = P + row0 * NINP + (DIR ? PC_AFB : PC_AFF) + ch; const bf16* qp = P + row0 * NINP + PC_AQ + ch;
    float lb[8], cum[8];
    { const f32x4 a = *(const GAS f32x4*)(LB + DIR * 1024 + ch), b = *(const GAS f32x4*)(LB + DIR * 1024 + ch + 4);
#pragma unroll
      for (int c = 0; c < 4; ++c) { lb[c] = a[c]; lb[4 + c] = b[c]; } }
#pragma unroll
    for (int c = 0; c < 8; ++c) cum[c] = 1.f;
    unsigned short* Ep = A.E + ((size_t)DIR * MT + row0) * 1024 + ch; bf16* Kp = A.K + ((size_t)DIR * MT + row0) * 1024 + ch;
    bf16* kt = A.KT + (((((size_t)DIR * NCH + g) * 8 + half * 4) * 8) * 128) * 8;
    v4u fn[4], qn[4];
#pragma unroll
    for (int j = 0; j < 4; ++j) { fn[j] = *(const GAS v4u*)(fp + (size_t)((DIR ? 0 : 60) + j) * NINP); qn[j] = *(const GAS v4u*)(qp + (size_t)((DIR ? 0 : 60) + j) * NINP); }
    for (int i8 = 0; i8 < 8; ++i8) { const int t8 = DIR ? i8 : 7 - i8;
        float kp[8][8];
#pragma unroll
        for (int hh = 0; hh < 2; ++hh) { const int hf = DIR ? hh : 1 - hh;
            v4u f[4], qf[4];
#pragma unroll
            for (int j = 0; j < 4; ++j) { f[j] = fn[j]; qf[j] = qn[j]; }
            { const int hgn = 2 * i8 + hh + 1; if (hgn < 16) { const int tb = DIR ? 4 * hgn : 60 - 4 * hgn;
#pragma unroll
                for (int j = 0; j < 4; ++j) { fn[j] = *(const GAS v4u*)(fp + (size_t)(tb + j) * NINP); qn[j] = *(const GAS v4u*)(qp + (size_t)(tb + j) * NINP); } } }
#pragma unroll
            for (int jj = 0; jj < 4; ++jj) { const int j = DIR ? jj : 3 - jj; const int t = t8 * 8 + hf * 4 + j; float ev[8], kv[8];
#pragma unroll
                for (int c = 0; c < 8; ++c) { const float x = bfe(f[j], c); const float sg = sigmoidf_(x); const float a = lb[c] + (1.f - lb[c]) * sg; const float k = (1.f - lb[c]) * (1.f - sg);
                    const float xq = bfe(qf[j], c); const float qv = xq * sigmoidf_(xq) * 0.08838834764831845f;
                    const float D = cum[c]; cum[c] = D * a;
                    kv[c] = k * D; kp[hf * 4 + j][c] = kv[c]; ev[c] = qv * __builtin_amdgcn_rcpf(fmaxf(D, 1.1754944e-38f)); }
                { v4u ew; ew.x = pk2(ev[0], ev[1]); ew.y = pk2(ev[2], ev[3]); ew.z = pk2(ev[4], ev[5]); ew.w = pk2(ev[6], ev[7]); *(GAS v4u*)(Ep + (size_t)t * 1024) = ew; }
                v4u kw; kw.x = pk2(kv[0], kv[1]); kw.y = pk2(kv[2], kv[3]); kw.z = pk2(kv[4], kv[5]); kw.w = pk2(kv[6], kv[7]); *(GAS v4u*)(Kp + (size_t)t * 1024) = kw; } }
        { v4u og[8];
#pragma unroll
          for (int c = 0; c < 8; ++c) { og[c].x = pk2(kp[0][c], kp[1][c]); og[c].y = pk2(kp[2][c], kp[3][c]); og[c].z = pk2(kp[4][c], kp[5][c]); og[c].w = pk2(kp[6][c], kp[7][c]); }
          store_groups<8, 128>(Wl, og, kt + (size_t)t8 * 128 * 8, (size_t)8 * 128 * 8, lane); }
    }
    float* be = A.BE + (((size_t)DIR * NCH + g) * 8 + h) * 128 + d; float* ae = A.AE + (((size_t)DIR * NCH + g) * 8 + h) * 128 + d;
    (void)be;
    *(GAS f32x4*)ae = (f32x4){cum[0], cum[1], cum[2], cum[3]}; *(GAS f32x4*)(ae + 4) = (f32x4){cum[4], cum[5], cum[6], cum[7]};
}
template <int DIR> __device__ __forceinline__ void prep_gla_k(const ScanBufs<64>& B, const bf16* P, const float* w2g, const float* b2g, const f32x2* RR, const LAS f32x2* RC  , int g, int half, int lane, LAS v4u* Wl, LAS v4u* Gl  ) {
    const int ch = half * 256 + 4 * lane, h = ch >> 6, d = ch & 63; const size_t row0 = (size_t)g * 64;
    float w2[16][4];
#pragma unroll
    for (int r = 0; r < 16; ++r) { const f32x4 w = *(const GAS f32x4*)(w2g + ((size_t)DIR * 16 + r) * 512 + ch); w2[r][0] = w[0]; w2[r][1] = w[1]; w2[r][2] = w[2]; w2[r][3] = w[3]; }
    const f32x4 b2 = *(const GAS f32x4*)(b2g + (size_t)DIR * 512 + ch);
    const bool lat = g < 128; const int grow = g & 31; const int j0 = d & 15; const bool isrow = d < 32; const bool second = (d & 16) != 0;
    f32x2 csr[4];
#pragma unroll
    for (int c = 0; c < 4; ++c) csr[c] = RR[grow * 16 + j0 + c];
    float cum[4] = {0.f, 0.f, 0.f, 0.f};
    const bf16* kp0 = P + row0 * NINP + PC_BK + ch; const bf16* lp0 = P + row0 * NINP + PC_GK + 16 * DIR; const bf16* qp0 = P + row0 * NINP + PC_BQ + ch;
    unsigned short* Ep = B.E + ((size_t)DIR * MT + row0) * 512 + ch; bf16* Kp = B.K + ((size_t)DIR * MT + row0) * 512 + ch;
    bf16* kt = B.KT + (((((size_t)DIR * NCH + g) * 8 + half * 4) * 8) * 64) * 8;
    { const bf16* lp = lp0 + (size_t)lane * NINP; const v4u a = *(const GAS v4u*)lp, b = *(const GAS v4u*)(lp + 8); Gl[2 * lane] = a; Gl[2 * lane + 1] = b; }
    v2u krn[4], qrn[4];
#pragma unroll
    for (int j = 0; j < 4; ++j) { const size_t ro = (size_t)((DIR ? 0 : 60) + j) * NINP; krn[j] = *(const GAS v2u*)(kp0 + ro); qrn[j] = *(const GAS v2u*)(qp0 + ro); }
    LDS_WAIT();
    for (int i8 = 0; i8 < 8; ++i8) { const int t8 = DIR ? i8 : 7 - i8;
        float kp[8][4];
#pragma unroll
        for (int hh = 0; hh < 2; ++hh) { const int hf = DIR ? hh : 1 - hh;
            v2u kr[4], qr2[4]; v4u l0[4], l1[4];
#pragma unroll
            for (int j = 0; j < 4; ++j) { kr[j] = krn[j]; qr2[j] = qrn[j]; }
            { const int hgn = 2 * i8 + hh + 1; if (hgn < 16) { const int tb = DIR ? 4 * hgn : 60 - 4 * hgn;
#pragma unroll
                for (int j = 0; j < 4; ++j) { const size_t ro = (size_t)(tb + j) * NINP; krn[j] = *(const GAS v2u*)(kp0 + ro); qrn[j] = *(const GAS v2u*)(qp0 + ro); } } }
#pragma unroll
            for (int j = 0; j < 4; ++j) { const int tt_ = t8 * 8 + hf * 4 + j; l0[j] = Gl[2 * tt_]; l1[j] = Gl[2 * tt_ + 1]; }
#pragma unroll
            for (int jj = 0; jj < 4; ++jj) { const int j = DIR ? jj : 3 - jj; const int t = t8 * 8 + hf * 4 + j; float ev[4], kv[4];
                f32x2 csc[4];
                { const LAS f32x4* rc4 = (const LAS f32x4*)(RC + t * 16 + j0); const f32x4 ra = rc4[0], rb = rc4[1];
                  csc[0] = isrow ? csr[0] : (f32x2){ra[0], ra[1]}; csc[1] = isrow ? csr[1] : (f32x2){ra[2], ra[3]}; csc[2] = isrow ? csr[2] : (f32x2){rb[0], rb[1]}; csc[3] = isrow ? csr[3] : (f32x2){rb[2], rb[3]}; }
#pragma unroll
                for (int c = 0; c < 4; ++c) { float x = b2[c];
#pragma unroll
                    for (int r = 0; r < 8; ++r) { x += bfe(l0[j], r) * w2[r][c]; x += bfe(l1[j], r) * w2[8 + r][c]; }
                    const float la = (fminf(x, 0.f) * 1.4426950408889634f - __log2f(1.f + __expf(-fabsf(x)))) * 0.0625f;
                    float k = bfe2(kr[j], c), q = bfe2(qr2[j], c);
                    if (lat) { const f32x2 cs = csc[c]; const float pt = __shfl_xor(k, 4), pq = __shfl_xor(q, 4); k = k * cs.x + (second ? pt : -pt) * cs.y; q = q * cs.x + (second ? pq : -pq) * cs.y; }
                    const float e = cum[c]; cum[c] += la; kv[c] = k * ex2(e); kp[hf * 4 + j][c] = kv[c]; ev[c] = q * 0.125f * ex2(fminf(-e, 126.f)); }
                { v2u ew; ew.x = pk2(ev[0], ev[1]); ew.y = pk2(ev[2], ev[3]); *(GAS v2u*)(Ep + (size_t)t * 512) = ew; }
                { v2u kw; kw.x = pk2(kv[0], kv[1]); kw.y = pk2(kv[2], kv[3]); *(GAS v2u*)(Kp + (size_t)t * 512) = kw; } } }
        { v4u og[4];
#pragma unroll
          for (int c = 0; c < 4; ++c) { og[c].x = pk2(kp[0][c], kp[1][c]); og[c].y = pk2(kp[2][c], kp[3][c]); og[c].z = pk2(kp[4][c], kp[5][c]); og[c].w = pk2(kp[6][c], kp[7][c]); }
          store_groups<4, 64>(Wl, og, kt + (size_t)t8 * 64 * 8, (size_t)8 * 64 * 8, lane); }
    }
    float* be = B.BE + (((size_t)DIR * NCH + g) * 8 + h) * 64 + d; float* ae = B.AE + (((size_t)DIR * NCH + g) * 8 + h) * 64 + d;
    *(GAS f32x4*)be = (f32x4){cum[0], cum[1], cum[2], cum[3]}; *(GAS f32x4*)ae = (f32x4){ex2(cum[0]), ex2(cum[1]), ex2(cum[2]), ex2(cum[3])};
}
__device__ __forceinline__ void prep_vt(const bf16* P, int vcol, bf16* VT, int g, int half, int lane, LAS v4u* Wl) {
    const int ch = half * 512 + 8 * lane, h = ch >> 7, d = ch & 127; const size_t row0 = (size_t)g * 64; const bf16* vp = P + row0 * NINP + vcol + ch; bf16* vt = VT + ((((size_t)g * 8 + half * 4) * 8) * 128) * 8;
    for (int t8 = 0; t8 < 8; ++t8) { v4u f[8];
#pragma unroll
        for (int j = 0; j < 8; ++j) f[j] = *(const GAS v4u*)(vp + (size_t)(t8 * 8 + j) * NINP);
        v4u og[8];
#pragma unroll
        for (int c = 0; c < 8; ++c) {
#pragma unroll
            for (int q = 0; q < 4; ++q) { const unsigned a = f[2 * q][c >> 1], b = f[2 * q + 1][c >> 1]; og[c][q] = (c & 1) ? ((a >> 16) | (b & 0xffff0000u)) : ((a & 0xffffu) | (b << 16)); } }
        store_groups<8, 128>(Wl, og, vt + (size_t)t8 * 128 * 8, (size_t)8 * 128 * 8, lane); }
}
__device__ __forceinline__ void mixer_phase1(Frame& FF, int l) {
    Frame F = FF; F.lane = xb_lane(); F.tid = F.wave * 64 + F.lane;
    const bf16* P = (const bf16*)(F.ws + WS_P);
    const ScanBufs<128> A = bufsA(F.ws); const ScanBufs<64> B = bufsB(F.ws);
    const float* LB = (const float*)(F.ws + WS_TAB + TAB_LB) + (size_t)l * 2048;
    const f32x2* RR = (const f32x2*)(F.ws + WS_TAB + TAB_RR); const f32x2* RC = (const f32x2*)(F.ws + WS_TAB + TAB_RC);
    const int gw = F.vcu * NWAVES + F.wave, NGW = F.G * NWAVES;
    LAS v4u* Wl = (LAS v4u*)(F.lds + F.wave * 8192);
    LAS f32x2* RCl = (LAS f32x2*)(F.lds + 65536);
    { const v4u v = *(const GAS v4u*)((const char*)RC + F.tid * 16); *(LAS v4u*)((LAS unsigned char*)RCl + F.tid * 16) = v; }
    LDS_WAIT(); __syncthreads();
    LAS v4u* Gl = (LAS v4u*)(F.lds + 73728 + F.wave * 2048);
    constexpr int U_F = NCH * 4, U_K = NCH * 4, U_V = NCH * 4, U_QA = 0, U_QB = 0, U_ALL = U_F + U_K + U_V + U_QA + U_QB;
    int u0 = -1;
    const bool deal = (F.G == 256); if (deal) { const int w = F.wave, cu = F.vcu;
        if (w < 4) u0 = w * 256 + cu;
        else if (w == 4 && cu < 128) u0 = 1024 + cu;
        else { const int li = cu < 128 ? cu * 3 + (w - 5) : 384 + (cu - 128) * 4 + (w - 4); if (U_F + U_K + li < U_ALL) u0 = U_F + U_K + li; }
    }
    const int ustep = deal ? 1 : NGW; const int uend = deal ? 1 : U_ALL;
    for (int ui = deal ? 0 : gw; ui < uend; ui += ustep) { const int u = deal ? u0 : ui; if (u < 0) continue;
        int r = u; const int lane = xb_lane();
        if (r < U_F) { const int half = r & 1, dir = (r >> 1) & 1, g = r >> 2; if (dir == 0) prep_hgrn_f<0>(A, P, LB, g, half, lane, Wl); else prep_hgrn_f<1>(A, P, LB, g, half, lane, Wl); continue; } r -= U_F;
        if (r < U_K) { const int half = r & 1, dir = (r >> 1) & 1, g = r >> 2; const float* w2g = FIN(9) + (size_t)l * 2 * 16 * 512; const float* b2g = FIN(10) + (size_t)l * 2 * 512;
            if (dir == 0) prep_gla_k<0>(B, P, w2g, b2g, RR, RCl, g, half, lane, Wl, Gl); else prep_gla_k<1>(B, P, w2g, b2g, RR, RCl, g, half, lane, Wl, Gl); continue; } r -= U_K;
        if (r < U_V) { const int half = r & 1, mix = (r >> 1) & 1, g = r >> 2; if (mix == 0) prep_vt(P, PC_AI, A.VT, g, half, lane, Wl); else prep_vt(P, PC_BV, B.VT, g, half, lane, Wl); continue; } r -= U_V;
        if (r < U_QA) { const int half = r & 1, g = r >> 1; const int ch = half * 512 + 8 * lane; const size_t row0 = (size_t)g * 64;
            for (int t8 = 0; t8 < 8; ++t8) { v4u f[8];
#pragma unroll
                for (int j = 0; j < 8; ++j) f[j] = *(const GAS v4u*)(P + (row0 + t8 * 8 + j) * NINP + PC_AQ + ch);
#pragma unroll
                for (int j = 0; j < 8; ++j) { float q[8];
#pragma unroll
                    for (int c = 0; c < 8; ++c) { const float x = bfe(f[j], c); q[c] = x * sigmoidf_(x) * 0.08838834764831845f; }
                    v4u o; o.x = pk2(q[0], q[1]); o.y = pk2(q[2], q[3]); o.z = pk2(q[4], q[5]); o.w = pk2(q[6], q[7]); *(GAS v4u*)(A.Q + (row0 + t8 * 8 + j) * 1024 + ch) = o; } }
            continue; } r -= U_QA;
        { const int g = r; const int ch = 8 * lane, d = ch & 63; const size_t row0 = (size_t)g * 64;
          const bool lat = g < 128; const int grow = g & 31; const int j0 = d & 15; const bool isrow = d < 32; const bool second = (d & 16) != 0;
          f32x2 csr[8];
#pragma unroll
          for (int c = 0; c < 8; ++c) csr[c] = RR[grow * 16 + j0 + c];
          for (int t8 = 0; t8 < 8; ++t8) { v4u f[8];
#pragma unroll
              for (int j = 0; j < 8; ++j) f[j] = *(const GAS v4u*)(P + (row0 + t8 * 8 + j) * NINP + PC_BQ + ch);
#pragma unroll
              for (int j = 0; j < 8; ++j) { float q[8]; const int t = t8 * 8 + j;
#pragma unroll
                  for (int c = 0; c < 8; ++c) { float x = bfe(f[j], c);
                      if (lat) { const f32x2 cs = isrow ? csr[c] : RC[t * 16 + j0 + c]; const float pt = __shfl_xor(x, 2); x = x * cs.x + (second ? pt : -pt) * cs.y; }
                      q[c] = x * 0.125f; }
                  v4u o; o.x = pk2(q[0], q[1]); o.y = pk2(q[2], q[3]); o.z = pk2(q[4], q[5]); o.w = pk2(q[6], q[7]); *(GAS v4u*)(B.Q + (row0 + t) * 512 + ch) = o; } } }
    }
}

__device__ __forceinline__ int scan_chunk(int b, int dir, int s) { return s < 4 ? 128 + 4 * b + (dir ? 3 - s : s) : 32 * b + (dir ? 31 - (s - 4) : (s - 4)); }
template <int DK> struct P2Frag { bf16x8 a[4]; bf16x8 bv[2][4]; f32x4 ae[4]; };
template <int DK> __device__ __forceinline__ void p2_load(P2Frag<DK>& f, const ScanBufs<DK>& S, int dir, int g, int h, int dkb, int dvb, int r, int hi) {
    const bf16* kt = S.KT + (((((size_t)dir * NCH + g) * 8 + h) * 8 + hi) * DK + dkb * 32 + r) * 8;
    const bf16* vt = S.VT + ((((size_t)g * 8 + h) * 8 + hi) * 128 + dvb * 64 + r) * 8;
    const float* ae = S.AE + (((size_t)dir * NCH + g) * 8 + h) * DK + dkb * 32 + 4 * hi;
#pragma unroll
    for (int kk = 0; kk < 4; ++kk) { f.a[kk] = *(const GAS bf16x8*)(kt + (size_t)kk * 2 * DK * 8); f.bv[0][kk] = *(const GAS bf16x8*)(vt + (size_t)kk * 2 * 128 * 8); f.bv[1][kk] = *(const GAS bf16x8*)(vt + (size_t)kk * 2 * 128 * 8 + 32 * 8); f.ae[kk] = *(const GAS f32x4*)(ae + 8 * kk); }
}
template <int DK> __device__ __forceinline__ void scan_state_unit(const ScanBufs<DK>& S, int unit, int lane, bool skip_ctx_store) {
    constexpr int NKB = DK / 32;
    const int dvb = unit & 1, dkb = (unit >> 1) % NKB, rest = (unit >> 1) / NKB; const int dir = rest & 1, h = (rest >> 1) & 7, b = rest >> 4;
    const int r = lane & 31, hi = lane >> 5;
    f32x16 acc[2]; acc[0] = f32x16{}; acc[1] = f32x16{};
    P2Frag<DK> cur, nxt; p2_load<DK>(cur, S, dir, scan_chunk(b, dir, 0), h, dkb, dvb, r, hi);
    for (int s = 0; s < 36; ++s) {
        const int g = scan_chunk(b, dir, s);
        if (s + 1 < 36) p2_load<DK>(nxt, S, dir, scan_chunk(b, dir, s + 1), h, dkb, dvb, r, hi);
        if (!(skip_ctx_store && s < 4)) {
            bf16* sp = S.SP + (((((size_t)dir * NCH + g) * 8 + h) * (DK / 8) + dkb * 4) * 128 + dvb * 64 + r) * 8 + 4 * hi;
#pragma unroll
            for (int j = 0; j < 2; ++j)
#pragma unroll
                for (int q = 0; q < 4; ++q) { v2u o; o.x = pk2(acc[j][4 * q], acc[j][4 * q + 1]); o.y = pk2(acc[j][4 * q + 2], acc[j][4 * q + 3]); *(GAS v2u*)(sp + ((size_t)q * 128 + j * 32) * 8) = o; }
        }
#pragma unroll
        for (int j = 0; j < 2; ++j)
#pragma unroll
            for (int q = 0; q < 4; ++q)
#pragma unroll
                for (int i = 0; i < 4; ++i) acc[j][4 * q + i] *= cur.ae[q][i];
#pragma unroll
        for (int kk = 0; kk < 4; ++kk) { acc[0] = __builtin_amdgcn_mfma_f32_32x32x16_bf16(cur.a[kk], cur.bv[0][kk], acc[0], 0, 0, 0); acc[1] = __builtin_amdgcn_mfma_f32_32x32x16_bf16(cur.a[kk], cur.bv[1][kk], acc[1], 0, 0, 0); }
        cur = nxt;
    }
}

constexpr int P3_ALP = 144, P3_WBYTES = 4 * 32 * P3_ALP, P3_STP = 272;
static_assert(32 * P3_STP <= 2 * 32 * P3_ALP, "output staging fits a t block's score rows");
template <int DK> __device__ __forceinline__ void scan_out_wave(const ScanBufs<DK>& S, int g, int h, const bf16* P, int gcol, const float* gain, bf16* Y, LAS unsigned char* W, int lane) {
    const int r = lane & 31, hi = lane >> 5;
    constexpr int NK = DK / 16, HD = 8 * DK;
    const size_t row0 = (size_t)g * 64;
    const unsigned oRow = (unsigned)((r * HD + 8 * hi) * 2);
    const unsigned oGrp = (unsigned)(((hi * 128 + r) * 8) * 2);
    const unsigned oHi4 = (unsigned)(8 * hi * 4), oHi2 = (unsigned)(8 * hi * 2);
#define UB(base) ([&]() -> const char* { const char* b_ = (const char*)(base); asm volatile("" : "+s"(b_)); return b_; }())
#define LDV(ub, off) (*(const GAS v4u*)((ub) + (off)))
#define LD16(base, off) ([&]() -> v4u { const char* b_ = (const char*)(base); asm volatile("" : "+s"(b_)); return *(const GAS v4u*)(b_ + (off)); }())
#define LD16F(base, off) ([&]() -> f32x4 { const char* b_ = (const char*)(base); asm volatile("" : "+s"(b_)); return *(const GAS f32x4*)(b_ + (off)); }())
#define P3_BLOCK(ti, si, DIAG, KA, QA) do { f32x16 acc_ = f32x16{}; _Pragma("unroll") for (int kk = 0; kk < NK; ++kk) acc_ = __builtin_amdgcn_mfma_f32_32x32x16_bf16(__builtin_bit_cast(bf16x8, KA[kk]), __builtin_bit_cast(bf16x8, QA[kk]), acc_, 0, 0, 0); \
            if (DIAG) { _Pragma("unroll") for (int e = 0; e < 16; ++e) { const int sl_ = (e & 3) + 8 * (e >> 2) + 4 * hi; const bool keep_ = dir == 0 ? (sl_ <= r) : (sl_ >= r); acc_[e] = keep_ ? acc_[e] : 0.f; } } \
            LAS unsigned char* ap_ = W + (((ti) * 2 + dir) * 32 + r) * P3_ALP + (32 * (si) + 4 * hi) * 2; \
            _Pragma("unroll") for (int q = 0; q < 4; ++q) { v2u o_; o_.x = pk2(acc_[4 * q], acc_[4 * q + 1]); o_.y = pk2(acc_[4 * q + 2], acc_[4 * q + 3]); *(LAS v2u*)(ap_ + 16 * q) = o_; } } while (0)
#define P3_ZERO(ti, si) do { LAS unsigned char* ap_ = W + (((ti) * 2 + dir) * 32 + r) * P3_ALP + (32 * (si) + 4 * hi) * 2; _Pragma("unroll") for (int q = 0; q < 4; ++q) *(LAS v2u*)(ap_ + 16 * q) = (v2u){0u, 0u}; } while (0)
#pragma unroll
    for (int dir = 0; dir < 2; ++dir) {
        const char* Qh = (const char*)(S.E + ((size_t)dir * MT + row0) * HD + h * DK); const char* Ku = (const char*)(S.K + ((size_t)dir * MT + row0) * HD + h * DK);
        v4u ka0[NK], ka1[NK], qa0[NK], qa1[NK];
        { const char* k0_ = UB(Ku); const char* k1_ = UB(Ku + (size_t)32 * HD * 2); const char* q0_ = UB(Qh); const char* q1_ = UB(Qh + (size_t)32 * HD * 2);
#pragma unroll
          for (int kk = 0; kk < NK; ++kk) { ka0[kk] = LDV(k0_ + 32 * kk, oRow); qa0[kk] = LDV(q0_ + 32 * kk, oRow); }
#pragma unroll
          for (int kk = 0; kk < NK; ++kk) { ka1[kk] = LDV(k1_ + 32 * kk, oRow); qa1[kk] = LDV(q1_ + 32 * kk, oRow); } }
        P3_BLOCK(0, 0, true, ka0, qa0);
        if (dir == 0) { P3_BLOCK(1, 0, false, ka0, qa1); P3_ZERO(0, 1); } else { P3_BLOCK(0, 1, false, ka1, qa0); P3_ZERO(1, 0); }
        P3_BLOCK(1, 1, true, ka1, qa1);
    }
#undef P3_BLOCK
#undef P3_ZERO
    LDS_WAIT();
    const char* VTu = (const char*)(S.VT + (((size_t)g * 8 + h) * 8) * 128 * 8);
    for (int tt = 0; tt < 2; ++tt) {
        f32x16 acc[4];
#pragma unroll
        for (int dvt = 0; dvt < 4; ++dvt) acc[dvt] = f32x16{};
        const LAS unsigned char* Wt = W + (size_t)tt * 2 * 32 * P3_ALP;
        const int tl = lane >> 3, seg = lane & 7; const size_t rowt = row0 + 32 * tt;
        const char* Gu = (const char*)(P + rowt * NINP + gcol + h * 128); const unsigned og = (unsigned)((tl * NINP + seg * 8) * 2);
        struct Raw8 { v4u x[8]; }; Raw8 A0, A1;
        constexpr int NST = 2 * (2 + NK);
#define P3_SLOAD(R, st) do { constexpr int dir_ = (st) / (2 + NK), j_ = (st) % (2 + NK); \
            if ((st) >= NST) { _Pragma("unroll") for (int j = 0; j < 8; ++j) { const char* gb_ = UB(Gu + ((size_t)(8 * (j >> 1)) * NINP + (j & 1) * 64) * 2); R.x[j] = LDV(gb_, og); } } \
            else if (j_ < 2) { _Pragma("unroll") for (int k2 = 0; k2 < 2; ++k2) { const char* vb_ = UB(VTu + (size_t)(2 * j_ + k2) * 2 * 128 * 16); _Pragma("unroll") for (int dvt = 0; dvt < 4; ++dvt) R.x[k2 * 4 + dvt] = LDV(vb_ + 32 * dvt * 16, oGrp); } } \
            else { constexpr int kk_ = j_ - 2; const char* sb_ = UB((const char*)(S.SP + ((((size_t)dir_ * NCH + g) * 8 + h) * (DK / 8)) * 128 * 8) + (size_t)kk_ * 2 * 128 * 16); \
                const char* qb_ = UB((const char*)(S.E + ((size_t)dir_ * MT + rowt) * HD + h * DK) + 32 * kk_); const char* bb_ = UB((const char*)(S.AE + (((size_t)dir_ * NCH + g) * 8 + h) * DK) + 64 * kk_); \
                _Pragma("unroll") for (int dvt = 0; dvt < 4; ++dvt) R.x[dvt] = LDV(sb_ + 32 * dvt * 16, oGrp); \
                R.x[4] = LDV(qb_, oRow); R.x[5] = R.x[4]; R.x[6] = LDV(bb_, oHi4); R.x[7] = LDV(bb_ + 16, oHi4); } \
            __builtin_amdgcn_sched_barrier(0); } while (0)
#define P3_SCOMP(R, st) do { constexpr int dir_ = (st) / (2 + NK), j_ = (st) % (2 + NK); \
            if (j_ < 2) { const LAS unsigned char* ap_ = Wt + (dir_ * 32 + r) * P3_ALP + (8 * hi) * 2; \
                _Pragma("unroll") for (int k2 = 0; k2 < 2; ++k2) { const bf16x8 af_ = *(const LAS bf16x8*)(ap_ + 32 * (2 * j_ + k2)); \
                    _Pragma("unroll") for (int dvt = 0; dvt < 4; ++dvt) acc[dvt] = __builtin_amdgcn_mfma_f32_32x32x16_bf16(__builtin_bit_cast(bf16x8, R.x[k2 * 4 + dvt]), af_, acc[dvt], 0, 0, 0); } } \
            else { const v4u qw_ = R.x[4]; const f32x4 b0_ = __builtin_bit_cast(f32x4, R.x[6]), b1_ = __builtin_bit_cast(f32x4, R.x[7]); v4u qa_;     \
                qa_.x = pk2(bflo(qw_.x) * b0_[0], bfhi(qw_.x) * b0_[1]); qa_.y = pk2(bflo(qw_.y) * b0_[2], bfhi(qw_.y) * b0_[3]); qa_.z = pk2(bflo(qw_.z) * b1_[0], bfhi(qw_.z) * b1_[1]); qa_.w = pk2(bflo(qw_.w) * b1_[2], bfhi(qw_.w) * b1_[3]); \
                _Pragma("unroll") for (int dvt = 0; dvt < 4; ++dvt) acc[dvt] = __builtin_amdgcn_mfma_f32_32x32x16_bf16(__builtin_bit_cast(bf16x8, R.x[dvt]), __builtin_bit_cast(bf16x8, qa_), acc[dvt], 0, 0, 0); } \
            __builtin_amdgcn_sched_barrier(0); } while (0)
#define P3_STEP2(st) do { P3_SLOAD(A1, (st) + 1); P3_SCOMP(A0, (st)); P3_SLOAD(A0, (st) + 2); P3_SCOMP(A1, (st) + 1); } while (0)
        P3_SLOAD(A0, 0);
        P3_STEP2(0); P3_STEP2(2); P3_STEP2(4); P3_STEP2(6); P3_STEP2(8); P3_STEP2(10);
        if (NK == 8) { P3_STEP2(12); P3_STEP2(14); P3_STEP2(16); P3_STEP2(18); }
#undef P3_SLOAD
#undef P3_SCOMP
#undef P3_STEP2
        float ss = 0.f;
#pragma unroll
        for (int dvt = 0; dvt < 4; ++dvt)
#pragma unroll
            for (int e = 0; e < 16; ++e) ss += acc[dvt][e] * acc[dvt][e];
        ss += __shfl_xor(ss, 32);
        const float rstd = 1.0f / sqrtf(ss * (1.f / 128.f) + RMS_EPS);
        LAS unsigned char* st = W + (size_t)tt * 2 * 32 * P3_ALP;
#pragma unroll
        for (int dvt = 0; dvt < 4; ++dvt)
#pragma unroll
            for (int q = 0; q < 4; ++q) { v2u o; o.x = pk2(acc[dvt][4 * q] * rstd, acc[dvt][4 * q + 1] * rstd); o.y = pk2(acc[dvt][4 * q + 2] * rstd, acc[dvt][4 * q + 3] * rstd); *(LAS v2u*)(st + r * P3_STP + (32 * dvt + 8 * q + 4 * hi) * 2) = o; }
        LDS_WAIT();
        { char* Yu = (char*)(Y + rowt * 1024 + h * 128); const unsigned oy = (unsigned)((tl * 1024 + seg * 8) * 2);
#pragma unroll
          for (int j = 0; j < 8; ++j) { const int rr = 8 * (j >> 1), hf = j & 1; const v4u ow = *(const LAS v4u*)(st + (tl + rr) * P3_STP + hf * 128 + seg * 16); const v4u gw = A0.x[j];
              const float* gn = gain + hf * 64 + seg * 8; const f32x4 n0 = *(const GAS f32x4*)gn, n1 = *(const GAS f32x4*)(gn + 4); v4u y;
#pragma unroll
              for (int c = 0; c < 4; ++c) { const float z0 = bflo(gw[c]), z1 = bfhi(gw[c]); const float na = c < 2 ? n0[2 * c] : n1[2 * c - 4], nb = c < 2 ? n0[2 * c + 1] : n1[2 * c - 3];
                  y[c] = pk2(bflo(ow[c]) * na * z0 * sigmoidf_(z0), bfhi(ow[c]) * nb * z1 * sigmoidf_(z1)); }
              *(GAS v4u*)(Yu + oy + ((size_t)rr * 1024 + hf * 64) * 2) = y; } }
        LDS_WAIT();
    }
#undef LD16
#undef LD16F
#undef UB
#undef LDV
}
__device__ __forceinline__ void mixer_phase3(Frame& FF, int l) {
    Frame F = FF; F.lane = xb_lane(); F.tid = F.wave * 64 + F.lane; const int lane = F.lane;
    const bf16* P = (const bf16*)(F.ws + WS_P); bf16* Y = (bf16*)(F.ws + WS_Y);
    const ScanBufs<128> A = bufsA(F.ws); const ScanBufs<64> B = bufsB(F.ws);
    const int nch = (l == DEPTH - 1) ? 128 : NCH;
    const int nu = nch * 8;
    LAS unsigned char* W = F.lds + F.wave * P3_WBYTES;
    const int NGW = F.G * NWAVES; const int gw0 = F.wave * F.G + F.vcu; const int gw1 = (F.G == 256) ? ((F.wave == 5) ? NGW + F.vcu : 2 * nu) : gw0 + NGW;
    for (int ui = 0; ui < 16; ++ui) { const int u = ui == 0 ? gw0 : (F.G == 256 ? (ui == 1 ? gw1 : 2 * nu) : gw0 + ui * NGW); if (u >= 2 * nu) break;
        const int ln = xb_lane();
        if (u < nu) scan_out_wave<128>(A, u >> 3, u & 7, P, PC_AG, FIN(8) + l * 128, Y, W, ln);
        else { const int v = u - nu; scan_out_wave<64>(B, v >> 3, v & 7, P, PC_BG, FIN(11) + l * 128, Y + (size_t)MT * 1024, W, ln); }
    }
}
namespace nat {
using s16x4 = __attribute__((ext_vector_type(4))) short; using u32x4 = __attribute__((ext_vector_type(4))) unsigned;
#define KSWZ(row, colB) ((row) * 256 + ((colB) ^ (((row) & 7) << 4)))
#define SBAR() __builtin_amdgcn_sched_barrier(0)
__device__ __forceinline__ int crow(int r, int hi) { return (r & 3) + 8 * (r >> 2) + 4 * hi; }
__device__ __forceinline__ unsigned cvtpk(float lo, float hi) {
  unsigned r; asm volatile("v_cvt_pk_bf16_f32 %0, %1, %2" : "=v"(r) : "v"(lo), "v"(hi)); return r;
}
__device__ __forceinline__ void finishSM(f32x16& p0, f32x16& p1, float alpha, float& l_reg, bf16x8& pa0, bf16x8& pa1, bf16x8& pa2, bf16x8& pa3) {
  for (int r = 0; r < 16; ++r) p1[r] = __builtin_amdgcn_exp2f(p1[r]);
  float ps = 0; for (int r = 0; r < 16; ++r) ps += p0[r]; for (int r = 0; r < 16; ++r) ps += p1[r];
  { auto rr = __builtin_amdgcn_permlane32_swap(__float_as_uint(ps), __float_as_uint(ps), false, false);
    ps = __uint_as_float(rr[0]) + __uint_as_float(rr[1]); }
  l_reg = l_reg * alpha + ps;
#define PK4(P, BASE, OUT) do { unsigned a0 = cvtpk(P[BASE + 0], P[BASE + 1]), a1 = cvtpk(P[BASE + 2], P[BASE + 3]);   \
    unsigned b0 = cvtpk(P[BASE + 4], P[BASE + 5]), b1 = cvtpk(P[BASE + 6], P[BASE + 7]);                              \
    auto r0 = __builtin_amdgcn_permlane32_swap(a0, b0, false, false); auto r1 = __builtin_amdgcn_permlane32_swap(a1, b1, false, false); \
    u32x4 w = {r0[0], r1[0], r0[1], r1[1]}; OUT = *reinterpret_cast<bf16x8*>(&w); } while (0)
  PK4(p0, 0, pa0); PK4(p0, 8, pa1); PK4(p1, 0, pa2); PK4(p1, 8, pa3);
#undef PK4
}
__device__ __forceinline__ void qkt(f32x16& p0, f32x16& p1, const bf16* Ks, const bf16x8* qr, int r32, int hi) {
  p0 = f32x16{}; p1 = f32x16{};
  for (int d0 = 0; d0 < 8; ++d0) { int cb = (d0 * 16 + hi * 8) * 2;
    bf16x8 b0 = *reinterpret_cast<const bf16x8*>((const char*)Ks + KSWZ(r32, cb));
    bf16x8 b1 = *reinterpret_cast<const bf16x8*>((const char*)Ks + KSWZ(32 + r32, cb));
    p0 = __builtin_amdgcn_mfma_f32_32x32x16_bf16(b0, qr[d0], p0, 0, 0, 0);
    p1 = __builtin_amdgcn_mfma_f32_32x32x16_bf16(b1, qr[d0], p1, 0, 0, 0); }
}
__device__ __forceinline__ int v_st(int k, int c) { const int kk = (k & ~0xC) | ((k & 4) << 1) | ((k & 8) >> 1); return ((kk >> 3) * 4 + (c >> 5)) * 512 + ((kk & 7) * 32 + (c & 31)) * 2; }
__device__ __forceinline__ int v_rd_base(int lane) { return ((lane & 3) << 3) | (((lane >> 2) & 3) << 6) | (((lane >> 4) & 1) << 5) | (((lane >> 5) & 1) << 8); }
constexpr int v_rd_off(int d0, int ks, int half) { return d0 * 512 + ks * 4096 + half * 2048; }
template <int OFF> __device__ __forceinline__ s16x4 tr_read(int vb) {
  s16x4 r; asm volatile("ds_read_b64_tr_b16 %0, %1 offset:%2" : "=&v"(r) : "v"(vb), "i"(OFF) : "memory"); return r;
}
template <int D0> __device__ __forceinline__ void pv_one(f32x16& od, int vb, bf16x8 pa0, bf16x8 pa1, bf16x8 pa2, bf16x8 pa3) {
  const s16x4 l0 = tr_read<v_rd_off(D0, 0, 0)>(vb), h0 = tr_read<v_rd_off(D0, 0, 1)>(vb), l1 = tr_read<v_rd_off(D0, 1, 0)>(vb), h1 = tr_read<v_rd_off(D0, 1, 1)>(vb);
  const s16x4 l2 = tr_read<v_rd_off(D0, 2, 0)>(vb), h2 = tr_read<v_rd_off(D0, 2, 1)>(vb), l3 = tr_read<v_rd_off(D0, 3, 0)>(vb), h3 = tr_read<v_rd_off(D0, 3, 1)>(vb);
  asm volatile("s_waitcnt lgkmcnt(0)" ::: "memory"); SBAR();
#define PK(L, H) (bf16x8){L[0], L[1], L[2], L[3], H[0], H[1], H[2], H[3]}
  od = __builtin_amdgcn_mfma_f32_32x32x16_bf16(pa0, PK(l0, h0), od, 0, 0, 0);
  od = __builtin_amdgcn_mfma_f32_32x32x16_bf16(pa1, PK(l1, h1), od, 0, 0, 0);
  od = __builtin_amdgcn_mfma_f32_32x32x16_bf16(pa2, PK(l2, h2), od, 0, 0, 0);
  od = __builtin_amdgcn_mfma_f32_32x32x16_bf16(pa3, PK(l3, h3), od, 0, 0, 0);
#undef PK
}
__device__ __forceinline__ void pv_d0(f32x16* o, int vb, bf16x8 pa0, bf16x8 pa1, bf16x8 pa2, bf16x8 pa3) {
  pv_one<0>(o[0], vb, pa0, pa1, pa2, pa3); pv_one<1>(o[1], vb, pa0, pa1, pa2, pa3); pv_one<2>(o[2], vb, pa0, pa1, pa2, pa3); pv_one<3>(o[3], vb, pa0, pa1, pa2, pa3);
}

constexpr int SHM_V = 64 * 128 * 2, SHM_K = 64 * 128 * 2, SHM_ATTN = 2 * SHM_V + 2 * SHM_K + 8 * 64 * 4;
constexpr int NAT_TAB = SHM_ATTN, NAT_TABW = 128, NAT_MISC = NAT_TAB + 15 * NAT_TABW * 4, NAT_LDS = NAT_MISC + 16;
constexpr float C2 = 0.088388347648318440f * 1.4426950408889634f;
constexpr float THR2 = 8.f * 1.4426950408889634f;
constexpr float NEGB = -1e30f;
template <bool WIN> __device__ __forceinline__ void partialSM(f32x16& p0, f32x16& p1, float& m_reg, float& mn, float& alpha, bool rowok, const float* tb, int t0) {
  if (WIN) {
    if (rowok) {
#pragma unroll
      for (int r = 0; r < 16; ++r) { const int cr = (r & 3) + 8 * (r >> 2);
        const float b0 = tb[cr], b1 = tb[cr + 32];
        p0[r] = ((unsigned)(cr + t0) < 16u) ? fmaf(p0[r], C2, b0) : NEGB;
        p1[r] = ((unsigned)(cr + 32 + t0) < 16u) ? fmaf(p1[r], C2, b1) : NEGB; }
    } else {
#pragma unroll
      for (int r = 0; r < 16; ++r) { p0[r] = NEGB; p1[r] = NEGB; }
    }
  } else {
#pragma unroll
    for (int r = 0; r < 16; ++r) { p0[r] *= C2; p1[r] *= C2; }
  }
  float pmax = p0[0];
#pragma unroll
  for (int r = 1; r < 16; ++r) pmax = fmaxf(pmax, p0[r]);
#pragma unroll
  for (int r = 0; r < 16; ++r) pmax = fmaxf(pmax, p1[r]);
  { auto rr = __builtin_amdgcn_permlane32_swap(__float_as_uint(pmax), __float_as_uint(pmax), false, false);
    pmax = fmaxf(__uint_as_float(rr[0]), __uint_as_float(rr[1])); }
  if (__builtin_expect(__all(pmax - m_reg <= THR2), 1)) { mn = m_reg; alpha = 1.f; }
  else { mn = fmaxf(m_reg, pmax); alpha = __builtin_amdgcn_exp2f(m_reg - mn); m_reg = mn; }
#pragma unroll
  for (int r = 0; r < 16; ++r) { p0[r] -= mn; p1[r] -= mn; }
#pragma unroll
  for (int r = 0; r < 16; ++r) p0[r] = __builtin_amdgcn_exp2f(p0[r]);
}
__device__ __forceinline__ void natten_unit(const bf16* __restrict__ P, bf16* __restrict__ Y, const float* __restrict__ rpbh, long qrow0, long crow0, long wrow0, int h, int NT, bool win, int r0, int ws0, char* lds, int tid) {
  const int wid = __builtin_amdgcn_readfirstlane(tid >> 6), lane = tid & 63, r32 = lane & 31, hi = lane >> 5;
  bf16* V_lds = (bf16*)lds; bf16* K_lds = (bf16*)(lds + 2 * SHM_V);
  float* ws = (float*)(lds + 2 * SHM_V + 2 * SHM_K) + wid * 64; float* li_l = ws; float* al_l = ws + 32;
  float* tab = (float*)(lds + NAT_TAB);
  __syncthreads();
  if (win) { for (int i = tid; i < 15 * NAT_TABW; i += 512) { const int dr = i >> 7, dc = (i & 127) - 48; tab[i] = (dc >= 0 && dc <= 30) ? rpbh[dr * 31 + dc] * 1.4426950408889634f : 0.f; } }
  float m_reg = -1e30f, l_reg = 0; f32x16 o[4] = {}; bf16x8 qr[8];
  { const char* Qb = (const char*)(P + (size_t)(qrow0 + wid * 32) * NINP + PC_CQ + h * 128); const unsigned qoff = (unsigned)((r32 * NINP + hi * 8) * 2);
#pragma unroll
    for (int d0 = 0; d0 < 8; ++d0) qr[d0] = *(const GAS bf16x8*)(Qb + qoff + d0 * 32); }
  const int sr = tid >> 4, sc = (tid & 15) * 8, vst0 = v_st(sr, sc), vst1 = v_st(32 + sr, sc);
  const int vb0 = (int)(uintptr_t)V_lds + v_rd_base(lane);
  const unsigned kvoff = (unsigned)((sr * NINP + h * 128 + sc) * 2);
  const char* Pk = (const char*)(P + PC_CK); const char* Pv = (const char*)(P + PC_CV);
  const int qgr = r0 + (wid >> 1), qc = 32 * (wid & 1) + r32;
  const int rs = min(max(qgr - 4, 0), 24), cs = min(max(qc - 8, 0), 48);
  const int t0 = 4 * hi - cs; const float* tbl = tab + 63 - qc + 4 * hi;
  bf16x8 vs0, vs1, ks0, ks1;
#define TROW(t) ((t) < 4 ? crow0 + 64 * (t) : wrow0 + 64 * ((t) - 4))
#define SLOAD(t) do { const size_t rb_ = (size_t)(TROW(t)) * (NINP * 2); const char* kb_ = Pk + rb_; const char* vb_ = Pv + rb_; \
    vs0 = *(const GAS bf16x8*)(vb_ + kvoff); vs1 = *(const GAS bf16x8*)(vb_ + (size_t)32 * NINP * 2 + kvoff); \
    ks0 = *(const GAS bf16x8*)(kb_ + kvoff); ks1 = *(const GAS bf16x8*)(kb_ + (size_t)32 * NINP * 2 + kvoff); } while (0)
#define SWRITE(b) do { *(bf16x8*)((char*)V_lds + (b) * SHM_V + vst0) = vs0; *(bf16x8*)((char*)V_lds + (b) * SHM_V + vst1) = vs1; const int kc = sc * 2; \
    *(bf16x8*)((char*)K_lds + (b) * SHM_K + KSWZ(sr, kc)) = ks0; *(bf16x8*)((char*)K_lds + (b) * SHM_K + KSWZ(32 + sr, kc)) = ks1; } while (0)
#define RESC(a) do { if (__any((a) < 1.f)) { if (hi == 0) al_l[r32] = (a); asm volatile("s_waitcnt lgkmcnt(0)" ::: "memory"); \
    for (int d = 0; d < 4; ++d) for (int r = 0; r < 16; ++r) o[d][r] *= al_l[crow(r, hi)]; } } while (0)
  f32x16 p0, p1; float mn, al; bf16x8 pa0, pa1, pa2, pa3;
  SLOAD(0); asm volatile("s_waitcnt vmcnt(0)" ::: "memory"); SWRITE(0); SLOAD(1);
  for (int t = 0; t < NT; ++t) {
    const int buf = t & 1;
    asm volatile("s_waitcnt lgkmcnt(0)" ::: "memory"); __syncthreads();
    if (t + 1 < NT) { asm volatile("s_waitcnt vmcnt(0)" ::: "memory"); SWRITE(buf ^ 1); if (t + 2 < NT) SLOAD(t + 2); }
    const int kr_ = ws0 + t - 4; const bool wtile = win && t >= 4; const bool ok_ = (unsigned)(kr_ - rs) < 8u;
    if (!wtile || ok_) {
        SBAR(); qkt(p0, p1, (bf16*)((char*)K_lds + buf * SHM_K), qr, r32, hi);
        if (!wtile) partialSM<false>(p0, p1, m_reg, mn, al, true, tbl, t0);
        else { const int dr_ = min(max(kr_ - qgr + 7, 0), 14); partialSM<true>(p0, p1, m_reg, mn, al, true, tbl + dr_ * NAT_TABW, t0); }
        finishSM(p0, p1, al, l_reg, pa0, pa1, pa2, pa3); SBAR();
        RESC(al);
        pv_d0(o, vb0 + buf * (int)SHM_V, pa0, pa1, pa2, pa3);
    }
  }
  if (hi == 0) li_l[r32] = l_reg; asm volatile("s_waitcnt lgkmcnt(0)" ::: "memory");
  float rli[16];
#pragma unroll
  for (int r = 0; r < 16; ++r) rli[r] = __builtin_amdgcn_rcpf(li_l[crow(r, hi)]);
  char* Ob = (char*)(Y + (size_t)(qrow0 + wid * 32) * 1024 + h * 128); const unsigned ooff = (unsigned)((4 * hi * 1024 + r32) * 2);
#pragma unroll
  for (int r = 0; r < 16; ++r) { const int orow = (r & 3) + 8 * (r >> 2);
#pragma unroll
    for (int d0 = 0; d0 < 4; ++d0) *(GAS bf16*)(Ob + ooff + (orow * 1024 + d0 * 32) * 2) = (bf16)f2bf(o[d0][r] * rli[r]); }
  asm volatile("s_waitcnt vmcnt(0)" ::: "memory");
#undef TROW
#undef SLOAD
#undef SWRITE
#undef RESC
}
}

__device__ __forceinline__ void mixer_phase2(Frame& FF, int l, int rep) {
    Frame F = FF; F.lane = xb_lane(); F.tid = F.wave * 64 + F.lane; const int lane = F.lane, tid = F.tid;
    { const ScanBufs<128> A = bufsA(F.ws); const ScanBufs<64> B = bufsB(F.ws);
      const int gw = F.vcu * NWAVES + F.wave; const bool lastl = (l == DEPTH - 1);
      if (gw < 512) scan_state_unit<128>(A, gw, lane, lastl);
      else if (gw < 768) scan_state_unit<64>(B, gw - 512, lane, lastl); }
    const bf16* P = (const bf16*)(F.ws + WS_P); bf16* Y = (bf16*)(F.ws + WS_Y) + (size_t)2 * MT * 1024;
    const float* rpb = FIN(12) + (size_t)l * 8 * 15 * 31;
    const int total = (l == DEPTH - 1) ? 256 : 288;
    volatile LAS unsigned* slot = (volatile LAS unsigned*)(F.lds + nat::NAT_MISC);
    gu32* qhead = F.ctl + CW_QUEUE + 64 * (l + 4 * rep);
    for (;;) {
        __syncthreads();
        if (tid == 0) *slot = __hip_atomic_fetch_add(qhead, 1u, RLX_AGENT);
        __syncthreads();
        const int idx = (int)__builtin_amdgcn_readfirstlane(*slot);
        if (idx >= total) break;
        if (idx < 256) { int bh, r0;
            if (idx < 192) { bh = idx / 6; r0 = 4 + 4 * (idx % 6); } else { const int i = idx - 192; bh = i >> 1; r0 = (i & 1) ? 28 : 0; }
            const int b = bh >> 3, h = bh & 7; const int ws0 = (r0 == 0) ? 0 : (r0 == 28 ? 24 : min(r0 - 4, 20)); const int nwin = (r0 == 0 || r0 == 28) ? 8 : 12;
            nat::natten_unit(P, Y, rpb + h * 15 * 31, (long)b * 2048 + 64 * r0, (long)ML + b * 256, (long)b * 2048 + 64 * ws0, h, 4 + nwin, true, r0, ws0, (char*)F.lds, tid);
        } else { const int bh = idx - 256, b = bh >> 3, h = bh & 7;
            nat::natten_unit(P, Y, rpb, (long)ML + b * 256, (long)ML + b * 256, 0, h, 4, false, 0, 0, (char*)F.lds, tid); }
    }
}


#ifndef WGM_IN
#define WGM_IN 4
#endif
#ifndef WGM_BR
#define WGM_BR 4
#endif
#ifndef WGM_OUT
#define WGM_OUT 4
#endif
#ifndef WGM_M1
#define WGM_M1 4
#endif
#ifndef WGM_M2
#define WGM_M2 2
#endif
constexpr int NPH_PRE = 3, NPH_LAYER = 10, NPH = NPH_PRE + DEPTH * NPH_LAYER;
struct Args { const float* in[21]; float* out; unsigned char* ws; int ph_lo, ph_hi, use_bar, pad; };
__global__ void __launch_bounds__(NWAVES * 64, 2) fwd_kernel(Args args) {
    extern __shared__ __attribute__((aligned(16))) unsigned char lds[];
    Frame F;
    F.lds = (LAS unsigned char*)lds;
    F.MISC = (volatile LAS unsigned*)(F.lds + MISC_OFF);
    F.wave = __builtin_amdgcn_readfirstlane((int)threadIdx.x >> 6); F.lane = xb_lane(); F.tid = F.wave * 64 + F.lane;
    F.G = gridDim.x; { const int bx = blockIdx.x; F.vcu = (F.G % 8 == 0) ? (bx % 8) * (F.G / 8) + bx / 8 : bx; }
    F.ws = args.ws; F.ctl = (gu32*)(args.ws + WS_CTL); F.out = args.out;
    F.kin = (kin_t)__builtin_amdgcn_kernarg_segment_ptr();
    for (int u = F.tid; u < (LDS_BYTES - LDSCTL_OFF) / 4; u += NWAVES * 64) ((LAS unsigned*)(F.lds + LDSCTL_OFF))[u] = 0u;
    __syncthreads();
    const bool use_bar = args.use_bar != 0;
    XcdBarrier bar; bar.bar = (unsigned*)(F.ctl + CW_BAR); bar.x = 0; bar.st = nullptr; bar.wave = F.wave;
    if (use_bar) bar = xcd_barrier_post((unsigned*)(F.ctl + CW_BAR), F.MISC + 8);
    const int lo = args.ph_lo, hi = args.ph_hi;
#define IN(k) (lo <= (k) && (k) < hi)
#ifndef REP_KIND
#define REP_KIND -1
#endif
#define RUN(kind, ...) do { _Pragma("nounroll") for (int rep_ = 0; rep_ < ((REP_KIND == (kind)) ? 2 : 1); ++rep_) { __VA_ARGS__; } } while (0)
#define SEAM(k) do { if (IN((k) + 1)) { if (use_bar) { xcd_barrier(bar); if (REP_KIND == 9) xcd_barrier(bar); } else if (F.tid == 0) __hip_atomic_store(F.ctl + CW_TMO, 0xBADBA0u, RLX_AGENT); } } while (0)
    unsigned char* ws = args.ws;
    if (IN(0)) { RUN(0, p0_prologue(F)); SEAM(0); }
    if (IN(1)) { p0b_modreduce(F); SEAM(1); }
    if (IN(2)) { p0c_modulate(F); SEAM(2); }
    for (int l = 0; l < DEPTH; ++l) {
        const int pb = NPH_PRE + l * NPH_LAYER;
        const bool lastl = (l == DEPTH - 1);
        const int Mg = lastl ? ML : MT;
        if (IN(pb + 0)) {
            RUN(1, { pg8::Gemm g{(const bf16*)(ws + WS_H), (const bf16*)(ws + WS_WIN) + (size_t)l * NINP * 2048, MT, NINP, 2048, 0, 0, 2048, 2048}; pg8::StaticOrder S; S.init(MT, NINP, F.G, (int)blockIdx.x, WGM_IN);
            pg8::EpiBf16<0> E{(bf16*)(ws + WS_P), NINP, 0};
            pg8::gemm_phase<pg8::EpiBf16<0>, pg8::StaticOrder, true, true>(F.lds + RING_OFF, g, S, E, F.wave); });
            if (F.G == 256) convert_pocket(F, l + 1, CV_P0, CV_P1, (MT / 256) * (NINP / 256) - 9 * 256);
            SEAM(pb + 0);
        }
        if (IN(pb + 1)) { RUN(2, mixer_phase1(F, l)); SEAM(pb + 1); }
        if (IN(pb + 2)) { mixer_phase2(F, l, 0); if (REP_KIND == 3) mixer_phase2(F, l, 1); SEAM(pb + 2); }
        if (IN(pb + 3)) { RUN(4, mixer_phase3(F, l)); SEAM(pb + 3); }
        if (IN(pb + 4)) {
            RUN(5, { pg8::Gemm g{(const bf16*)(ws + WS_Y), (const bf16*)(ws + WS_WBR) + (size_t)l * 3 * 2048 * 1024, ML, 2048, 1024, (size_t)MT * 1024 * 2, (size_t)2048 * 1024 * 2, 1024, 1024}; pg8::SlabOrder<3> S; S.init(ML, 2048, F.G, (int)blockIdx.x, WGM_BR);
            pg8::EpiGate<true> E{(bf16*)(ws + WS_U), 2048, (const bf16*)(ws + WS_P) + PC_GT, NINP, 0};
            pg8::gemm_phase<pg8::EpiGate<true>, pg8::SlabOrder<3>, true, true>(F.lds + RING_OFF, g, S, E, F.wave);
            if (!lastl) { pg8::Gemm g2 = g; g2.M = MC; pg8::SplitKOrder<1, 3> S2; S2.init(MC, 2048, F.G, (int)blockIdx.x, ML / 256, 1024);
                pg8::EpiGate<false> E2{(bf16*)(ws + WS_UC) - (size_t)ML * 2048, 2048, (const bf16*)(ws + WS_P) + PC_GT, NINP, (size_t)MC * 2048};
                pg8::gemm_phase<pg8::EpiGate<false>, pg8::SplitKOrder<1, 3>, true, true>(F.lds + RING_OFF, g2, S2, E2, F.wave); } });
            if (F.G == 256 && !lastl) convert_pocket(F, l + 1, CV_P1, CV_P2, 96);
            SEAM(pb + 4);
        }
        if (IN(pb + 5)) {
            RUN(6, { pg8::Gemm g{(const bf16*)(ws + WS_U), (const bf16*)(ws + WS_WOUT) + (size_t)l * 2048 * 2048, ML, 2048, 2048, 0, 0, 2048, 2048}; pg8::StaticOrder S; S.init(ML, 2048, F.G, (int)blockIdx.x, WGM_OUT);
            pg8::EpiBf16<0> E{(bf16*)(ws + WS_MIX), 2048, 0};
            pg8::gemm_phase<pg8::EpiBf16<0>, pg8::StaticOrder, true, true>(F.lds + RING_OFF, g, S, E, F.wave);
            if (!lastl) { pg8::Gemm g2{(const bf16*)(ws + WS_UC) - (size_t)ML * 2048, (const bf16*)(ws + WS_WOUT) + (size_t)l * 2048 * 2048, MC, 2048, 1024, (size_t)MC * 2048 * 2, 0, 2048, 2048}; pg8::SplitKOrder<2, 3> S2; S2.init(MC, 2048, F.G, (int)blockIdx.x, ML / 256, 1024);
                pg8::EpiBf16<0> E2{(bf16*)(ws + WS_PART) - (size_t)ML * 2048, 2048, (size_t)MC * 2048};
                pg8::gemm_phase<pg8::EpiBf16<0>, pg8::SplitKOrder<2, 3>, true, true>(F.lds + RING_OFF, g2, S2, E2, F.wave); } });
            SEAM(pb + 5);
        }
        if (IN(pb + 6)) { if (REP_KIND == 10) ln_phase(F, l, 2, FIN(15) + l * DM, FIN(16) + l * DM, l, 3, l == 0, false, Mg, true, 6); ln_phase(F, l, 2, FIN(15) + l * DM, FIN(16) + l * DM, l, 3, l == 0, false, Mg, false, 6); SEAM(pb + 6); }
        if (IN(pb + 7)) {
            RUN(7, { pg8::Gemm g{(const bf16*)(ws + WS_H), (const bf16*)(ws + WS_WM1) + (size_t)l * 8192 * 2048, Mg, DFF, 2048, 0, 0, 2048, 2048}; pg8::StaticOrder S; S.init(Mg, DFF, F.G, (int)blockIdx.x, WGM_M1);
            pg8::EpiBf16<2> E{(bf16*)(ws + WS_HM), DFF, 0};
            pg8::gemm_phase<pg8::EpiBf16<2>, pg8::StaticOrder, true, true>(F.lds + RING_OFF, g, S, E, F.wave); });
            if (F.G == 256 && !lastl) convert_pocket(F, l + 1, CV_P2, CV_IL, 128);
            SEAM(pb + 7);
        }
        if (IN(pb + 8)) {
            RUN(8, { pg8::Gemm g{(const bf16*)(ws + WS_HM), (const bf16*)(ws + WS_WM2) + (size_t)l * 2048 * 8192, ML, 2048, DFF, 0, 0, DFF, DFF}; pg8::StaticOrder S; S.init(ML, 2048, F.G, (int)blockIdx.x, WGM_M2);
            pg8::EpiBf16<0> E{(bf16*)(ws + WS_MIX), 2048, 0};
            pg8::gemm_phase<pg8::EpiBf16<0>, pg8::StaticOrder, true, true>(F.lds + RING_OFF, g, S, E, F.wave);
            if (!lastl) { pg8::Gemm g2{(const bf16*)(ws + WS_HM), (const bf16*)(ws + WS_WM2) + (size_t)l * 2048 * 8192, MC, 2048, 1024, 0, 0, DFF, DFF}; pg8::SplitKOrder<8> S2; S2.init(MC, 2048, F.G, (int)blockIdx.x, ML / 256, 1024);
                pg8::EpiBf16<0> E2{(bf16*)(ws + WS_PART) - (size_t)ML * 2048, 2048, (size_t)MC * 2048};
                pg8::gemm_phase<pg8::EpiBf16<0>, pg8::SplitKOrder<8>, true, true>(F.lds + RING_OFF, g2, S2, E2, F.wave); } });
            SEAM(pb + 8);
        }
        if (IN(pb + 9)) { if (REP_KIND == 10) ln_phase(F, l, 5, FIN(17) + l * DM, FIN(18) + l * DM, l + 1, lastl ? -1 : 0, false, lastl, Mg, true, 8); ln_phase(F, l, 5, FIN(17) + l * DM, FIN(18) + l * DM, l + 1, lastl ? -1 : 0, false, lastl, Mg, false, 8); SEAM(pb + 9); }
    }
#undef IN
#undef SEAM
}

#ifndef MK_LAUNCHES
#define MK_LAUNCHES 1
#endif
extern "C" void kernel_launch(void* const* d_in, const int* in_sizes, int n_in, void* d_out, int out_size, void* d_ws, size_t ws_size, hipStream_t stream) {
    static int grid = 0;
    if (grid == 0) {
        if (n_in != 21 || out_size != ML * DM || ws_size < WS_END) { fprintf(stderr, "kernel_launch: unexpected shapes: n_in %d out %d ws %zu (need %zu)\n", n_in, out_size, ws_size, (size_t)WS_END); grid = -1; return; }
        int dev = 0, cus = 0, per_cu = 0;
        if (hipGetDevice(&dev) != hipSuccess || hipDeviceGetAttribute(&cus, hipDeviceAttributeMultiprocessorCount, dev) != hipSuccess) { grid = -1; return; }
        if (hipFuncSetAttribute((const void*)fwd_kernel, hipFuncAttributeMaxDynamicSharedMemorySize, LDS_BYTES) != hipSuccess) { fprintf(stderr, "kernel_launch: hipFuncSetAttribute failed\n"); grid = -1; return; }
        if (hipOccupancyMaxActiveBlocksPerMultiprocessor(&per_cu, (const void*)fwd_kernel, NWAVES * 64, LDS_BYTES) != hipSuccess || per_cu < 1) { fprintf(stderr, "kernel_launch: occupancy query reports %d\n", per_cu); }
        (void)hipGetLastError();
        grid = cus;
    }
    if (grid < 0) return;
    if (hipMemsetAsync((char*)d_ws + WS_CTL, 0, CTL_ZERO_BYTES, stream) != hipSuccess) return;
    Args a{};
    for (int i = 0; i < 21; ++i) a.in[i] = (const float*)d_in[i];
    a.out = (float*)d_out; a.ws = (unsigned char*)d_ws; a.pad = 0;
#if MK_LAUNCHES == 1
    a.ph_lo = 0; a.ph_hi = NPH; a.use_bar = 1;
    hipLaunchKernelGGL(fwd_kernel, dim3(grid), dim3(NWAVES * 64), LDS_BYTES, stream, a);
#else
    for (int p = 0; p < NPH; ++p) { a.ph_lo = p; a.ph_hi = p + 1; a.use_bar = 0; hipLaunchKernelGGL(fwd_kernel, dim3(grid), dim3(NWAVES * 64), LDS_BYTES, stream, a); }
#endif
    const hipError_t le = hipPeekAtLastError();
    if (le != hipSuccess) fprintf(stderr, "kernel_launch: launch failed: %s\n", hipGetErrorName(le));
}
```
